# Optimizing an MI355X kernel written in HIP

```python
import math
import jax, jax.numpy as jnp
from jax import lax
import numpy as np

D_MODEL = 1024
BATCH = 16
SEQ = 2048
DEPTH = 1

ATTN_HEADS = 8
ATTN_KV_HEADS = 2
HEAD_DIM = 64
ATTN_WIDTH = ATTN_HEADS * HEAD_DIM
KV_WIDTH = ATTN_KV_HEADS * HEAD_DIM
IDX_HEADS = 8
IDX_DIM = 64
IDX_TOPK_MAX = 256
Q_BLOCK = 128
SSD_HEADS = 8
SSD_HEAD_DIM = 64
SSD_WIDTH = SSD_HEADS * SSD_HEAD_DIM
SSD_GROUPS = 2
SSD_STATE = 128
SSD_CONV = 4
SSD_CHUNK = 128
CONV_DIM = SSD_WIDTH + 2 * SSD_GROUPS * SSD_STATE
MIX_WIDTH = ATTN_WIDTH + SSD_WIDTH
IN_SIZES = (ATTN_WIDTH, KV_WIDTH, KV_WIDTH, IDX_HEADS * IDX_DIM, IDX_DIM, IDX_HEADS, SSD_WIDTH, CONV_DIM, SSD_HEADS)
D_IN_PROJ = ATTN_WIDTH + 2 * KV_WIDTH + IDX_HEADS * IDX_DIM + IDX_DIM + IDX_HEADS + SSD_WIDTH + CONV_DIM + SSD_HEADS
PEER_HEADS = 8
PEER_NKEYS = 128
PEER_NEXPERTS = PEER_NKEYS * PEER_NKEYS
PEER_KEY_DIM = 128
PEER_HALF = PEER_KEY_DIM // 2
PEER_TOPK = 16
PEER_TOKEN_BLOCK = 128
ROPE_THETA = 10000.0
NORM_EPS = 1e-6

kernel_name = 'hybrid_dsa_ssd_peer_block'


def rmsnorm(x, g):
    xf = x.astype(jnp.float32)
    y = xf * lax.rsqrt(jnp.mean(xf * xf, axis=-1, keepdims=True) + NORM_EPS)
    return (y * g.astype(jnp.float32)).astype(x.dtype)


def rope_tables(positions, dim):
    inv_freq = ROPE_THETA ** (-jnp.arange(0, dim, 2, dtype=jnp.float32) / dim)
    ang = positions.astype(jnp.float32)[..., None] * inv_freq
    return jnp.cos(ang)[:, :, None, :], jnp.sin(ang)[:, :, None, :]


def apply_rope(x, cos, sin):
    half = x.shape[-1] // 2
    x1 = x[..., :half].astype(jnp.float32)
    x2 = x[..., half:].astype(jnp.float32)
    out = jnp.concatenate([x1 * cos - x2 * sin, x2 * cos + x1 * sin], axis=-1)
    return out.astype(x.dtype)


def dsa_attention(q, k, v, q_idx, k_idx, w_idx):
    b_, s_ = q.shape[0], q.shape[1]
    topk = min(IDX_TOPK_MAX, s_ // 4)
    n_blk = s_ // Q_BLOCK
    grp = ATTN_HEADS // ATTN_KV_HEADS
    key_pos = jnp.arange(s_)
    w_scaled = w_idx.astype(jnp.float32) * (IDX_HEADS ** -0.5)

    def block(i):
        start = i * Q_BLOCK
        qb = lax.dynamic_slice_in_dim(q, start, Q_BLOCK, axis=1)
        qib = lax.dynamic_slice_in_dim(q_idx, start, Q_BLOCK, axis=1)
        wib = lax.dynamic_slice_in_dim(w_scaled, start, Q_BLOCK, axis=1)
        qpos = start + jnp.arange(Q_BLOCK)
        causal = key_pos[None, :] <= qpos[:, None]
        logits = jnp.einsum('bqhd,bsd->bqhs', qib, k_idx).astype(jnp.float32) * (IDX_DIM ** -0.5)
        score = jnp.einsum('bqh,bqhs->bqs', wib, jax.nn.relu(logits))
        score = jnp.where(causal[None], score, -jnp.inf)
        _, sel = lax.top_k(score, topk)
        valid = sel <= qpos[None, :, None]
        k_sel = jax.vmap(lambda kb, ib: kb[ib])(k, sel)
        v_sel = jax.vmap(lambda vb, ib: vb[ib])(v, sel)
        qg = qb.reshape(b_, Q_BLOCK, ATTN_KV_HEADS, grp, HEAD_DIM)
        s = jnp.einsum('bqhgd,bqkhd->bqhgk', qg, k_sel).astype(jnp.float32) * (HEAD_DIM ** -0.5)
        s = jnp.where(valid[:, :, None, None, :], s, -jnp.inf)
        p = jax.nn.softmax(s, axis=-1).astype(v.dtype)
        o = jnp.einsum('bqhgk,bqkhd->bqhgd', p, v_sel)
        return o.reshape(b_, Q_BLOCK, ATTN_WIDTH)

    out = lax.map(block, jnp.arange(n_blk))
    return out.transpose(1, 0, 2, 3).reshape(b_, s_, ATTN_WIDTH)


def segsum(a):
    t = a.shape[-1]
    ii = jnp.arange(t)[:, None]
    jj = jnp.arange(t)[None, :]
    ar = jnp.broadcast_to(a[..., :, None], a.shape + (t,))
    ar = jnp.where(ii > jj, ar, 0.0)
    cs = jnp.cumsum(ar, axis=-2)
    return jnp.where(ii >= jj, cs, -jnp.inf)


def ssd_mixer(z, xbc, dt_raw, conv_w, conv_b, dt_bias, a_log, d_skip, norm_g):
    b_, s_ = z.shape[0], z.shape[1]
    f32 = jnp.float32
    xbc = lax.conv_general_dilated(xbc, conv_w[:, None, :].astype(xbc.dtype), window_strides=(1,),
                                   padding=[(SSD_CONV - 1, 0)], dimension_numbers=('NWC', 'WIO', 'NWC'),
                                   feature_group_count=CONV_DIM)
    xbc = jax.nn.silu(xbc + conv_b.astype(xbc.dtype))
    xs = xbc[..., :SSD_WIDTH]
    bm = xbc[..., SSD_WIDTH:SSD_WIDTH + SSD_GROUPS * SSD_STATE]
    cm = xbc[..., SSD_WIDTH + SSD_GROUPS * SSD_STATE:]
    dt = jax.nn.softplus(dt_raw.astype(f32) + dt_bias.astype(f32))
    a = -jnp.exp(a_log.astype(f32))
    nc = s_ // SSD_CHUNK
    r = SSD_HEADS // SSD_GROUPS
    x = xs.astype(f32).reshape(b_, nc, SSD_CHUNK, SSD_GROUPS, r, SSD_HEAD_DIM)
    dtc = dt.reshape(b_, nc, SSD_CHUNK, SSD_GROUPS, r)
    xdt = x * dtc[..., None]
    bc = bm.astype(f32).reshape(b_, nc, SSD_CHUNK, SSD_GROUPS, SSD_STATE)
    cc = cm.astype(f32).reshape(b_, nc, SSD_CHUNK, SSD_GROUPS, SSD_STATE)
    adt = (dtc * a.reshape(SSD_GROUPS, r)).transpose(0, 3, 4, 1, 2)
    a_cum = jnp.cumsum(adt, axis=-1)
    lmat = jnp.exp(segsum(adt))
    cb = jnp.einsum('bclgn,bcsgn->bgcls', cc, bc)
    y_diag = jnp.einsum('bgcls,bgrcls,bcsgrp->bclgrp', cb, lmat, xdt)
    decay_states = jnp.exp(a_cum[..., -1:] - a_cum)
    states = jnp.einsum('bclgn,bgrcl,bclgrp->bcgrpn', bc, decay_states, xdt)
    states = jnp.concatenate([jnp.zeros_like(states[:, :1]), states], axis=1)
    chunk_decay = jnp.exp(segsum(jnp.pad(a_cum[..., -1], ((0, 0), (0, 0), (0, 0), (1, 0)))))
    states = jnp.einsum('bgrzc,bcgrpn->bzgrpn', chunk_decay, states)[:, :-1]
    y_off = jnp.einsum('bclgn,bcgrpn,bgrcl->bclgrp', cc, states, jnp.exp(a_cum))
    y = y_diag + y_off + x * d_skip.astype(f32).reshape(SSD_GROUPS, r)[..., None]
    y = y.reshape(b_, s_, SSD_WIDTH)
    y = rmsnorm(y * jax.nn.silu(z.astype(f32)), norm_g)
    return y.astype(z.dtype)


def peer_ffn(h, w_q, sub_keys, u, v):
    b_, s_, d_ = h.shape
    ht = h.reshape((b_ * s_) // PEER_TOKEN_BLOCK, PEER_TOKEN_BLOCK, d_)

    def block(xb):
        q = (xb @ w_q).reshape(PEER_TOKEN_BLOCK, PEER_HEADS, 2, PEER_HALF)
        s = jnp.einsum('thid,hikd->thik', q, sub_keys).astype(jnp.float32)
        sv, si = lax.top_k(s, PEER_TOPK)
        cand = (sv[..., 0, :, None] + sv[..., 1, None, :]).reshape(PEER_TOKEN_BLOCK, PEER_HEADS, PEER_TOPK * PEER_TOPK)
        cidx = (si[..., 0, :, None] * PEER_NKEYS + si[..., 1, None, :]).reshape(PEER_TOKEN_BLOCK, PEER_HEADS, PEER_TOPK * PEER_TOPK)
        fv, fpos = lax.top_k(cand, PEER_TOPK)
        eidx = jnp.take_along_axis(cidx, fpos, axis=-1)
        g = jax.nn.softmax(fv, axis=-1)
        u_sel = jnp.take(u, eidx, axis=0)
        act = jax.nn.gelu(jnp.einsum('thkd,td->thk', u_sel, xb).astype(jnp.float32), approximate=False) * g
        v_sel = jnp.take(v, eidx, axis=0)
        return jnp.einsum('thk,thkd->td', act.astype(v.dtype), v_sel)

    out = lax.map(block, ht)
    return out.reshape(b_, s_, d_)


def setup_inputs(seed: int = 0) -> dict:
    key = jax.random.key(seed)
    ks = jax.random.split(key, 24)
    f32 = jnp.float32

    def nrm(k, shape, s):
        return jax.random.normal(k, shape, f32) * s

    x = nrm(ks[0], (BATCH, SEQ, D_MODEL), 1.0)
    c = nrm(ks[1], (BATCH, D_MODEL), 1.0)
    offs = jax.random.randint(ks[2], (BATCH, 1), 0, 64, dtype=jnp.int32)
    positions = offs + jnp.arange(SEQ, dtype=jnp.int32)[None, :]
    w_ada = nrm(ks[3], (DEPTH, D_MODEL, 6 * D_MODEL), 0.5 * D_MODEL ** -0.5)
    b_ada = nrm(ks[4], (DEPTH, 6 * D_MODEL), 0.02)
    pre_mix_g = 1.0 + nrm(ks[5], (DEPTH, D_MODEL), 0.02)
    post_mix_g = 1.0 + nrm(ks[6], (DEPTH, D_MODEL), 0.02)
    w_in = nrm(ks[7], (DEPTH, D_MODEL, D_IN_PROJ), D_MODEL ** -0.5)
    conv_w = nrm(ks[8], (DEPTH, SSD_CONV, CONV_DIM), SSD_CONV ** -0.5)
    conv_b = nrm(ks[9], (DEPTH, CONV_DIM), 0.02)
    dt0 = jnp.exp(jax.random.uniform(ks[10], (DEPTH, SSD_HEADS), f32, math.log(1e-3), math.log(1e-1)))
    dt_bias = dt0 + jnp.log(-jnp.expm1(-dt0))
    a_log = jnp.log(jax.random.uniform(ks[11], (DEPTH, SSD_HEADS), f32, 1.0, 16.0))
    d_skip = 1.0 + nrm(ks[12], (DEPTH, SSD_HEADS), 0.02)
    ssd_norm_g = 1.0 + nrm(ks[13], (DEPTH, SSD_WIDTH), 0.02)
    w_out = nrm(ks[14], (DEPTH, MIX_WIDTH, D_MODEL), MIX_WIDTH ** -0.5)
    pre_ffn_g = 1.0 + nrm(ks[15], (DEPTH, D_MODEL), 0.02)
    post_ffn_g = 1.0 + nrm(ks[16], (DEPTH, D_MODEL), 0.02)
    peer_w_q = nrm(ks[17], (DEPTH, D_MODEL, PEER_HEADS * PEER_KEY_DIM), D_MODEL ** -0.5)
    peer_sub_keys = nrm(ks[18], (DEPTH, PEER_HEADS, 2, PEER_NKEYS, PEER_HALF), PEER_HALF ** -0.5)
    peer_u = nrm(ks[19], (DEPTH, PEER_NEXPERTS, D_MODEL), D_MODEL ** -0.5)
    peer_v = nrm(ks[20], (DEPTH, PEER_NEXPERTS, D_MODEL), D_MODEL ** -0.5)
    return {'x': x, 'c': c, 'positions': positions, 'w_ada': w_ada, 'b_ada': b_ada,
            'pre_mix_g': pre_mix_g, 'post_mix_g': post_mix_g, 'w_in': w_in, 'conv_w': conv_w,
            'conv_b': conv_b, 'dt_bias': dt_bias, 'a_log': a_log, 'd_skip': d_skip,
            'ssd_norm_g': ssd_norm_g, 'w_out': w_out, 'pre_ffn_g': pre_ffn_g, 'post_ffn_g': post_ffn_g,
            'peer_w_q': peer_w_q, 'peer_sub_keys': peer_sub_keys, 'peer_u': peer_u, 'peer_v': peer_v}


def reference(x, c, positions, w_ada, b_ada, pre_mix_g, post_mix_g, w_in, conv_w, conv_b, dt_bias,
              a_log, d_skip, ssd_norm_g, w_out, pre_ffn_g, post_ffn_g, peer_w_q, peer_sub_keys,
              peer_u, peer_v):
    b_, s_, _ = x.shape
    cos, sin = rope_tables(positions, HEAD_DIM)
    split_at = np.cumsum(IN_SIZES)[:-1].tolist()
    for l in range(DEPTH):
        mod = jax.nn.silu(c) @ w_ada[l] + b_ada[l]
        sh1, sc1, g1, sh2, sc2, g2 = jnp.split(mod[:, None, :], 6, axis=-1)
        h = rmsnorm(x, pre_mix_g[l]) * (1.0 + sc1) + sh1
        proj = h @ w_in[l]
        q, k, v, qi, ki, wi, z, xbc, dt_raw = jnp.split(proj, split_at, axis=-1)
        q = apply_rope(q.reshape(b_, s_, ATTN_HEADS, HEAD_DIM), cos, sin)
        k = apply_rope(k.reshape(b_, s_, ATTN_KV_HEADS, HEAD_DIM), cos, sin)
        v = v.reshape(b_, s_, ATTN_KV_HEADS, HEAD_DIM)
        qi = apply_rope(qi.reshape(b_, s_, IDX_HEADS, IDX_DIM), cos, sin)
        ki = apply_rope(ki[:, :, None, :], cos, sin)[:, :, 0, :]
        attn_out = dsa_attention(q, k, v, qi, ki, wi)
        ssd_out = ssd_mixer(z, xbc, dt_raw, conv_w[l], conv_b[l], dt_bias[l], a_log[l], d_skip[l], ssd_norm_g[l])
        mix = jnp.concatenate([attn_out, ssd_out.astype(attn_out.dtype)], axis=-1) @ w_out[l]
        x = x + g1 * rmsnorm(mix, post_mix_g[l])
        h = rmsnorm(x, pre_ffn_g[l]) * (1.0 + sc2) + sh2
        f = peer_ffn(h, peer_w_q[l], peer_sub_keys[l], peer_u[l], peer_v[l])
        x = x + g2 * rmsnorm(f, post_ffn_g[l])
    return x.astype(positions.dtype if False else x.dtype)
```

```cpp
#include <hip/hip_runtime.h>
#include <hip/hip_cooperative_groups.h>
#include <stdint.h>
#include <stdio.h>
namespace cg = cooperative_groups;

#ifndef STAGE
#define STAGE 99
#endif
#ifndef ONLY
#define ONLY -1
#endif
#define PH(n) (ONLY < 0 || ONLY == (n))
#ifndef PROBE_P0
#define PROBE_P0 1
#endif
#ifndef PROBE_HN
#define PROBE_HN 1
#endif
#ifndef PROBE_P1
#define PROBE_P1 1
#endif
#ifndef PROBE_SSDA
#define PROBE_SSDA 1
#endif
#ifndef PROBE_DSA
#define PROBE_DSA 1
#endif
#ifndef PROBE_SSDB
#define PROBE_SSDB 1
#endif
#ifndef PROBE_UHOT
#define PROBE_UHOT 0
#endif
#ifndef PROBE_VHOT
#define PROBE_VHOT 0
#endif
#ifndef PROBE_DSA_SC
#define PROBE_DSA_SC 1
#endif
#ifndef PROBE_DSA_BIS
#define PROBE_DSA_BIS 1
#endif
#ifndef PROBE_DSA_ATT
#define PROBE_DSA_ATT 1
#endif
#ifndef PROBE_U
#define PROBE_U 1
#endif
#ifndef PROBE_V
#define PROBE_V 1
#endif
#ifndef PROBE_ROUTE
#define PROBE_ROUTE 1
#endif
#ifndef PROBE_G3
#define PROBE_G3 1
#endif

#define NT 512
typedef unsigned short u16;
typedef __attribute__((ext_vector_type(8))) short bf16x8;
typedef __attribute__((ext_vector_type(16))) float f32x16;
typedef __attribute__((ext_vector_type(16))) unsigned u32x16;

#define DEV __device__ __forceinline__

constexpr int B_ = 16, S_ = 2048, D_ = 1024, T_ = B_ * S_;
constexpr int NPROJ = 2896, NPAD = 3072;
constexpr int SV_ = 2048 + 64;
constexpr float NEG_INF = -__builtin_huge_valf();

constexpr size_t OFF_MOD = 0;
constexpr size_t OFF_COS = OFF_MOD + 786432;
constexpr size_t OFF_SIN = OFF_COS + (size_t)T_ * 32 * 4;
constexpr size_t OFF_HBUF = OFF_SIN + (size_t)T_ * 32 * 4;
constexpr size_t OFF_WTIN = OFF_HBUF + (size_t)T_ * 1024 * 2;
constexpr size_t OFF_WTOUT = OFF_WTIN + (size_t)NPAD * 1024 * 2;
constexpr size_t OFF_WTQ = OFF_WTOUT + (size_t)1024 * 1024 * 2;
constexpr size_t OFF_SK = OFF_WTQ + (size_t)1024 * 1024 * 2;
constexpr size_t OFF_U = OFF_SK + (size_t)16 * 128 * 64 * 2;
constexpr size_t OFF_V = OFF_U + (size_t)16384 * 1024;
constexpr size_t OFF_SU = OFF_V + (size_t)16384 * 1024;
constexpr size_t OFF_SV = OFF_SU + (size_t)16384 * 4;
constexpr size_t OFF_Q = OFF_SV + (size_t)16384 * 4;
constexpr size_t OFF_QI = OFF_Q + (size_t)T_ * 512 * 2;
constexpr size_t OFF_XBC = OFF_QI + (size_t)T_ * 512 * 2;
constexpr size_t OFF_SIN_ST = OFF_XBC;
constexpr size_t OFF_MIX = OFF_Q;
constexpr size_t OFF_K = OFF_XBC + (size_t)T_ * 1024 * 2;
constexpr size_t OFF_VT = OFF_K + (size_t)T_ * 128 * 2;
constexpr size_t OFF_KI = OFF_VT + (size_t)16 * 2 * 64 * SV_ * 2;
constexpr size_t OFF_WI = OFF_KI + (size_t)T_ * 64 * 2;
constexpr size_t OFF_DT = OFF_WI + (size_t)T_ * 8 * 4;
constexpr size_t OFF_Z = OFF_DT + (size_t)T_ * 8 * 4;
constexpr size_t OFF_EIDX = OFF_Z;
constexpr size_t OFF_GATE = OFF_Z + (size_t)T_ * 128 * 4;
constexpr size_t OFF_ST = OFF_Z + (size_t)T_ * 512 * 2;
constexpr size_t OFF_YP_ = OFF_ST + (size_t)16 * 16 * 8 * 64 * 128 * 4 + (size_t)16 * 16 * 8 * 128 * 4;
constexpr size_t OFF_X1 = OFF_ST;
constexpr size_t OFF_QP = OFF_YP_;
constexpr size_t OFF_ACUM = OFF_ST + (size_t)16 * 16 * 8 * 64 * 128 * 4;
constexpr size_t OFF_YP = OFF_ACUM + (size_t)16 * 16 * 8 * 128 * 4;
static_assert(OFF_YP_ == OFF_YP, "alias");
constexpr size_t OFF_CC = OFF_YP + (size_t)T_ * 512 * 4;
constexpr size_t OFF_BAR = OFF_CC + (size_t)T_ * 256 * 2;
constexpr size_t OFF_XB = OFF_BAR + 256;
constexpr size_t OFF_H2Q = OFF_XB + 16384;
constexpr size_t OFF_SH = OFF_H2Q + (size_t)T_ * 1024;
constexpr size_t WS_END = OFF_SH + (size_t)T_ * 4;

constexpr int LDS_BYTES = 156672;

struct Params {
  const float* x; const float* c; const int* pos; const float* w_ada; const float* b_ada;
  const float* pre_mix_g; const float* post_mix_g; const float* w_in; const float* conv_w; const float* conv_b;
  const float* dt_bias; const float* a_log; const float* d_skip; const float* ssd_norm_g; const float* w_out;
  const float* pre_ffn_g; const float* post_ffn_g; const float* w_q; const float* sub_keys; const float* peer_u;
  const float* peer_v; float* out; unsigned char* ws;
};

__constant__ float c_inv_freq[32] = {
  1.000000000e+00f, 7.498942614e-01f, 5.623413324e-01f, 4.216965139e-01f, 3.162277639e-01f, 2.371373773e-01f, 1.778279394e-01f, 1.333521307e-01f,
  1.000000015e-01f, 7.498941571e-02f, 5.623413250e-02f, 4.216965288e-02f, 3.162277490e-02f, 2.371373773e-02f, 1.778279431e-02f, 1.333521493e-02f,
  9.999999776e-03f, 7.498941850e-03f, 5.623413250e-03f, 4.216964822e-03f, 3.162277630e-03f, 2.371373586e-03f, 1.778279431e-03f, 1.333521446e-03f,
  1.000000047e-03f, 7.498942432e-04f, 5.623413017e-04f, 4.216965172e-04f, 3.162277571e-04f, 2.371373703e-04f, 1.778279402e-04f, 1.333521504e-04f};

DEV int opaque_tid() { int t = threadIdx.x; asm volatile("" : "+v"(t)); return t; }
DEV u16 f2bf(float f) { unsigned u = __float_as_uint(f); u += 0x7FFFu + ((u >> 16) & 1u); return (u16)(u >> 16); }
DEV float bf2f(u16 h) { return __uint_as_float(((unsigned)h) << 16); }
DEV unsigned pack2(float a, float b) { unsigned r; asm("v_cvt_pk_bf16_f32 %0, %1, %2" : "=v"(r) : "v"(a), "v"(b)); return r; }
DEV float bflo(unsigned u) { return __uint_as_float(u << 16); }
DEV float bfhi(unsigned u) { return __uint_as_float(u & 0xFFFF0000u); }
DEV float wave_sum(float v) {
#pragma unroll
  for (int o = 32; o > 0; o >>= 1) v += __shfl_xor(v, o);
  return v;
}
#define DPP_ADD(v, ctrl, rmask) v += __int_as_float(__builtin_amdgcn_update_dpp(0, __float_as_int(v), ctrl, rmask, 0xF, false))
DEV float wave_sum63(float v) {
  DPP_ADD(v, 0xB1, 0xF);
  DPP_ADD(v, 0x4E, 0xF);
  DPP_ADD(v, 0x141, 0xF);
  DPP_ADD(v, 0x140, 0xF);
  DPP_ADD(v, 0x142, 0xA);
  DPP_ADD(v, 0x143, 0xC);
  return v;
}
DEV f32x16 mfma32(bf16x8 a, bf16x8 b, f32x16 c) { return __builtin_amdgcn_mfma_f32_32x32x16_bf16(a, b, c, 0, 0, 0); }
DEV f32x16 zero16() { f32x16 z;
#pragma unroll
  for (int i = 0; i < 16; i++) z[i] = 0.f;
  return z; }
DEV int rowmap(int reg, int hh) { return (reg & 3) + 8 * (reg >> 2) + 4 * hh; }
DEV float silu_f(float v) { return v / (1.f + expf(-v)); }
DEV unsigned ordkey(float f) { unsigned b = __float_as_uint(f); unsigned m = (unsigned)((int)b >> 31) | 0x80000000u; return b ^ m; }
DEV bf16x8 mk_frag(uint2 lo, uint2 hi) { union { uint4 u; bf16x8 v; } t; t.u = make_uint4(lo.x, lo.y, hi.x, hi.y); return t.v; }
DEV bf16x8 pack_frag(const f32x16& v, int base) {
  union { uint4 u; bf16x8 f; } t;
  t.u = make_uint4(pack2(v[base + 0], v[base + 1]), pack2(v[base + 2], v[base + 3]), pack2(v[base + 4], v[base + 5]), pack2(v[base + 6], v[base + 7]));
  return t.f;
}

DEV float4 ldmod(const float* mod, int off) {
  const float4 a = *(const float4*)(mod + off), b = *(const float4*)(mod + 98304 + off);
  return make_float4(a.x + b.x, a.y + b.y, a.z + b.z, a.w + b.w);
}
DEV void phase_mod(const Params& p, char* smem) {
  float* s_silu = (float*)smem;
  float* s_red = (float*)(smem + 32768);
  float* mod = (float*)(p.ws + OFF_MOD);
  const int tid = threadIdx.x;
  for (int item = blockIdx.x; item < 192; item += gridDim.x) {
    const int cgp = item >> 1, ks = item & 1;
    __syncthreads();
    for (int e = tid; e < 8192; e += NT) { int b = e >> 9, i = e & 511; s_silu[i * 16 + b] = silu_f(p.c[b * 1024 + ks * 512 + i]); }
    __syncthreads();
    const int kg = tid >> 6, col = tid & 63;
    float acc[16];
#pragma unroll
    for (int b = 0; b < 16; b++) acc[b] = 0.f;
    const float* w = p.w_ada + (size_t)(ks * 512 + kg * 64) * 6144 + cgp * 64 + col;
#pragma unroll 1
    for (int i0 = 0; i0 < 64; i0 += 16) {
      float wreg[16];
#pragma unroll
      for (int u = 0; u < 16; u++) wreg[u] = w[(size_t)(i0 + u) * 6144];
#pragma unroll
      for (int u = 0; u < 16; u++) {
        const float wv = wreg[u];
        const float4* sp = (const float4*)(s_silu + (kg * 64 + i0 + u) * 16);
        float4 s0 = sp[0], s1 = sp[1], s2 = sp[2], s3 = sp[3];
        acc[0] += s0.x * wv; acc[1] += s0.y * wv; acc[2] += s0.z * wv; acc[3] += s0.w * wv;
        acc[4] += s1.x * wv; acc[5] += s1.y * wv; acc[6] += s1.z * wv; acc[7] += s1.w * wv;
        acc[8] += s2.x * wv; acc[9] += s2.y * wv; acc[10] += s2.z * wv; acc[11] += s2.w * wv;
        acc[12] += s3.x * wv; acc[13] += s3.y * wv; acc[14] += s3.z * wv; acc[15] += s3.w * wv;
      }
    }
#pragma unroll
    for (int b = 0; b < 16; b++) s_red[(kg * 64 + col) * 16 + b] = acc[b];
    __syncthreads();
    for (int e = tid; e < 1024; e += NT) {
      int cc = e >> 4, b = e & 15; float sum = 0.f;
#pragma unroll
      for (int k = 0; k < 8; k++) sum += s_red[(k * 64 + cc) * 16 + b];
      int j = cgp * 64 + cc;
      mod[ks * 98304 + b * 6144 + j] = sum + (ks == 0 ? p.b_ada[j] : 0.f);
    }
  }
}

DEV int remap_col(int n) {
  if (n < 1344) return n;
  if (n < 1352) return 2880 + (n - 1344);
  if (n < 2888) return n - 8;
  return n;
}

DEV void transpose_convert(const float* __restrict__ src, int N, u16* __restrict__ dst, bool remap, char* smem) {
  float* tile = (float*)smem;
  const int tid = threadIdx.x;
  const int ntn = (N + 63) >> 6;
  const int nitems = 16 * ntn;
  for (int item = blockIdx.x; item < nitems; item += gridDim.x) {
    const int kt = item / ntn, nt = item - kt * ntn;
    const int k0 = kt * 64, n0 = nt * 64;
    __syncthreads();
    for (int e = tid; e < 4096; e += NT) {
      int r = e >> 6, ci = e & 63, n = n0 + ci;
      tile[r * 65 + ci] = (n < N) ? src[(size_t)(k0 + r) * N + n] : 0.f;
    }
    __syncthreads();
    for (int e = tid; e < 4096; e += NT) {
      int nn = e >> 6, kk = e & 63, n = n0 + nn;
      if (n < N) { int n2 = remap ? remap_col(n) : n; dst[(size_t)n2 * 1024 + k0 + kk] = f2bf(tile[kk * 65 + nn]); }
    }
  }
}

DEV void convert_bf16(const float* __restrict__ src, u16* __restrict__ dst, size_t n8) {
  const size_t g = (size_t)blockIdx.x * NT + threadIdx.x, gs = (size_t)gridDim.x * NT;
  for (size_t i = g; i < n8; i += gs) {
    const float4 a = ((const float4*)src)[2 * i], b = ((const float4*)src)[2 * i + 1];
    ((uint4*)dst)[i] = make_uint4(pack2(a.x, a.y), pack2(a.z, a.w), pack2(b.x, b.y), pack2(b.z, b.w));
  }
}

DEV void convert_fp8_rows(const float* __restrict__ src, unsigned char* __restrict__ dst, float* __restrict__ scl) {
  const int tid_ = opaque_tid(); const int lane = tid_ & 63, wave = __builtin_amdgcn_readfirstlane(tid_ >> 6);
  for (int e0 = ((blockIdx.x >> 1) * 8 + wave) * 4 + (blockIdx.x & 1) * 8192; e0 < 8192 + (blockIdx.x & 1) * 8192; e0 += (gridDim.x >> 1) * 32) {
    float4 v[4][4];
#pragma unroll
    for (int u = 0; u < 4; u++)
#pragma unroll
      for (int j = 0; j < 4; j++) v[u][j] = *(const float4*)(src + (size_t)(e0 + u) * 1024 + j * 256 + lane * 4);
#pragma unroll
    for (int u = 0; u < 4; u++) {
      float mx = 0.f;
#pragma unroll
      for (int j = 0; j < 4; j++) mx = fmaxf(mx, fmaxf(fmaxf(fabsf(v[u][j].x), fabsf(v[u][j].y)), fmaxf(fabsf(v[u][j].z), fabsf(v[u][j].w))));
#pragma unroll
      for (int o = 32; o > 0; o >>= 1) mx = fmaxf(mx, __shfl_xor(mx, o));
      const float inv = (mx > 0.f) ? 384.f / mx : 0.f;
      int wd[4];
#pragma unroll
      for (int j = 0; j < 4; j++) {
        int t = 0;
        t = __builtin_amdgcn_cvt_pk_fp8_f32(v[u][j].x * inv, v[u][j].y * inv, t, false);
        t = __builtin_amdgcn_cvt_pk_fp8_f32(v[u][j].z * inv, v[u][j].w * inv, t, true);
        wd[j] = t;
      }
      *(uint4*)(dst + (size_t)(e0 + u) * 1024 + lane * 16) = make_uint4((unsigned)wd[0], (unsigned)wd[1], (unsigned)wd[2], (unsigned)wd[3]);
      if (lane == 0) scl[e0 + u] = mx * (1.f / 384.f);
    }
  }
}

DEV unsigned pack_i8x4(float a, float b, float c, float d) {
  const int ia = (int)rintf(a), ib = (int)rintf(b), ic = (int)rintf(c), id = (int)rintf(d);
  return (unsigned)(ia & 255) | ((unsigned)(ib & 255) << 8) | ((unsigned)(ic & 255) << 16) | ((unsigned)id << 24);
}
DEV void convert_i8_rows(const float* __restrict__ src, unsigned char* __restrict__ dst, float* __restrict__ scl) {
  const int tid_ = opaque_tid(); const int lane = tid_ & 63, wave = __builtin_amdgcn_readfirstlane(tid_ >> 6);
  for (int e0 = ((blockIdx.x >> 1) * 8 + wave) * 4 + (blockIdx.x & 1) * 8192; e0 < 8192 + (blockIdx.x & 1) * 8192; e0 += (gridDim.x >> 1) * 32) {
    float4 v[4][4];
#pragma unroll
    for (int u = 0; u < 4; u++)
#pragma unroll
      for (int j = 0; j < 4; j++) v[u][j] = *(const float4*)(src + (size_t)(e0 + u) * 1024 + j * 256 + lane * 4);
#pragma unroll
    for (int u = 0; u < 4; u++) {
      float mx = 0.f;
#pragma unroll
      for (int j = 0; j < 4; j++) mx = fmaxf(mx, fmaxf(fmaxf(fabsf(v[u][j].x), fabsf(v[u][j].y)), fmaxf(fabsf(v[u][j].z), fabsf(v[u][j].w))));
#pragma unroll
      for (int o = 32; o > 0; o >>= 1) mx = fmaxf(mx, __shfl_xor(mx, o));
      const float inv = (mx > 0.f) ? 127.f / mx : 0.f;
      unsigned wd[4];
#pragma unroll
      for (int j = 0; j < 4; j++) wd[j] = pack_i8x4(v[u][j].x * inv, v[u][j].y * inv, v[u][j].z * inv, v[u][j].w * inv);
      *(uint4*)(dst + (size_t)(e0 + u) * 1024 + lane * 16) = make_uint4(wd[0], wd[1], wd[2], wd[3]);
      if (lane == 0) scl[e0 + u] = mx * (1.f / 127.f);
    }
  }
}

DEV void phase0(const Params& p, char* smem) {
  {
    float* cosT = (float*)(p.ws + OFF_COS); float* sinT = (float*)(p.ws + OFF_SIN);
    const int g = blockIdx.x * NT + threadIdx.x, gs = gridDim.x * NT;
    for (int e = g; e < T_ * 32; e += gs) {
      int t = e >> 5, j = e & 31;
      float ang = (float)p.pos[t] * c_inv_freq[j];
      double rev = (double)ang * 0.15915494309189533577;
      rev -= rint(rev);
      float fr = (float)rev;
      cosT[e] = __builtin_amdgcn_cosf(fr);
      sinT[e] = __builtin_amdgcn_sinf(fr);
    }
  }
  transpose_convert(p.w_in, NPROJ, (u16*)(p.ws + OFF_WTIN), true, smem);
  {
    uint4* z = (uint4*)(p.ws + OFF_WTIN + (size_t)NPROJ * 1024 * 2);
    const int n = (NPAD - NPROJ) * 1024 * 2 / 16;
    for (int i = blockIdx.x * NT + threadIdx.x; i < n; i += gridDim.x * NT) z[i] = make_uint4(0, 0, 0, 0);
  }
  transpose_convert(p.w_out, 1024, (u16*)(p.ws + OFF_WTOUT), false, smem);
  transpose_convert(p.w_q, 1024, (u16*)(p.ws + OFF_WTQ), false, smem);
  convert_bf16(p.sub_keys, (u16*)(p.ws + OFF_SK), (size_t)16 * 128 * 64 / 8);
}

DEV void phase_hnorm(const Params& p) {
  const int tid_ = opaque_tid(); const int lane = tid_ & 63, wave = __builtin_amdgcn_readfirstlane(tid_ >> 6);
  const float* mod = (const float*)(p.ws + OFF_MOD);
  u16* h = (u16*)(p.ws + OFF_HBUF);
#pragma unroll 2
  for (int t = blockIdx.x * 8 + wave; t < T_; t += gridDim.x * 8) {
    const int b = t >> 11;
    const float4* xr = (const float4*)(p.x + (size_t)t * 1024);
    float4 v[4]; float ss = 0.f;
#pragma unroll
    for (int i = 0; i < 4; i++) { v[i] = xr[i * 64 + lane]; ss += v[i].x * v[i].x + v[i].y * v[i].y + v[i].z * v[i].z + v[i].w * v[i].w; }
    ss = wave_sum(ss);
    const float rstd = rsqrtf(ss * (1.f / 1024.f) + 1e-6f);
#pragma unroll
    for (int i = 0; i < 4; i++) {
      const int col = (i * 64 + lane) * 4;
      const float4 g = *(const float4*)(p.pre_mix_g + col);
      const float4 sh = ldmod(mod, b * 6144 + col);
      const float4 sc = ldmod(mod, b * 6144 + 1024 + col);
      float y0 = (v[i].x * rstd * g.x) * (1.f + sc.x) + sh.x;
      float y1 = (v[i].y * rstd * g.y) * (1.f + sc.y) + sh.y;
      float y2 = (v[i].z * rstd * g.z) * (1.f + sc.z) + sh.z;
      float y3 = (v[i].w * rstd * g.w) * (1.f + sc.w) + sh.w;
      *(uint2*)(h + (size_t)t * 1024 + col) = make_uint2(pack2(y0, y1), pack2(y2, y3));
    }
  }
}

constexpr int G_ROWB = 144;
constexpr int G_ABYTES = 128 * G_ROWB;
constexpr int G_STAGE = (128 + 256) * G_ROWB;
constexpr int G_SROW = 68;

template <class Epi>
DEV void gemm_tile(const u16* __restrict__ A, int lda, const u16* __restrict__ Bt, int ldb, int K, char* smem, Epi& epi) {
  const int tid = opaque_tid(), lane = tid & 63, wave = __builtin_amdgcn_readfirstlane(tid >> 6), wm = wave >> 2, wn = wave & 3;
  const int r = lane & 31, hh = lane >> 5;
  f32x16 acc00 = zero16(), acc01 = zero16(), acc10 = zero16(), acc11 = zero16();
  uint4 pa0, pa1, pb0, pb1, pb2, pb3;
  uint4 qa0, qa1, qb0, qb1, qb2, qb3;
  const int crow = tid >> 3, ckc = tid & 7;
  const u16* Ap = A + (size_t)crow * lda + ckc * 8;
  const u16* Bp = Bt + (size_t)crow * ldb + ckc * 8;
  const size_t a64 = (size_t)64 * lda, b64 = (size_t)64 * ldb;
  const int loff = crow * G_ROWB + ckc * 16;
#define G_LOAD(S, k0) { S##a0 = *(const uint4*)(Ap + (k0)); S##a1 = *(const uint4*)(Ap + a64 + (k0)); \
    S##b0 = *(const uint4*)(Bp + (k0)); S##b1 = *(const uint4*)(Bp + b64 + (k0)); S##b2 = *(const uint4*)(Bp + 2 * b64 + (k0)); S##b3 = *(const uint4*)(Bp + 3 * b64 + (k0)); }
#define G_STORE(S, buf) { char* sb_ = smem + (buf) * G_STAGE + loff; *(uint4*)(sb_) = S##a0; *(uint4*)(sb_ + 64 * G_ROWB) = S##a1; \
    char* sc_ = sb_ + G_ABYTES; *(uint4*)(sc_) = S##b0; *(uint4*)(sc_ + 64 * G_ROWB) = S##b1; *(uint4*)(sc_ + 128 * G_ROWB) = S##b2; *(uint4*)(sc_ + 192 * G_ROWB) = S##b3; }
#define G_COMPUTE(buf) { const char* sb = smem + (buf) * G_STAGE; _Pragma("unroll") for (int s = 0; s < 4; s++) { \
      const bf16x8 a0 = *(const bf16x8*)(sb + aoff + s * 32); const bf16x8 a1 = *(const bf16x8*)(sb + aoff + 32 * G_ROWB + s * 32); \
      const bf16x8 b0 = *(const bf16x8*)(sb + boff + s * 32); const bf16x8 b1 = *(const bf16x8*)(sb + boff + 32 * G_ROWB + s * 32); \
      acc00 = mfma32(a0, b0, acc00); acc01 = mfma32(a0, b1, acc01); acc10 = mfma32(a1, b0, acc10); acc11 = mfma32(a1, b1, acc11); } }
  const int nk = K >> 6;
  const int aoff = (wm * 64 + r) * G_ROWB + hh * 16;
  const int boff = G_ABYTES + (wn * 64 + r) * G_ROWB + hh * 16;
  G_LOAD(p, 0); G_LOAD(q, 64);
  __syncthreads();
  G_STORE(p, 0);
  __syncthreads();
  for (int kt = 0; kt < nk; kt += 2) {
    if (kt + 2 < nk) G_LOAD(p, (kt + 2) * 64);
    G_COMPUTE(0);
    G_STORE(q, 1);
    __syncthreads();
    if (kt + 3 < nk) G_LOAD(q, (kt + 3) * 64);
    G_COMPUTE(1);
    if (kt + 2 < nk) G_STORE(p, 0);
    __syncthreads();
  }
#undef G_LOAD
#undef G_STORE
#undef G_COMPUTE
  {
    float* stage = (float*)(smem + wave * (64 * G_SROW * 4));
#pragma unroll
    for (int reg = 0; reg < 16; reg++) {
      const int row = (reg & 3) + 8 * (reg >> 2) + 4 * hh;
      stage[row * G_SROW + r] = acc00[reg];
      stage[row * G_SROW + 32 + r] = acc01[reg];
      stage[(32 + row) * G_SROW + r] = acc10[reg];
      stage[(32 + row) * G_SROW + 32 + r] = acc11[reg];
    }
    epi.apply(stage, wm * 64, wn * 64, lane);
  }
}

DEV void ld16(const float* src, float* x) {
  const float4 a = *(const float4*)src, b = *(const float4*)(src + 4), c = *(const float4*)(src + 8), d = *(const float4*)(src + 12);
  x[0] = a.x; x[1] = a.y; x[2] = a.z; x[3] = a.w; x[4] = b.x; x[5] = b.y; x[6] = b.z; x[7] = b.w;
  x[8] = c.x; x[9] = c.y; x[10] = c.z; x[11] = c.w; x[12] = d.x; x[13] = d.y; x[14] = d.z; x[15] = d.w;
}
DEV void st16_bf(u16* dst, const float* x) {
  *(uint4*)dst = make_uint4(pack2(x[0], x[1]), pack2(x[2], x[3]), pack2(x[4], x[5]), pack2(x[6], x[7]));
  *(uint4*)(dst + 8) = make_uint4(pack2(x[8], x[9]), pack2(x[10], x[11]), pack2(x[12], x[13]), pack2(x[14], x[15]));
}
DEV void st16_f(float* dst, const float* x) {
  *(float4*)dst = make_float4(x[0], x[1], x[2], x[3]); *(float4*)(dst + 4) = make_float4(x[4], x[5], x[6], x[7]);
  *(float4*)(dst + 8) = make_float4(x[8], x[9], x[10], x[11]); *(float4*)(dst + 12) = make_float4(x[12], x[13], x[14], x[15]);
}

struct EpiInProj {
  const Params* p; int m0, n0;
  DEV void apply(const float* stage, int rbase, int cbase, int lane) { apply_s<G_SROW>(stage, rbase, cbase, lane); }
  template <int SROW>
  DEV void apply_s(const float* stage, int rbase, int cbase, int lane) {
    const int nb = n0 + cbase;
    unsigned char* ws = p->ws;
    const int tb = m0 + rbase;
    if (nb < 640 || (nb >= 768 && nb < 1344)) {
      u16* dst; int ld, cb;
      if (nb < 512) { dst = (u16*)(ws + OFF_Q); ld = 512; cb = nb; }
      else if (nb < 640) { dst = (u16*)(ws + OFF_K); ld = 128; cb = nb - 512; }
      else if (nb < 1280) { dst = (u16*)(ws + OFF_QI); ld = 512; cb = nb - 768; }
      else { dst = (u16*)(ws + OFF_KI); ld = 64; cb = 0; }
      const float* cosT = (const float*)(ws + OFF_COS); const float* sinT = (const float*)(ws + OFF_SIN);
      const int cg = lane & 1;
#pragma unroll 1
      for (int i = 0; i < 2; i++) {
        const int row = (lane >> 1) + 32 * i; const int t = tb + row;
        float x1[16], x2[16], cs[16], sn[16], o1[16], o2[16];
        ld16(stage + row * SROW + cg * 16, x1); ld16(stage + row * SROW + 32 + cg * 16, x2);
        ld16(cosT + (size_t)t * 32 + cg * 16, cs); ld16(sinT + (size_t)t * 32 + cg * 16, sn);
#pragma unroll
        for (int k = 0; k < 16; k++) { o1[k] = x1[k] * cs[k] - x2[k] * sn[k]; o2[k] = x2[k] * cs[k] + x1[k] * sn[k]; }
        st16_bf(dst + (size_t)t * ld + cb + cg * 16, o1); st16_bf(dst + (size_t)t * ld + cb + 32 + cg * 16, o2);
      }
    } else if (nb >= 640 && nb < 768) {
      u16* vt = (u16*)(ws + OFF_VT);
      const int kvh = (nb - 640) >> 6;
      const int b = tb >> 11, s0 = tb & 2047;
      u16* dp = vt + ((size_t)(b * 2 + kvh) * 64 + lane) * SV_ + s0;
#pragma unroll 1
      for (int q8 = 0; q8 < 8; q8++) {
        float x[8];
#pragma unroll
        for (int k = 0; k < 8; k++) x[k] = stage[(q8 * 8 + k) * SROW + lane];
        *(uint4*)(dp + q8 * 8) = make_uint4(pack2(x[0], x[1]), pack2(x[2], x[3]), pack2(x[4], x[5]), pack2(x[6], x[7]));
      }
    } else if (nb >= 1344 && nb < 2880) {
      u16* dst; int ld, cb;
      if (nb < 1856) { dst = (u16*)(ws + OFF_Z); ld = 512; cb = nb - 1344; }
      else { dst = (u16*)(ws + OFF_XBC); ld = 1024; cb = nb - 1856; }
      const int cg = lane & 1;
#pragma unroll 1
      for (int i = 0; i < 2; i++) {
        const int row = (lane >> 1) + 32 * i; const int t = tb + row;
        float x1[16], x2[16];
        ld16(stage + row * SROW + cg * 16, x1); ld16(stage + row * SROW + 32 + cg * 16, x2);
        st16_bf(dst + (size_t)t * ld + cb + cg * 16, x1); st16_bf(dst + (size_t)t * ld + cb + 32 + cg * 16, x2);
      }
    } else if (nb == 2880) {
      float* wi = (float*)(ws + OFF_WI); float* dtr = (float*)(ws + OFF_DT);
      const int t = tb + lane;
      float x[16];
      ld16(stage + lane * SROW, x);
      const float sc = 0.044194173824159216f;
      *(float4*)(wi + (size_t)t * 8) = make_float4(x[0] * sc, x[1] * sc, x[2] * sc, x[3] * sc);
      *(float4*)(wi + (size_t)t * 8 + 4) = make_float4(x[4] * sc, x[5] * sc, x[6] * sc, x[7] * sc);
      *(float4*)(dtr + (size_t)t * 8) = make_float4(x[8], x[9], x[10], x[11]);
      *(float4*)(dtr + (size_t)t * 8 + 4) = make_float4(x[12], x[13], x[14], x[15]);
    }
  }
};

struct EpiStoreF32 {
  float* dst; int n0;
  DEV void apply(const float* stage, int rbase, int cbase, int lane) {
    const int cg = lane & 1;
#pragma unroll 1
    for (int i = 0; i < 2; i++) {
      const int row = (lane >> 1) + 32 * i;
      float x1[16], x2[16];
      ld16(stage + row * G_SROW + cg * 16, x1); ld16(stage + row * G_SROW + 32 + cg * 16, x2);
      float* d = dst + (size_t)(rbase + row) * 1024 + n0 + cbase + cg * 16;
      st16_f(d, x1); st16_f(d + 32, x2);
    }
  }
};
struct EpiStoreBf16 {
  u16* dst; int n0;
  DEV void apply(const float* stage, int rbase, int cbase, int lane) {
    const int cg = lane & 1;
#pragma unroll 1
    for (int i = 0; i < 2; i++) {
      const int row = (lane >> 1) + 32 * i;
      float x1[16], x2[16];
      ld16(stage + row * G_SROW + cg * 16, x1); ld16(stage + row * G_SROW + 32 + cg * 16, x2);
      u16* d = dst + (size_t)(rbase + row) * 1024 + n0 + cbase + cg * 16;
      st16_bf(d, x1); st16_bf(d + 32, x2);
    }
  }
};

typedef __attribute__((ext_vector_type(4))) float f32x4v;
constexpr int P8_HT = 128 * 64;
constexpr int P8_SROW = 260;
DEV int p8_lds_byte(int r, int c) {
  const int st = (r >> 4) * 2 + (c >> 5), rr = r & 15, cc = c & 31, ob = rr * 64 + cc * 2;
  return st * 1024 + (ob ^ (((ob >> 9) & 1) << 5));
}
DEV void p8_stage_rc(int b, int& R, int& C) {
  const int st = b / 1024, sb = b % 1024, swz = sb ^ (((sb >> 9) & 1) << 5);
  R = (st >> 1) * 16 + swz / 64; C = (st & 1) * 32 + (swz % 64) / 2;
}
template <class Epi>
DEV void gemm256_8phase(const u16* __restrict__ A, const u16* __restrict__ Bt, int brow, int bcol, char* smem, Epi& epi) {
  constexpr int K = 1024, BK = 64, HALF = 128;
  u16* shm = (u16*)smem;
  const int tid = opaque_tid();
#define SA(b,h) (shm+((b)*2+(h))*P8_HT)
#define SB(b,h) (shm+(4+(b)*2+(h))*P8_HT)
#define P8STAGE(P,BASE,br,kt) do{ const long _g=(long)(br)*K+(long)(kt)*BK; \
    _Pragma("unroll") for(int _i=0;_i<2;++_i){ const int _b=tid*16+_i*8192; int _r,_c; p8_stage_rc(_b,_r,_c); \
      __builtin_amdgcn_global_load_lds((const unsigned*)(BASE+_g+(long)_r*K+_c), (__attribute__((address_space(3))) unsigned*)((char*)(P)+_b),16,0,0);} }while(0)
#define LDA(dst,b,h) _Pragma("unroll") for(int m=0;m<4;++m) _Pragma("unroll") for(int k=0;k<2;++k) \
    dst[m][k]=*reinterpret_cast<const bf16x8*>((char*)SA(b,h)+p8_lds_byte(wr*64+m*16+fr,k*32+fq*8))
#define LDB(dst,b,h) _Pragma("unroll") for(int n=0;n<2;++n) _Pragma("unroll") for(int k=0;k<2;++k) \
    dst[n][k]=*reinterpret_cast<const bf16x8*>((char*)SB(b,h)+p8_lds_byte(wc*32+n*16+fr,k*32+fq*8))
#define MMA(ai,bj,At,Bt_) do{ __builtin_amdgcn_s_setprio(1); \
    _Pragma("unroll") for(int m=0;m<4;++m) _Pragma("unroll") for(int n=0;n<2;++n) _Pragma("unroll") for(int k=0;k<2;++k) \
      acc[ai][bj][m][n]=__builtin_amdgcn_mfma_f32_16x16x32_bf16(At[m][k],Bt_[n][k],acc[ai][bj][m][n],0,0,0); \
    __builtin_amdgcn_s_setprio(0);}while(0)
#define WAIT_V(n) asm volatile("s_waitcnt vmcnt(" #n ")":::"memory")
#define WAIT_L(n) asm volatile("s_waitcnt lgkmcnt(" #n ")":::"memory")
#define BAR __builtin_amdgcn_s_barrier()
#define SCHED __builtin_amdgcn_sched_barrier(0)
  const int wid = __builtin_amdgcn_readfirstlane(tid >> 6), lane = tid & 63, wr = wid >> 2, wc = wid & 3, fr = lane & 15, fq = lane >> 4;
  f32x4v acc[2][2][4][2];
#pragma unroll
  for (int a_ = 0; a_ < 2; a_++)
#pragma unroll
    for (int b_ = 0; b_ < 2; b_++)
#pragma unroll
      for (int m = 0; m < 4; m++)
#pragma unroll
        for (int n = 0; n < 2; n++) acc[a_][b_][m][n] = (f32x4v){0.f, 0.f, 0.f, 0.f};
  bf16x8 At[4][2], B0[2][2], B1[2][2];
  constexpr int nt = K / BK;
  asm volatile("s_waitcnt vmcnt(0) lgkmcnt(0)" ::: "memory");
  __syncthreads();
  P8STAGE(SB(0,0),Bt,bcol,0); P8STAGE(SA(0,0),A,brow,0);
  P8STAGE(SB(0,1),Bt,bcol+HALF,0); P8STAGE(SA(0,1),A,brow+HALF,0);
  if(wr==1)BAR;
  WAIT_V(4); BAR;
  P8STAGE(SB(1,0),Bt,bcol,1); P8STAGE(SA(1,0),A,brow,1); P8STAGE(SB(1,1),Bt,bcol+HALF,1);
  WAIT_V(6); BAR;
#pragma unroll 1
  for(int t=0;t<nt-2;t+=2){
    LDB(B0,0,0); SCHED; LDA(At,0,0); P8STAGE(SA(1,1),A,brow+HALF,t+1);
    WAIT_L(8); BAR; WAIT_L(0); MMA(0,0,At,B0); BAR; SCHED;
    LDB(B1,0,1); P8STAGE(SB(0,0),Bt,bcol,t+2);
    BAR; WAIT_L(0); MMA(0,1,At,B1); BAR;
    LDA(At,0,1); P8STAGE(SA(0,0),A,brow,t+2);
    BAR; WAIT_L(0); MMA(1,0,At,B0); BAR; SCHED;
    P8STAGE(SB(0,1),Bt,bcol+HALF,t+2);
    WAIT_V(6); BAR; MMA(1,1,At,B1); BAR;
    LDB(B0,1,0); SCHED; LDA(At,1,0); P8STAGE(SA(0,1),A,brow+HALF,t+2);
    WAIT_L(8); BAR; WAIT_L(0); MMA(0,0,At,B0); BAR; SCHED;
    LDB(B1,1,1); P8STAGE(SB(1,0),Bt,bcol,t+3);
    BAR; WAIT_L(0); MMA(0,1,At,B1); BAR;
    LDA(At,1,1); P8STAGE(SA(1,0),A,brow,t+3);
    BAR; WAIT_L(0); MMA(1,0,At,B0); BAR; SCHED;
    P8STAGE(SB(1,1),Bt,bcol+HALF,t+3);
    WAIT_V(6); BAR; MMA(1,1,At,B1); BAR;
  }
  { LDB(B0,0,0); LDA(At,0,0); P8STAGE(SA(1,1),A,brow+HALF,nt-1);
    BAR; WAIT_L(0); MMA(0,0,At,B0); BAR;
    LDB(B1,0,1); BAR; WAIT_L(0); MMA(0,1,At,B1); BAR;
    LDA(At,0,1); WAIT_V(4); BAR; WAIT_L(0); MMA(1,0,At,B0); MMA(1,1,At,B1); BAR; }
  { LDB(B0,1,0); LDA(At,1,0); WAIT_V(2); BAR; WAIT_L(0); MMA(0,0,At,B0); BAR;
    LDB(B1,1,1); WAIT_V(0); BAR; WAIT_L(0); MMA(0,1,At,B1); BAR;
    LDA(At,1,1); BAR; WAIT_L(0); MMA(1,0,At,B0); MMA(1,1,At,B1); BAR; }
  if(wr==0)BAR;
  float* img = (float*)smem;
#pragma unroll
  for (int ai = 0; ai < 2; ai++) {
    __syncthreads();
#pragma unroll
    for (int bj = 0; bj < 2; bj++)
#pragma unroll
      for (int m = 0; m < 4; m++)
#pragma unroll
        for (int n = 0; n < 2; n++)
#pragma unroll
          for (int j = 0; j < 4; j++)
            img[(wr * 64 + m * 16 + fq * 4 + j) * P8_SROW + bj * HALF + wc * 32 + n * 16 + fr] = acc[ai][bj][m][n][j];
    __syncthreads();
    epi.template apply_s<P8_SROW>(img + (wid >> 2) * 64 * P8_SROW + (wid & 3) * 64, ai * 128 + (wid >> 2) * 64, (wid & 3) * 64, lane);
  }
  __syncthreads();
#undef SA
#undef SB
#undef P8STAGE
#undef LDA
#undef LDB
#undef MMA
#undef WAIT_V
#undef WAIT_L
#undef BAR
#undef SCHED
}

DEV void phase1(const Params& p, char* smem) {
  const u16* h = (const u16*)(p.ws + OFF_HBUF);
  const u16* wt = (const u16*)(p.ws + OFF_WTIN);
  if (blockIdx.x & 1) convert_i8_rows(p.peer_u, p.ws + OFF_U, (float*)(p.ws + OFF_SU));
  const int ntiles = 128 * 12;
  for (int tile = blockIdx.x; tile < ntiles; tile += gridDim.x) {
    const int mt = tile % 128, nt = tile / 128;
    EpiInProj epi{&p, mt * 256, nt * 256};
    gemm256_8phase(h, wt, mt * 256, nt * 256, smem, epi);
  }
  if (!(blockIdx.x & 1)) convert_i8_rows(p.peer_u, p.ws + OFF_U, (float*)(p.ws + OFF_SU));
}

constexpr int DS_QROW = 1040;
constexpr int DS_CNT = 32 * DS_QROW;
constexpr int DS_MASK = DS_CNT + 2 * 8 * 32 * 4;
constexpr int DS_WQ = DS_MASK + 64 * 64 * 2;
constexpr int DS_KV = DS_WQ + 1024;
constexpr int DS_KVSTAGE = 2 * 32 * 144 + 2 * 64 * 72;
constexpr int DS_VOFF = 2 * 32 * 144;

DEV int dsa_reduce(int c, unsigned* cbuf, int& par, int r, int hh, int w) {
  c += __shfl_xor(c, 32);
  unsigned* bq = cbuf + par * 256;
  if (hh == 0) bq[w * 32 + r] = (unsigned)c;
  __syncthreads();
  int tot = 0;
#pragma unroll
  for (int k = 0; k < 8; k++) tot += (int)bq[k * 32 + r];
  par ^= 1;
  return tot;
}

DEV void dsa_item(const Params& p, int b, int qt, char* smem) {
  const int tid = opaque_tid(), lane = tid & 63, w = __builtin_amdgcn_readfirstlane(tid >> 6), r = lane & 31, hh = lane >> 5;
  const int q0 = qt * 32; const size_t tb = (size_t)b * 2048;
  const u16* qi = (const u16*)(p.ws + OFF_QI);
  const u16* ki = (const u16*)(p.ws + OFF_KI);
  const float* wi = (const float*)(p.ws + OFF_WI);
  unsigned* cbuf = (unsigned*)(smem + DS_CNT);
  u16* maskb = (u16*)(smem + DS_MASK);
  const bool need_sel = (qt >= 8);
  __syncthreads();
  if (need_sel) {
#pragma unroll
    for (int i = 0; i < 4; i++) {
      int c = tid + i * 512; int row = c >> 6, cc = c & 63;
      *(uint4*)(smem + row * DS_QROW + cc * 16) = *(const uint4*)(qi + (tb + q0 + row) * 512 + cc * 8);
    }
    if (tid < 256) ((float*)(smem + DS_WQ))[tid] = wi[(tb + q0) * 8 + tid];
  }
  __syncthreads();
  if (need_sel) {
    const float* wql = (const float*)(smem + DS_WQ) + r * 8;
    u32x16 uk[8];
#pragma unroll
    for (int i = 0; i < 8; i++) {
      const int kt = w + 8 * i;
      if (kt <= qt) {
        const u16* kp = ki + (tb + kt * 32 + r) * 64 + hh * 8;
        bf16x8 ka[4];
#pragma unroll
        for (int s = 0; s < 4; s++) ka[s] = *(const bf16x8*)(kp + s * 16);
        f32x16 scr = zero16();
#pragma unroll 2
        for (int h8 = 0; h8 < 8; h8++) {
          f32x16 a = zero16();
          const char* qrow = smem + r * DS_QROW + h8 * 128 + hh * 16;
#pragma unroll
          for (int s = 0; s < 4; s++) {
            const bf16x8 qb = *(const bf16x8*)(qrow + s * 32);
            a = mfma32(ka[s], qb, a);
          }
          const float wv = wql[h8];
#pragma unroll
          for (int reg = 0; reg < 16; reg++) scr[reg] = fmaf(wv, fmaxf(a[reg], 0.f), scr[reg]);
        }
#pragma unroll
        for (int reg = 0; reg < 16; reg++) {
          float v = scr[reg];
          if (kt == qt && ((reg & 3) + 8 * (reg >> 2)) > r - 4 * hh) v = NEG_INF;
          uk[i][reg] = ordkey(v);
        }
      } else {
#pragma unroll
        for (int reg = 0; reg < 16; reg++) uk[i][reg] = 0u;
      }
    }
    int par = 0;
    unsigned T = 0u;
    unsigned* lst = (unsigned*)(smem + DS_KV);
    unsigned* lcnt = (unsigned*)(smem + DS_KV + 16384);
    unsigned* lhic = lcnt + 32;
    unsigned* ltp = lcnt + 64;
    for (int rep_b = 0; rep_b < PROBE_DSA_BIS; rep_b++) {
    T = 0u;
    if (tid < 32) lcnt[tid] = 0u;
    for (int it = 0; it < 12; ++it) {
      const unsigned cand = T | (0x80000000u >> it);
      int c = 0;
#pragma unroll
      for (int i = 0; i < 8; i++) {
        if (w + 8 * i <= qt) {
#pragma unroll
          for (int reg = 0; reg < 16; reg++) c += (uk[i][reg] >= cand) ? 1 : 0;
        }
      }
      if (dsa_reduce(c, cbuf, par, r, hh, w) >= 256) T = cand;
    }
    int hic;
    {
      const bool ovf = (T >= 0xFFF00000u);
      const unsigned hi = T + 0x00100000u;
      int c = 0;
      if (!ovf) {
#pragma unroll
        for (int i = 0; i < 8; i++) {
          if (w + 8 * i <= qt) {
#pragma unroll
            for (int reg = 0; reg < 16; reg++) c += (uk[i][reg] >= hi) ? 1 : 0;
          }
        }
      }
      hic = dsa_reduce(c, cbuf, par, r, hh, w);
    }
#pragma unroll
    for (int i = 0; i < 8; i++) {
      if (w + 8 * i <= qt) {
#pragma unroll
        for (int reg = 0; reg < 16; reg++) {
          const unsigned d = uk[i][reg] - T;
          if (d < 0x00100000u) { const unsigned pos = atomicAdd(&lcnt[r], 1u); if (pos < 128u) lst[r * 128 + pos] = d; }
        }
      }
    }
    if (w == 0 && hh == 0) { lhic[r] = (unsigned)hic; ltp[r] = T; }
    __syncthreads();
    if (!__syncthreads_or(lcnt[r] > 128u)) {
      const int qsub = lane >> 4, l16 = lane & 15, q = 4 * w + qsub;
      const int n = (int)lcnt[q];
      const int kp = 256 - (int)lhic[q];
      unsigned v[8];
#pragma unroll
      for (int j = 0; j < 8; j++) { const int ix = l16 + 16 * j; v[j] = (ix < n) ? lst[q * 128 + ix] : 0u; }
      unsigned Tl = 0u;
#pragma unroll 1
      for (int bit = 19; bit >= 0; --bit) {
        const unsigned cand = Tl | (1u << bit);
        int c = 0;
#pragma unroll
        for (int j = 0; j < 8; j++) c += (v[j] >= cand) ? 1 : 0;
        c += __builtin_amdgcn_update_dpp(0, c, 0xB1, 0xF, 0xF, false);
        c += __builtin_amdgcn_update_dpp(0, c, 0x4E, 0xF, 0xF, false);
        c += __builtin_amdgcn_update_dpp(0, c, 0x141, 0xF, 0xF, false);
        c += __builtin_amdgcn_update_dpp(0, c, 0x140, 0xF, 0xF, false);
        if (c >= kp) Tl = cand;
      }
      const unsigned tq = ltp[q] | Tl;
      __syncthreads();
      if (l16 == 0) ltp[q] = tq;
      __syncthreads();
      T = ltp[r];
    } else {
      for (int it = 12; it < 32; ++it) {
        const unsigned cand = T | (0x80000000u >> it);
        int c = 0;
#pragma unroll
        for (int i = 0; i < 8; i++) {
          if (w + 8 * i <= qt) {
#pragma unroll
            for (int reg = 0; reg < 16; reg++) c += (uk[i][reg] >= cand) ? 1 : 0;
          }
        }
        if (dsa_reduce(c, cbuf, par, r, hh, w) >= 256) T = cand;
      }
    }
    }
    int cge;
    {
      int c = 0;
      unsigned Tv = T;
      asm volatile("" : "+v"(Tv));
#pragma unroll
      for (int i = 0; i < 8; i++) {
        if (w + 8 * i <= qt) {
#pragma unroll
          for (int reg = 0; reg < 16; reg++) c += (uk[i][reg] >= Tv) ? 1 : 0;
        }
      }
      cge = dsa_reduce(c, cbuf, par, r, hh, w);
    }
    unsigned J = 4095u;
    if (__syncthreads_or(cge != 256)) {
      int need;
      {
        int c = 0;
        unsigned Tv = T;
        asm volatile("" : "+v"(Tv));
#pragma unroll
        for (int i = 0; i < 8; i++) {
          if (w + 8 * i <= qt) {
#pragma unroll
            for (int reg = 0; reg < 16; reg++) c += (uk[i][reg] > Tv) ? 1 : 0;
          }
        }
        need = 256 - dsa_reduce(c, cbuf, par, r, hh, w);
      }
      J = 0u;
      for (int it = 0; it < 12; ++it) {
        const unsigned cj = J | (2048u >> it);
        int c = 0;
        unsigned Tv = T;
        asm volatile("" : "+v"(Tv));
#pragma unroll
        for (int i = 0; i < 8; i++) {
          if (w + 8 * i <= qt) {
            const int lim = (int)cj - ((w + 8 * i) * 32 + 4 * hh);
#pragma unroll
            for (int reg = 0; reg < 16; reg++) c += (uk[i][reg] == Tv && ((reg & 3) + 8 * (reg >> 2)) < lim) ? 1 : 0;
          }
        }
        if (dsa_reduce(c, cbuf, par, r, hh, w) <= need) J = cj;
      }
    }
#pragma unroll
    for (int i = 0; i < 8; i++) {
      const int kt = w + 8 * i;
      if (kt <= qt) {
        const int lim = (int)J - (kt * 32 + 4 * hh);
        unsigned bits = 0u;
#pragma unroll
        for (int reg = 0; reg < 16; reg++) {
          const unsigned u = uk[i][reg];
          const bool sel = (u > T) || (u == T && ((reg & 3) + 8 * (reg >> 2)) < lim);
          bits |= (sel ? 1u : 0u) << reg;
        }
        maskb[kt * 64 + lane] = (u16)bits;
      }
    }
  } else {
#pragma unroll
    for (int i = 0; i < 8; i++) {
      const int kt = w + 8 * i;
      if (kt <= qt) {
        unsigned bits = 0xFFFFu;
        if (kt == qt) {
          bits = 0u;
#pragma unroll
          for (int reg = 0; reg < 16; reg++) bits |= ((((reg & 3) + 8 * (reg >> 2)) <= r - 4 * hh) ? 1u : 0u) << reg;
        }
        maskb[kt * 64 + lane] = (u16)bits;
      }
    }
  }
  for (int rep_a = 0; rep_a < PROBE_DSA_ATT; rep_a++)
  {
    const int head = w, kvh = w >> 2;
    const u16* q = (const u16*)(p.ws + OFF_Q);
    const u16* kk = (const u16*)(p.ws + OFF_K);
    const u16* vt = (const u16*)(p.ws + OFF_VT);
    bf16x8 qf[4];
    {
      const u16* qp = q + (tb + q0 + r) * 512 + head * 64 + hh * 8;
#pragma unroll
      for (int s = 0; s < 4; s++) qf[s] = *(const bf16x8*)(qp + s * 16);
    }
    const int l_kvh = tid >> 8;
    const int k_row = (tid >> 3) & 31, k_ch = tid & 7;
    const int v_d = (tid >> 2) & 63, v_ch = tid & 3;
    const u16* gk = kk + (tb + k_row) * 128 + l_kvh * 64 + k_ch * 8;
    const u16* gv = vt + ((size_t)(b * 2 + l_kvh) * 64 + v_d) * SV_ + v_ch * 8;
    const int lk = DS_KV + l_kvh * (32 * 144) + k_row * 144 + k_ch * 16;
    const int lv = DS_KV + DS_VOFF + l_kvh * (64 * 72) + v_d * 72 + v_ch * 16;
    const int fk = DS_KV + kvh * (32 * 144) + r * 144 + hh * 16;
    const int fv = DS_KV + DS_VOFF + kvh * (64 * 72) + r * 72 + hh * 8;
    const int nsteps = (qt + 3) / 3;
    uint4 rkA, rvA, rkB, rvB, rkC, rvC;
#define AT_LOAD(j_) { const int ka_ = 3 * (j_), kb_ = (ka_ + 1 <= qt) ? ka_ + 1 : qt, kc_ = (ka_ + 2 <= qt) ? ka_ + 2 : qt; \
      rkA = *(const uint4*)(gk + (size_t)ka_ * 32 * 128); rvA = *(const uint4*)(gv + ka_ * 32); \
      rkB = *(const uint4*)(gk + (size_t)kb_ * 32 * 128); rvB = *(const uint4*)(gv + kb_ * 32); \
      rkC = *(const uint4*)(gk + (size_t)kc_ * 32 * 128); rvC = *(const uint4*)(gv + kc_ * 32); }
#define AT_ST1(d_, rk_, rv_) { *(uint4*)((d_) + lk) = rk_; *(uint2*)((d_) + lv) = make_uint2(rv_.x, rv_.y); *(uint2*)((d_) + lv + 8) = make_uint2(rv_.z, rv_.w); }
#define AT_STORE(sb_) { char* d_ = smem + (sb_) * (3 * DS_KVSTAGE); AT_ST1(d_, rkA, rvA); AT_ST1(d_ + DS_KVSTAGE, rkB, rvB); AT_ST1(d_ + 2 * DS_KVSTAGE, rkC, rvC); }
    AT_LOAD(0);
    __syncthreads();
    AT_STORE(0);
    __syncthreads();
    f32x16 o0 = zero16(), o1 = zero16();
    float m = NEG_INF, l = 0.f;
    const float SC = 0.125f * 1.4426950408889634f;
    for (int j = 0; j < nsteps; ++j) {
      const char* stg = smem + (j & 1) * (3 * DS_KVSTAGE);
      if (j + 1 < nsteps) AT_LOAD(j + 1);
      f32x16 sa = zero16(), sb = zero16(), sc = zero16();
#pragma unroll
      for (int s = 0; s < 4; s++) {
        const bf16x8 kfa = *(const bf16x8*)(stg + fk + s * 32);
        const bf16x8 kfb = *(const bf16x8*)(stg + DS_KVSTAGE + fk + s * 32);
        const bf16x8 kfc = *(const bf16x8*)(stg + 2 * DS_KVSTAGE + fk + s * 32);
        sa = mfma32(kfa, qf[s], sa); sb = mfma32(kfb, qf[s], sb); sc = mfma32(kfc, qf[s], sc);
      }
      const int kt0 = 3 * j;
      const unsigned bitsA = maskb[kt0 * 64 + lane];
      const unsigned bitsB = (kt0 + 1 <= qt) ? (unsigned)maskb[(kt0 + 1) * 64 + lane] : 0u;
      const unsigned bitsC = (kt0 + 2 <= qt) ? (unsigned)maskb[(kt0 + 2) * 64 + lane] : 0u;
#pragma unroll
      for (int reg = 0; reg < 16; reg++) {
        sa[reg] = ((bitsA >> reg) & 1u) ? sa[reg] : NEG_INF; sb[reg] = ((bitsB >> reg) & 1u) ? sb[reg] : NEG_INF; sc[reg] = ((bitsC >> reg) & 1u) ? sc[reg] : NEG_INF;
      }
      float tmax = fmaxf(fmaxf(sa[0], sb[0]), sc[0]);
#pragma unroll
      for (int reg = 1; reg < 16; reg++) tmax = fmaxf(tmax, fmaxf(fmaxf(sa[reg], sb[reg]), sc[reg]));
      tmax = fmaxf(tmax, __shfl_xor(tmax, 32));
      const float mn = fmaxf(m, tmax);
      const float ms = (mn == NEG_INF) ? 0.f : mn;
      const float nmsc = -ms * SC;
      float ps = 0.f, ps2 = 0.f, ps3 = 0.f;
#pragma unroll
      for (int reg = 0; reg < 16; reg++) {
        const float pa = __builtin_amdgcn_exp2f(fmaf(sa[reg], SC, nmsc)), pb = __builtin_amdgcn_exp2f(fmaf(sb[reg], SC, nmsc)), pc = __builtin_amdgcn_exp2f(fmaf(sc[reg], SC, nmsc));
        sa[reg] = pa; sb[reg] = pb; sc[reg] = pc; ps += pa; ps2 += pb; ps3 += pc;
      }
      if (__any(mn != m)) {
        const float alpha = __builtin_amdgcn_exp2f(fmaf(m, SC, nmsc));
        l *= alpha;
#pragma unroll
        for (int reg = 0; reg < 16; reg++) { o0[reg] *= alpha; o1[reg] *= alpha; }
      }
      l += (ps + ps2) + ps3; m = mn;
#define AT_PV(P_, OFF_) { const bf16x8 pf0 = pack_frag(P_, 0), pf1 = pack_frag(P_, 8); const char* vb = stg + (OFF_) + fv; \
        const bf16x8 v00 = mk_frag(*(const uint2*)(vb), *(const uint2*)(vb + 16)); const bf16x8 v01 = mk_frag(*(const uint2*)(vb + 32), *(const uint2*)(vb + 48)); \
        const bf16x8 v10 = mk_frag(*(const uint2*)(vb + 32 * 72), *(const uint2*)(vb + 32 * 72 + 16)); const bf16x8 v11 = mk_frag(*(const uint2*)(vb + 32 * 72 + 32), *(const uint2*)(vb + 32 * 72 + 48)); \
        o0 = mfma32(v00, pf0, o0); o1 = mfma32(v10, pf0, o1); o0 = mfma32(v01, pf1, o0); o1 = mfma32(v11, pf1, o1); }
      AT_PV(sa, 0); AT_PV(sb, DS_KVSTAGE); AT_PV(sc, 2 * DS_KVSTAGE);
#undef AT_PV
      if (j + 1 < nsteps) AT_STORE((j + 1) & 1);
      __syncthreads();
    }
#undef AT_LOAD
#undef AT_ST1
#undef AT_STORE
    const float lt = l + __shfl_xor(l, 32);
    const float inv = 1.f / lt;
    u16* cat = (u16*)(p.ws + OFF_HBUF);
    u16* op = cat + (tb + q0 + r) * 1024 + head * 64 + 4 * hh;
#pragma unroll
    for (int gq = 0; gq < 4; gq++) {
      *(uint2*)(op + 8 * gq) = make_uint2(pack2(o0[4 * gq] * inv, o0[4 * gq + 1] * inv), pack2(o0[4 * gq + 2] * inv, o0[4 * gq + 3] * inv));
      *(uint2*)(op + 32 + 8 * gq) = make_uint2(pack2(o1[4 * gq] * inv, o1[4 * gq + 1] * inv), pack2(o1[4 * gq + 2] * inv, o1[4 * gq + 3] * inv));
    }
  }
}

constexpr int SA_ROW = 272;
constexpr int SA_XROW = 144;
constexpr int SA_C = 0, SA_B = 128 * SA_ROW;
constexpr int SA_XDT = 2 * 128 * SA_ROW;
constexpr int SA_XDS = SA_XDT + 128 * SA_XROW;
constexpr int SA_FL = SA_XDS + 128 * SA_XROW;

DEV float silu_fast(float v) { return v * __builtin_amdgcn_rcpf(1.f + __builtin_amdgcn_exp2f(-1.4426950408889634f * v)); }

DEV void conv_pair8(const u16* __restrict__ xbc, const float* __restrict__ cw, const float* __restrict__ cbias, size_t tb, int pos0, int ch, float* o0, float* o1) {
  const float2 w0 = *(const float2*)(cw + ch), w1 = *(const float2*)(cw + 1024 + ch), w2 = *(const float2*)(cw + 2048 + ch), w3 = *(const float2*)(cw + 3072 + ch);
  const float2 bs = *(const float2*)(cbias + ch);
  unsigned xr[11];
#pragma unroll
  for (int j = 0; j < 11; j++) { const int sp = pos0 - 3 + j; xr[j] = (sp >= 0) ? *(const unsigned*)(xbc + (tb + sp) * 1024 + ch) : 0u; }
#pragma unroll
  for (int j = 0; j < 8; j++) {
    float a = bs.x, c = bs.y;
    a = fmaf(w0.x, bflo(xr[j]), a); c = fmaf(w0.y, bfhi(xr[j]), c);
    a = fmaf(w1.x, bflo(xr[j + 1]), a); c = fmaf(w1.y, bfhi(xr[j + 1]), c);
    a = fmaf(w2.x, bflo(xr[j + 2]), a); c = fmaf(w2.y, bfhi(xr[j + 2]), c);
    a = fmaf(w3.x, bflo(xr[j + 3]), a); c = fmaf(w3.y, bfhi(xr[j + 3]), c);
    o0[j] = silu_fast(a); o1[j] = silu_fast(c);
  }
}

DEV bf16x8 gather8(const char* base, int stride, bool perm) {
  unsigned v[8];
#pragma unroll
  for (int j = 0; j < 8; j++) { const int row = perm ? ((j & 3) + 8 * (j >> 2)) : j; v[j] = *(const u16*)(base + row * stride); }
  union { uint4 u; bf16x8 f; } t;
  t.u = make_uint4(v[0] | (v[1] << 16), v[2] | (v[3] << 16), v[4] | (v[5] << 16), v[6] | (v[7] << 16));
  return t.f;
}

DEV void ssdA_item(const Params& p, int b, int c, int g, char* smem) {
  const int tid = opaque_tid(), lane = tid & 63, w = __builtin_amdgcn_readfirstlane(tid >> 6), r = lane & 31, hh = lane >> 5;
  const size_t tb = (size_t)b * 2048;
  const u16* xbc = (const u16*)(p.ws + OFF_XBC);
  const float* dtraw = (const float*)(p.ws + OFF_DT);
  __syncthreads();
  {
    u16* ccg = (u16*)(p.ws + OFF_CC);
#pragma unroll 1
    for (int k = 0; k < 4; k++) {
      const int e = tid + k * 512;
      const int pr = e & 63, lb = (e >> 6) & 15, which = e >> 10;
      const int n = 2 * pr, l0 = lb * 8;
      float o0[8], o1[8];
      conv_pair8(xbc, p.conv_w, p.conv_b, tb, c * 128 + l0, 512 + which * 256 + g * 128 + n, o0, o1);
      char* dst = smem + (which ? SA_C : SA_B) + l0 * SA_ROW + n * 2;
#pragma unroll
      for (int j = 0; j < 8; j++) {
        const unsigned pk = pack2(o0[j], o1[j]);
        *(unsigned*)(dst + j * SA_ROW) = pk;
        if (which) *(unsigned*)(ccg + (tb + c * 128 + l0 + j) * 256 + g * 128 + n) = pk;
      }
    }
  }
  if (w < 4) {
    const int h = g * 4 + w;
    float* dtv_ = (float*)(smem + SA_FL) + w * 384; float* acum_ = dtv_ + 128; float* decs_ = dtv_ + 256;
    {
      const float A = -expf(p.a_log[h]);
      const float bias = p.dt_bias[h];
      float x0 = dtraw[(tb + c * 128 + lane) * 8 + h] + bias;
      float x1 = dtraw[(tb + c * 128 + 64 + lane) * 8 + h] + bias;
      float d0 = (x0 > 20.f) ? x0 : log1pf(expf(x0));
      float d1 = (x1 > 20.f) ? x1 : log1pf(expf(x1));
      dtv_[lane] = d0; dtv_[64 + lane] = d1;
      float v0 = d0 * A, v1 = d1 * A;
#pragma unroll
      for (int o = 1; o < 64; o <<= 1) { float n0 = __shfl_up(v0, o), n1 = __shfl_up(v1, o); if (lane >= o) { v0 += n0; v1 += n1; } }
      const float tot0 = __shfl(v0, 63);
      v1 += tot0;
      acum_[lane] = v0; acum_[64 + lane] = v1;
      const float atot = __shfl(v1, 63);
      decs_[lane] = expf(atot - v0); decs_[64 + lane] = expf(atot - v1);
    }
  }
#pragma unroll 1
  for (int h4 = 0; h4 < 4; h4++) {
    const int h = g * 4 + h4;
    float* dtv = (float*)(smem + SA_FL) + h4 * 384; float* acum = dtv + 128; float* decs = dtv + 256;
    __syncthreads();
    {
      const int pr = tid & 31, lb = tid >> 5;
      const int pp = 2 * pr, l0 = lb * 8;
      float o0[8], o1[8];
      conv_pair8(xbc, p.conv_w, p.conv_b, tb, c * 128 + l0, h * 64 + pp, o0, o1);
#pragma unroll
      for (int j = 0; j < 8; j++) {
        const float d = dtv[l0 + j], ds = decs[l0 + j];
        const float a0 = o0[j] * d, a1 = o1[j] * d;
        *(unsigned*)(smem + SA_XDT + (l0 + j) * SA_XROW + pp * 2) = pack2(a0, a1);
        *(unsigned*)(smem + SA_XDS + (l0 + j) * SA_XROW + pp * 2) = pack2(a0 * ds, a1 * ds);
      }
    }
    __syncthreads();
    {
      const int pt = w & 1, lt = w >> 1;
      const int lidx = lt * 32 + r;
      const float acl = acum[lidx];
      f32x16 yT = zero16();
      for (int st = 0; st <= lt; ++st) {
        f32x16 cb = zero16();
#pragma unroll
        for (int ks = 0; ks < 8; ks++) {
          const bf16x8 a = *(const bf16x8*)(smem + SA_B + (st * 32 + r) * SA_ROW + ks * 32 + hh * 16);
          const bf16x8 bq = *(const bf16x8*)(smem + SA_C + (lt * 32 + r) * SA_ROW + ks * 32 + hh * 16);
          cb = mfma32(a, bq, cb);
        }
#pragma unroll
        for (int reg = 0; reg < 16; reg++) {
          const int sidx = st * 32 + rowmap(reg, hh);
          const float as = acum[sidx];
          cb[reg] = (sidx <= lidx) ? cb[reg] * __builtin_amdgcn_exp2f((acl - as) * 1.4426950408889634f) : 0.f;
        }
        const bf16x8 mf0 = pack_frag(cb, 0), mf1 = pack_frag(cb, 8);
        const char* xb = smem + SA_XDT + (st * 32 + 4 * hh) * SA_XROW + (pt * 32 + r) * 2;
        const bf16x8 x0 = gather8(xb, SA_XROW, true);
        const bf16x8 x1 = gather8(xb + 16 * SA_XROW, SA_XROW, true);
        yT = mfma32(x0, mf0, yT); yT = mfma32(x1, mf1, yT);
      }
      const float dsk = p.d_skip[h] / dtv[lidx];
      float* yp = (float*)(p.ws + OFF_YP) + (tb + c * 128 + lidx) * 512 + h * 64 + pt * 32 + 4 * hh;
#pragma unroll
      for (int gq = 0; gq < 4; gq++) {
        const uint2 xv = *(const uint2*)(smem + SA_XDT + lidx * SA_XROW + (pt * 32 + 8 * gq + 4 * hh) * 2);
        *(float4*)(yp + 8 * gq) = make_float4(yT[4 * gq] + dsk * bflo(xv.x), yT[4 * gq + 1] + dsk * bfhi(xv.x), yT[4 * gq + 2] + dsk * bflo(xv.y), yT[4 * gq + 3] + dsk * bfhi(xv.y));
      }
      const int nt = w >> 1;
      f32x16 sacc = zero16();
#pragma unroll
      for (int ks = 0; ks < 8; ks++) {
        const bf16x8 a = gather8(smem + SA_XDS + (ks * 16 + hh * 8) * SA_XROW + (pt * 32 + r) * 2, SA_XROW, false);
        const bf16x8 bq = gather8(smem + SA_B + (ks * 16 + hh * 8) * SA_ROW + (nt * 32 + r) * 2, SA_ROW, false);
        sacc = mfma32(a, bq, sacc);
      }
      float* stp = (float*)(p.ws + OFF_ST) + ((size_t)((b * 16 + c) * 8 + h) * 64) * 128;
#pragma unroll
      for (int reg = 0; reg < 16; reg++) stp[(pt * 32 + rowmap(reg, hh)) * 128 + nt * 32 + r] = sacc[reg];
      if (tid < 128) ((float*)(p.ws + OFF_ACUM))[((b * 16 + c) * 8 + h) * 128 + tid] = acum[tid];
    }
  }
}

DEV void ssdS_item(const Params& p, int b, int h, int q) {
  const int tid = opaque_tid();
  const float* stb = (const float*)(p.ws + OFF_ST);
  const float* acg = (const float*)(p.ws + OFF_ACUM);
  u16* sin = (u16*)(p.ws + OFF_SIN_ST);
  const int off = q * 2048 + tid * 4;
  float4 S = make_float4(0.f, 0.f, 0.f, 0.f);
  float4 ld[4];
#pragma unroll
  for (int j = 0; j < 4; j++) ld[j] = *(const float4*)(stb + (size_t)((b * 16 + j) * 8 + h) * 8192 + off);
#pragma unroll
  for (int c4 = 0; c4 < 16; c4 += 4) {
    float4 nx[4];
    if (c4 + 4 < 16) {
#pragma unroll
      for (int j = 0; j < 4; j++) nx[j] = *(const float4*)(stb + (size_t)((b * 16 + c4 + 4 + j) * 8 + h) * 8192 + off);
    }
#pragma unroll
    for (int j = 0; j < 4; j++) {
      const int c = c4 + j;
      *(uint2*)(sin + (size_t)((b * 16 + c) * 8 + h) * 8192 + off) = make_uint2(pack2(S.x, S.y), pack2(S.z, S.w));
      const float dec = expf(acg[((b * 16 + c) * 8 + h) * 128 + 127]);
      S.x = fmaf(S.x, dec, ld[j].x); S.y = fmaf(S.y, dec, ld[j].y); S.z = fmaf(S.z, dec, ld[j].z); S.w = fmaf(S.w, dec, ld[j].w);
    }
    if (c4 + 4 < 16) {
#pragma unroll
      for (int j = 0; j < 4; j++) ld[j] = nx[j];
    }
  }
}

DEV void ssdB_item(const Params& p, int b, int c, char* smem) {
  const int tid = opaque_tid(), lane = tid & 63, h = __builtin_amdgcn_readfirstlane(tid >> 6), r = lane & 31, hh = lane >> 5;
  const size_t tb = (size_t)b * 2048;
  const int g = h >> 2;
  float* ssq = (float*)smem;
  const float* acg = (const float*)(p.ws + OFF_ACUM);
  __syncthreads();
  bf16x8 sf[2][8];
  if (c > 0) {
    const u16* sin = (const u16*)(p.ws + OFF_SIN_ST) + (size_t)((b * 16 + c) * 8 + h) * 8192;
#pragma unroll
    for (int pt = 0; pt < 2; pt++)
#pragma unroll
      for (int ks = 0; ks < 8; ks++) sf[pt][ks] = *(const bf16x8*)(sin + (pt * 32 + r) * 128 + ks * 16 + hh * 8);
  }
  const u16* ccg = (const u16*)(p.ws + OFF_CC);
  const u16* zb = (const u16*)(p.ws + OFF_Z);
  const float* ypb = (const float*)(p.ws + OFF_YP);
  u16* cat = (u16*)(p.ws + OFF_HBUF);
#pragma unroll 1
  for (int lt = 0; lt < 4; ++lt) {
    const int lidx = lt * 32 + r;
    const size_t t = tb + c * 128 + lidx;
    f32x16 y0 = zero16(), y1 = zero16();
    if (c > 0) {
#pragma unroll
      for (int ks = 0; ks < 8; ks++) {
        const bf16x8 cf = *(const bf16x8*)(ccg + t * 256 + g * 128 + ks * 16 + hh * 8);
        y0 = mfma32(sf[0][ks], cf, y0); y1 = mfma32(sf[1][ks], cf, y1);
      }
      const float e = expf(acg[((b * 16 + c) * 8 + h) * 128 + lidx]);
#pragma unroll
      for (int reg = 0; reg < 16; reg++) { y0[reg] *= e; y1[reg] *= e; }
    }
    float ss = 0.f;
#pragma unroll
    for (int gq = 0; gq < 4; gq++) {
      const int pb = 8 * gq + 4 * hh;
      const float4 a0 = *(const float4*)(ypb + t * 512 + h * 64 + pb);
      const float4 a1 = *(const float4*)(ypb + t * 512 + h * 64 + 32 + pb);
      const uint2 z0 = *(const uint2*)(zb + t * 512 + h * 64 + pb);
      const uint2 z1 = *(const uint2*)(zb + t * 512 + h * 64 + 32 + pb);
      y0[4 * gq + 0] = (y0[4 * gq + 0] + a0.x) * silu_f(bflo(z0.x)); y0[4 * gq + 1] = (y0[4 * gq + 1] + a0.y) * silu_f(bfhi(z0.x));
      y0[4 * gq + 2] = (y0[4 * gq + 2] + a0.z) * silu_f(bflo(z0.y)); y0[4 * gq + 3] = (y0[4 * gq + 3] + a0.w) * silu_f(bfhi(z0.y));
      y1[4 * gq + 0] = (y1[4 * gq + 0] + a1.x) * silu_f(bflo(z1.x)); y1[4 * gq + 1] = (y1[4 * gq + 1] + a1.y) * silu_f(bfhi(z1.x));
      y1[4 * gq + 2] = (y1[4 * gq + 2] + a1.z) * silu_f(bflo(z1.y)); y1[4 * gq + 3] = (y1[4 * gq + 3] + a1.w) * silu_f(bfhi(z1.y));
#pragma unroll
      for (int j = 0; j < 4; j++) ss += y0[4 * gq + j] * y0[4 * gq + j] + y1[4 * gq + j] * y1[4 * gq + j];
    }
    ss += __shfl_xor(ss, 32);
    if (hh == 0) ssq[(lt * 32 + r) * 8 + h] = ss;
    __syncthreads();
    float tot = 0.f;
#pragma unroll
    for (int k = 0; k < 8; k++) tot += ssq[(lt * 32 + r) * 8 + k];
    const float rstd = rsqrtf(tot * (1.f / 512.f) + 1e-6f);
#pragma unroll
    for (int gq = 0; gq < 4; gq++) {
      const int pb = 8 * gq + 4 * hh;
      const float4 g0 = *(const float4*)(p.ssd_norm_g + h * 64 + pb);
      const float4 g1 = *(const float4*)(p.ssd_norm_g + h * 64 + 32 + pb);
      *(uint2*)(cat + t * 1024 + 512 + h * 64 + pb) = make_uint2(pack2(y0[4 * gq] * rstd * g0.x, y0[4 * gq + 1] * rstd * g0.y), pack2(y0[4 * gq + 2] * rstd * g0.z, y0[4 * gq + 3] * rstd * g0.w));
      *(uint2*)(cat + t * 1024 + 512 + h * 64 + 32 + pb) = make_uint2(pack2(y1[4 * gq] * rstd * g1.x, y1[4 * gq + 1] * rstd * g1.y), pack2(y1[4 * gq + 2] * rstd * g1.z, y1[4 * gq + 3] * rstd * g1.w));
    }
  }
}


DEV void p3_rows1(const Params& p, int m0) {
  const int tid_ = opaque_tid(); const int lane = tid_ & 63, w = __builtin_amdgcn_readfirstlane(tid_ >> 6);
  const u16* mix = (const u16*)(p.ws + OFF_MIX);
  const float* mod = (const float*)(p.ws + OFF_MOD);
  u16* h2 = (u16*)(p.ws + OFF_HBUF);
#pragma unroll 2
  for (int i = 0; i < 16; i++) {
    const int t = m0 + w * 16 + i; const int b = t >> 11;
    float4 mv[4], xv[4]; float ss = 0.f;
#pragma unroll
    for (int k = 0; k < 4; k++) {
      { const uint2 mq = *(const uint2*)(mix + (size_t)t * 1024 + (k * 64 + lane) * 4); mv[k] = make_float4(bflo(mq.x), bfhi(mq.x), bflo(mq.y), bfhi(mq.y)); }
      xv[k] = *(const float4*)(p.x + (size_t)t * 1024 + (k * 64 + lane) * 4);
      ss += mv[k].x * mv[k].x + mv[k].y * mv[k].y + mv[k].z * mv[k].z + mv[k].w * mv[k].w;
    }
    ss = wave_sum(ss);
    const float rstd = rsqrtf(ss * (1.f / 1024.f) + 1e-6f);
    float s2 = 0.f;
#pragma unroll
    for (int k = 0; k < 4; k++) {
      const int col = (k * 64 + lane) * 4;
      const float4 pg = *(const float4*)(p.post_mix_g + col);
      const float4 g1 = ldmod(mod, b * 6144 + 2048 + col);
      xv[k].x += g1.x * (mv[k].x * rstd * pg.x); xv[k].y += g1.y * (mv[k].y * rstd * pg.y);
      xv[k].z += g1.z * (mv[k].z * rstd * pg.z); xv[k].w += g1.w * (mv[k].w * rstd * pg.w);
      s2 += xv[k].x * xv[k].x + xv[k].y * xv[k].y + xv[k].z * xv[k].z + xv[k].w * xv[k].w;
      *(uint2*)((u16*)(p.ws + OFF_X1) + (size_t)t * 1024 + col) = make_uint2(pack2(xv[k].x, xv[k].y), pack2(xv[k].z, xv[k].w));
    }
    s2 = wave_sum(s2);
    const float rstd2 = rsqrtf(s2 * (1.f / 1024.f) + 1e-6f);
#pragma unroll
    for (int k = 0; k < 4; k++) {
      const int col = (k * 64 + lane) * 4;
      const float4 fg = *(const float4*)(p.pre_ffn_g + col);
      const float4 sh = ldmod(mod, b * 6144 + 3072 + col);
      const float4 sc = ldmod(mod, b * 6144 + 4096 + col);
      const float y0 = (xv[k].x * rstd2 * fg.x) * (1.f + sc.x) + sh.x;
      const float y1 = (xv[k].y * rstd2 * fg.y) * (1.f + sc.y) + sh.y;
      const float y2 = (xv[k].z * rstd2 * fg.z) * (1.f + sc.z) + sh.z;
      const float y3 = (xv[k].w * rstd2 * fg.w) * (1.f + sc.w) + sh.w;
      *(uint2*)(h2 + (size_t)t * 1024 + col) = make_uint2(pack2(y0, y1), pack2(y2, y3));
      xv[k] = make_float4(y0, y1, y2, y3);
    }
    {
      float mx = 0.f;
#pragma unroll
      for (int k = 0; k < 4; k++) mx = fmaxf(mx, fmaxf(fmaxf(fabsf(xv[k].x), fabsf(xv[k].y)), fmaxf(fabsf(xv[k].z), fabsf(xv[k].w))));
#pragma unroll
      for (int o = 32; o > 0; o >>= 1) mx = fmaxf(mx, __shfl_xor(mx, o));
      const float inv = (mx > 0.f) ? 127.f / mx : 0.f;
      unsigned wd[4];
#pragma unroll
      for (int k = 0; k < 4; k++) wd[k] = pack_i8x4(xv[k].x * inv, xv[k].y * inv, xv[k].z * inv, xv[k].w * inv);
      *(uint4*)(p.ws + OFF_H2Q + (size_t)t * 1024 + lane * 16) = make_uint4(wd[0], wd[1], wd[2], wd[3]);
      if (lane == 0) ((float*)(p.ws + OFF_SH))[t] = mx * (1.f / 127.f);
    }
  }
}

#define INS16(L, x) { _Pragma("unroll") for (int j_ = 0; j_ < 16; j_++) { const unsigned hi_ = max(L[j_], x); x = min(L[j_], x); L[j_] = hi_; } }
#define CEX(L, a_, b_) { const unsigned hi_ = max(L[a_], L[b_]); const unsigned lo_ = min(L[a_], L[b_]); L[a_] = hi_; L[b_] = lo_; }
DEV float unordkey(unsigned u) { const unsigned b = (u & 0x80000000u) ? (u ^ 0x80000000u) : ~u; return __uint_as_float(b); }

#define SORT16(L) { \
  _Pragma("unroll") for (int k_ = 2; k_ <= 16; k_ <<= 1) { \
    _Pragma("unroll") for (int j_ = k_ >> 1; j_ > 0; j_ >>= 1) { \
      _Pragma("unroll") for (int i_ = 0; i_ < 16; i_++) { \
        const int l_ = i_ ^ j_; \
        if (l_ > i_) { \
          const unsigned a_ = L[i_], b_ = L[l_]; \
          const bool desc_ = ((i_ & k_) == 0); \
          L[i_] = desc_ ? max(a_, b_) : min(a_, b_); L[l_] = desc_ ? min(a_, b_) : max(a_, b_); \
        } } } } }
#define MERGE16(A, B) { \
  _Pragma("unroll") for (int j_ = 0; j_ < 16; j_++) A[j_] = max(A[j_], B[15 - j_]); \
  _Pragma("unroll") for (int j_ = 0; j_ < 8; j_++) CEX(A, j_, j_ + 8); \
  _Pragma("unroll") for (int j_ = 0; j_ < 16; j_++) if ((j_ & 4) == 0) CEX(A, j_, j_ + 4); \
  _Pragma("unroll") for (int j_ = 0; j_ < 16; j_++) if ((j_ & 2) == 0) CEX(A, j_, j_ + 2); \
  _Pragma("unroll") for (int j_ = 0; j_ < 16; j_ += 2) CEX(A, j_, j_ + 1); }

constexpr int RT_LROW = 36;

DEV void p3_route(const Params& p, int m0, char* smem) {
  const int tid = opaque_tid(), lane = tid & 63, w = __builtin_amdgcn_readfirstlane(tid >> 6), r = lane & 31, hh = lane >> 5;
  const u16* qp = (const u16*)(p.ws + OFF_QP);
  const u16* sk = (const u16*)(p.ws + OFF_SK);
  unsigned* lists = (unsigned*)smem;
  int* eidx = (int*)(p.ws + OFF_EIDX);
  float* gate = (float*)(p.ws + OFF_GATE);
  __syncthreads();
  {
    const int h = w;
#pragma unroll 1
    for (int i = 0; i < 2; i++) {
      bf16x8 af[4][4];
#pragma unroll
      for (int kt4 = 0; kt4 < 4; kt4++)
#pragma unroll
        for (int ks = 0; ks < 4; ks++) af[kt4][ks] = *(const bf16x8*)(sk + ((size_t)(h * 2 + i) * 128 + kt4 * 32 + r) * 64 + ks * 16 + hh * 8);
#pragma unroll 1
      for (int tt = 0; tt < 4; tt++) {
        bf16x8 bq[4];
#pragma unroll
        for (int ks = 0; ks < 4; ks++) bq[ks] = *(const bf16x8*)(qp + (size_t)(m0 + tt * 32 + r) * 1024 + h * 128 + i * 64 + ks * 16 + hh * 8);
        unsigned L0[16], L1[16], L2[16], L3[16];
#define RT_TILE(LL, kt4) { f32x16 acc = zero16(); \
          _Pragma("unroll") for (int ks = 0; ks < 4; ks++) acc = mfma32(af[kt4][ks], bq[ks], acc); \
          const unsigned kb = (unsigned)(127 - (kt4) * 32 - 4 * hh); \
          _Pragma("unroll") for (int reg = 0; reg < 16; reg++) LL[reg] = (ordkey(acc[reg]) & 0xFFFFFF80u) | (kb - (unsigned)((reg & 3) + 8 * (reg >> 2))); \
          SORT16(LL); }
        RT_TILE(L0, 0); RT_TILE(L1, 1);
        MERGE16(L0, L1);
        RT_TILE(L2, 2); RT_TILE(L3, 3);
        MERGE16(L2, L3);
        MERGE16(L0, L2);
#undef RT_TILE
        unsigned C[16];
#pragma unroll
        for (int j = 0; j < 16; j++) C[j] = (unsigned)__shfl_xor((int)L0[j], 32);
        MERGE16(L0, C);
#pragma unroll
        for (int j = 0; j < 16; j++) C[j] = L0[j];
        if (hh == 0) {
          uint4* dst = (uint4*)(lists + ((size_t)(h * 128 + tt * 32 + r)) * RT_LROW + i * 16);
          dst[0] = make_uint4(C[0], C[1], C[2], C[3]); dst[1] = make_uint4(C[4], C[5], C[6], C[7]);
          dst[2] = make_uint4(C[8], C[9], C[10], C[11]); dst[3] = make_uint4(C[12], C[13], C[14], C[15]);
        }
      }
    }
  }
  __syncthreads();
#pragma unroll 1
  for (int k = 0; k < 2; k++) {
    const int task = tid + k * 512;
    const int h = task >> 7, t = task & 127;
    const uint4* src = (const uint4*)(lists + (size_t)(h * 128 + t) * RT_LROW);
    unsigned K0[16], K1[16];
#pragma unroll
    for (int q = 0; q < 4; q++) {
      const uint4 a = src[q], bb = src[4 + q];
      K0[4 * q] = a.x; K0[4 * q + 1] = a.y; K0[4 * q + 2] = a.z; K0[4 * q + 3] = a.w;
      K1[4 * q] = bb.x; K1[4 * q + 1] = bb.y; K1[4 * q + 2] = bb.z; K1[4 * q + 3] = bb.w;
    }
    float s0[16], s1[16];
#pragma unroll
    for (int j = 0; j < 16; j++) { s0[j] = unordkey(K0[j] & 0xFFFFFF80u); s1[j] = unordkey(K1[j] & 0xFFFFFF80u); }
    unsigned L[16];
#pragma unroll
    for (int j = 0; j < 16; j++) L[j] = 0u;
#pragma unroll
    for (int a = 0; a < 16; a++) {
#pragma unroll
      for (int bb = 0; bb < 16; bb++) {
        if ((a + 1) * (bb + 1) <= 16) {
          unsigned x = (ordkey(s0[a] + s1[bb]) & 0xFFFFFF00u) | (unsigned)(255 - (a * 16 + bb));
          INS16(L, x);
        }
      }
    }
    float fv[16]; int ei[16]; float mx = NEG_INF;
#pragma unroll
    for (int j = 0; j < 16; j++) {
      const int code = 255 - (int)(L[j] & 255u); const int a = code >> 4, bb = code & 15;
      const unsigned ka = ((const unsigned*)src)[a], kb2 = ((const unsigned*)src)[16 + bb];
      const float va = unordkey(ka & 0xFFFFFF80u), vb = unordkey(kb2 & 0xFFFFFF80u);
      fv[j] = va + vb;
      ei[j] = (127 - (int)(ka & 127u)) * 128 + (127 - (int)(kb2 & 127u));
      mx = fmaxf(mx, fv[j]);
    }
    float sum = 0.f;
#pragma unroll
    for (int j = 0; j < 16; j++) { fv[j] = __expf(fv[j] - mx); sum += fv[j]; }
    const float inv = 1.f / sum;
    int* ep = eidx + (size_t)(m0 + t) * 128 + h * 16;
    float* gp = gate + (size_t)(m0 + t) * 128 + h * 16;
#pragma unroll
    for (int q = 0; q < 4; q++) {
      *(int4*)(ep + 4 * q) = make_int4(ei[4 * q], ei[4 * q + 1], ei[4 * q + 2], ei[4 * q + 3]);
      *(float4*)(gp + 4 * q) = make_float4(fv[4 * q] * inv, fv[4 * q + 1] * inv, fv[4 * q + 2] * inv, fv[4 * q + 3] * inv);
    }
  }
}

typedef __attribute__((ext_vector_type(2))) float f32x2;
DEV void dec16(const uint4& q, float* f) {
  f32x2 t;
  t = __builtin_amdgcn_cvt_pk_f32_fp8((int)q.x, false); f[0] = t[0]; f[1] = t[1];
  t = __builtin_amdgcn_cvt_pk_f32_fp8((int)q.x, true);  f[2] = t[0]; f[3] = t[1];
  t = __builtin_amdgcn_cvt_pk_f32_fp8((int)q.y, false); f[4] = t[0]; f[5] = t[1];
  t = __builtin_amdgcn_cvt_pk_f32_fp8((int)q.y, true);  f[6] = t[0]; f[7] = t[1];
  t = __builtin_amdgcn_cvt_pk_f32_fp8((int)q.z, false); f[8] = t[0]; f[9] = t[1];
  t = __builtin_amdgcn_cvt_pk_f32_fp8((int)q.z, true);  f[10] = t[0]; f[11] = t[1];
  t = __builtin_amdgcn_cvt_pk_f32_fp8((int)q.w, false); f[12] = t[0]; f[13] = t[1];
  t = __builtin_amdgcn_cvt_pk_f32_fp8((int)q.w, true);  f[14] = t[0]; f[15] = t[1];
}

constexpr int PX_ROW = 132;
constexpr int PX_Z = 0;
constexpr int PX_E = 8 * 16 * PX_ROW * 4;
constexpr int PX_SS = 2 * PX_E;
constexpr int PX_CL = PX_SS + 512;

DEV void p3_ustage(const Params& p, int m0, char* smem) {
  const int tid_ = opaque_tid(); const int lane = tid_ & 63, w = __builtin_amdgcn_readfirstlane(tid_ >> 6);
  const int sl = lane >> 3, ch = lane & 7;
  const unsigned char* h2q = p.ws + OFF_H2Q;
  const unsigned char* U = p.ws + OFF_U;
  const int* eidx = (const int*)(p.ws + OFF_EIDX);
  float* zb = (float*)(smem + PX_Z) + w * 16 * PX_ROW;
  int* eb = (int*)(smem + PX_E) + w * 16 * PX_ROW;
  int* cl = (int*)(smem + PX_CL) + w * 128;
#pragma unroll 1
  for (int i = 0; i < 16; i++) {
    const int t = m0 + w * 16 + i;
    eb[i * PX_ROW + lane] = eidx[(size_t)t * 128 + lane]; eb[i * PX_ROW + 64 + lane] = eidx[(size_t)t * 128 + 64 + lane];
  }
  if (lane < 16) ((float*)(smem + PX_SS))[w * 16 + lane] = 0.f;
#define U_LOAD8(Q, E) { const unsigned char* up_ = U + (size_t)((E) & emask) * 1024 + ch * 16; _Pragma("unroll") for (int k_ = 0; k_ < 8; k_++) Q[k_] = *(const uint4*)(up_ + k_ * 128); }
#pragma unroll 1
  for (int rep = 0; rep < PROBE_U + PROBE_UHOT; rep++)
#pragma unroll 1
  for (int x = 0; x < 8; x++) {
    const int emask = (rep >= PROBE_U) ? 63 : 0xFFFFF;
    float* zbase = (rep >= PROBE_U) ? ((float*)(p.ws + OFF_K) + ((size_t)blockIdx.x * 8 + w) * 16 * PX_ROW) : zb;
    uint4 hqn[8];
#pragma unroll
    for (int k = 0; k < 8; k++) hqn[k] = *(const uint4*)(h2q + (size_t)(m0 + w * 16) * 1024 + k * 128 + ch * 16);
#pragma unroll 1
    for (int i = 0; i < 16; i++) {
      uint4 hq[8];
#pragma unroll
      for (int k = 0; k < 8; k++) hq[k] = hqn[k];
      const int ev0 = eb[i * PX_ROW + lane], ev1 = eb[i * PX_ROW + 64 + lane];
      const bool f0 = (ev0 >> 11) == x, f1 = (ev1 >> 11) == x;
      const unsigned long long mk0 = __ballot(f0), mk1 = __ballot(f1);
      const int n0 = __builtin_popcountll(mk0), n = n0 + __builtin_popcountll(mk1);
      const int r0 = __builtin_amdgcn_mbcnt_hi((unsigned)(mk0 >> 32), __builtin_amdgcn_mbcnt_lo((unsigned)mk0, 0));
      const int r1 = n0 + __builtin_amdgcn_mbcnt_hi((unsigned)(mk1 >> 32), __builtin_amdgcn_mbcnt_lo((unsigned)mk1, 0));
      if (f0) cl[r0] = ev0 | (lane << 16);
      if (f1) cl[r1] = ev1 | ((64 + lane) << 16);
      float* zrow = zbase + i * PX_ROW;
      uint4 qA[8]; int ceA = 0;
      if (n > 0) { ceA = cl[(sl < n) ? sl : 0]; U_LOAD8(qA, ceA & 0xFFFF); }
      {
        const unsigned char* hp = h2q + (size_t)(m0 + w * 16 + ((i < 15) ? i + 1 : i)) * 1024 + ch * 16;
#pragma unroll
        for (int k = 0; k < 8; k++) hqn[k] = *(const uint4*)(hp + k * 128);
      }
#pragma unroll 1
      for (int bb = 0; bb < n; bb += 8) {
        uint4 qB[8]; int ceB = 0;
        const bool more = (bb + 8 < n);
        if (more) { const int ix = bb + 8 + sl; ceB = cl[(ix < n) ? ix : bb + 8]; U_LOAD8(qB, ceB & 0xFFFF); }
        int d = 0;
#pragma unroll
        for (int k = 0; k < 8; k++) {
          d = __builtin_amdgcn_sdot4((int)qA[k].x, (int)hq[k].x, d, false);
          d = __builtin_amdgcn_sdot4((int)qA[k].y, (int)hq[k].y, d, false);
          d = __builtin_amdgcn_sdot4((int)qA[k].z, (int)hq[k].z, d, false);
          d = __builtin_amdgcn_sdot4((int)qA[k].w, (int)hq[k].w, d, false);
        }
        d += __builtin_amdgcn_update_dpp(0, d, 0xB1, 0xF, 0xF, false);
        d += __builtin_amdgcn_update_dpp(0, d, 0x4E, 0xF, 0xF, false);
        d += __builtin_amdgcn_update_dpp(0, d, 0x141, 0xF, 0xF, false);
        if (ch == 0 && bb + sl < n) zrow[ceA >> 16] = (float)d;
        if (more) {
#pragma unroll
          for (int k = 0; k < 8; k++) qA[k] = qB[k];
          ceA = ceB;
        }
      }
    }
  }
#undef U_LOAD8
  {
    const float* su = (const float*)(p.ws + OFF_SU);
    const float* sv = (const float*)(p.ws + OFF_SV);
    const float* shs = (const float*)(p.ws + OFF_SH);
    const float* gate = (const float*)(p.ws + OFF_GATE);
#pragma unroll 1
    for (int i = 0; i < 16; i++) {
      const int t = m0 + w * 16 + i;
      const float st = shs[t];
#pragma unroll
      for (int half = 0; half < 2; half++) {
        const int e = eb[i * PX_ROW + half * 64 + lane];
        const float z = zb[i * PX_ROW + half * 64 + lane] * (su[e] * st);
        zb[i * PX_ROW + half * 64 + lane] = 0.5f * z * (1.f + erff(z * 0.70710678118654752f)) * gate[(size_t)t * 128 + half * 64 + lane] * sv[e];
      }
    }
  }
}

DEV void p3_vstage(const Params& p, int m0, char* smem) {
  const int tid_ = opaque_tid(); const int lane = tid_ & 63, w = __builtin_amdgcn_readfirstlane(tid_ >> 6);
  const unsigned char* V = p.ws + OFF_V;
  const float* ab = (const float*)(smem + PX_Z) + w * 16 * PX_ROW;
  const int* eb = (const int*)(smem + PX_E) + w * 16 * PX_ROW;
  float* ssq = (float*)(smem + PX_SS) + w * 16;
  u16* F = (u16*)(p.ws + OFF_MIX + (size_t)T_ * 1024 * 2);
  const int ts = lane >> 3, ch = lane & 7;
#define V_LOAD4(Q, E4) { Q[0] = *(const uint4*)(vb + (size_t)((E4).x & emask) * 1024); Q[1] = *(const uint4*)(vb + (size_t)((E4).y & emask) * 1024); \
    Q[2] = *(const uint4*)(vb + (size_t)((E4).z & emask) * 1024); Q[3] = *(const uint4*)(vb + (size_t)((E4).w & emask) * 1024); }
#pragma unroll 1
  for (int rep = 0; rep < PROBE_V + PROBE_VHOT; rep++)
#pragma unroll 1
  for (int x = 0; x < 8; x++) {
    const int emask = (rep >= PROBE_V) ? 63 : 0xFFFFF;
    const unsigned char* vb = V + x * 128 + ch * 16;
#pragma unroll 1
    for (int grp = 0; grp < 2; grp++) {
      const int i = grp * 8 + ts;
      const int t = m0 + w * 16 + i;
      const int4* ep = (const int4*)(eb + i * PX_ROW);
      const float4* ap = (const float4*)(ab + i * PX_ROW);
      f32x2 acc[8];
#pragma unroll
      for (int k = 0; k < 8; k++) acc[k] = (f32x2){0.f, 0.f};
      uint4 qA[4], qB[4];
      int4 e4 = ep[0];
      V_LOAD4(qA, e4);
      e4 = ep[1];
      V_LOAD4(qB, e4);
#pragma unroll 1
      for (int pb = 0; pb < 32; pb += 2) {
#pragma unroll
        for (int half = 0; half < 2; half++) {
          const float4 a4 = ap[pb + half];
          const float av[4] = {a4.x, a4.y, a4.z, a4.w};
#pragma unroll
          for (int u = 0; u < 4; u++) {
            const uint4 qq = half ? qB[u] : qA[u];
            const f32x2 a2 = {av[u], av[u]};
            const unsigned wds[4] = {qq.x, qq.y, qq.z, qq.w};
#pragma unroll
            for (int k2 = 0; k2 < 4; k2++) {
              acc[2 * k2] = __builtin_elementwise_fma(a2, __builtin_amdgcn_cvt_pk_f32_fp8((int)wds[k2], false), acc[2 * k2]);
              acc[2 * k2 + 1] = __builtin_elementwise_fma(a2, __builtin_amdgcn_cvt_pk_f32_fp8((int)wds[k2], true), acc[2 * k2 + 1]);
            }
          }
          const int nx = pb + 2 + half;
          if (nx < 32) { const int4 en = ep[nx]; if (half) { V_LOAD4(qB, en); } else { V_LOAD4(qA, en); } }
        }
      }
      float ss = 0.f;
#pragma unroll
      for (int k = 0; k < 8; k++) ss = fmaf(acc[k][0], acc[k][0], fmaf(acc[k][1], acc[k][1], ss));
      ss += __int_as_float(__builtin_amdgcn_update_dpp(0, __float_as_int(ss), 0xB1, 0xF, 0xF, false));
      ss += __int_as_float(__builtin_amdgcn_update_dpp(0, __float_as_int(ss), 0x4E, 0xF, 0xF, false));
      ss += __int_as_float(__builtin_amdgcn_update_dpp(0, __float_as_int(ss), 0x141, 0xF, 0xF, false));
      if (rep < PROBE_V) {
        u16* fp = F + (size_t)t * 1024 + x * 128 + ch * 16;
        *(uint4*)(fp) = make_uint4(pack2(acc[0][0], acc[0][1]), pack2(acc[1][0], acc[1][1]), pack2(acc[2][0], acc[2][1]), pack2(acc[3][0], acc[3][1]));
        *(uint4*)(fp + 8) = make_uint4(pack2(acc[4][0], acc[4][1]), pack2(acc[5][0], acc[5][1]), pack2(acc[6][0], acc[6][1]), pack2(acc[7][0], acc[7][1]));
        if (ch == 0 && rep == 0) ssq[i] += ss;
      }
    }
  }
#undef V_LOAD4
  {
    const float* mod = (const float*)(p.ws + OFF_MOD);
#pragma unroll 2
    for (int i = 0; i < 16; i++) {
      const int t = m0 + w * 16 + i; const int b = t >> 11;
      const float rstd = rsqrtf(ssq[i] * (1.f / 1024.f) + 1e-6f);
#pragma unroll
      for (int j = 0; j < 4; j++) {
        const uint2 fq = *(const uint2*)(F + (size_t)t * 1024 + lane * 16 + j * 4);
        const float4 f = make_float4(bflo(fq.x), bfhi(fq.x), bflo(fq.y), bfhi(fq.y));
        const int col = j * 256 + lane * 4;
        const uint2 xq = *(const uint2*)((const u16*)(p.ws + OFF_X1) + (size_t)t * 1024 + col);
        const float4 x1 = make_float4(bflo(xq.x), bfhi(xq.x), bflo(xq.y), bfhi(xq.y));
        const float4 fg = *(const float4*)(p.post_ffn_g + col);
        const float4 g2 = ldmod(mod, b * 6144 + 5120 + col);
        float4 o;
        o.x = x1.x + g2.x * (f.x * rstd * fg.x); o.y = x1.y + g2.y * (f.y * rstd * fg.y);
        o.z = x1.z + g2.z * (f.z * rstd * fg.z); o.w = x1.w + g2.w * (f.w * rstd * fg.w);
        *(float4*)(p.out + (size_t)t * 1024 + col) = o;
      }
    }
  }
}

DEV void phase3_tile(const Params& p, int mt, char* smem) {
  const int m0 = mt * 128;
  const u16* cat = (const u16*)(p.ws + OFF_HBUF) + (size_t)m0 * 1024;
  {
    const u16* wt = (const u16*)(p.ws + OFF_WTOUT);
    for (int rep = 0; rep < PROBE_G3; rep++)
    for (int nc = 0; nc < 4; nc++) {
      EpiStoreBf16 epi{(u16*)(p.ws + OFF_MIX) + (size_t)m0 * 1024, nc * 256};
      gemm_tile(cat, 1024, wt + (size_t)nc * 256 * 1024, 1024, 1024, smem, epi);
    }
  }
  __syncthreads();
  p3_rows1(p, m0);
#if STAGE >= 6
  __syncthreads();
  {
    const u16* wt = (const u16*)(p.ws + OFF_WTQ);
    for (int rep = 0; rep < PROBE_G3; rep++)
    for (int nc = 0; nc < 4; nc++) {
      EpiStoreBf16 epi{(u16*)(p.ws + OFF_QP) + (size_t)m0 * 1024, nc * 256};
      gemm_tile(cat, 1024, wt + (size_t)nc * 256 * 1024, 1024, 1024, smem, epi);
    }
  }
  __syncthreads();
  for (int rep = 0; rep < PROBE_ROUTE; rep++) p3_route(p, m0, smem);
  __syncthreads();
#endif
}

DEV void grid_barrier(unsigned* counter, unsigned& target) {
  asm volatile("s_waitcnt vmcnt(0)" ::: "memory");
  __syncthreads();
  if (threadIdx.x == 0) {
    __builtin_amdgcn_fence(__ATOMIC_RELEASE, "agent");
    asm volatile("s_waitcnt vmcnt(0)" ::: "memory");
    target += gridDim.x;
    __hip_atomic_fetch_add(counter, 1u, __ATOMIC_RELAXED, __HIP_MEMORY_SCOPE_AGENT);
    while (__hip_atomic_load(counter, __ATOMIC_RELAXED, __HIP_MEMORY_SCOPE_AGENT) < target) __builtin_amdgcn_s_sleep(1);
    __builtin_amdgcn_fence(__ATOMIC_ACQUIRE, "agent");
    asm volatile("s_waitcnt vmcnt(0)" ::: "memory");
  }
  __syncthreads();
}

#define XB_TMO      128
#define XB_XCNT(j)  (256  + 64 * (j))
#define XB_XSUB(j)  (1280 + 64 * (j))
#define XB_XGEN(j)  (2304 + 64 * (j))
#define XB_TOP      3328
#define XB_TOPGEN   3392
#define XB_SPIN_CAP (1u << 22)
DEV unsigned xb_ld(unsigned* p) { return __hip_atomic_load(p, __ATOMIC_RELAXED, __HIP_MEMORY_SCOPE_AGENT); }
DEV unsigned xb_add(unsigned* p, unsigned v) { return __hip_atomic_fetch_add(p, v, __ATOMIC_RELAXED, __HIP_MEMORY_SCOPE_AGENT); }
DEV unsigned xb_xcc_id() { return (unsigned)__builtin_amdgcn_s_getreg((3 << 11) | 20) & 0xFu; }
#define XB_SPIN(cond, bar) do { unsigned _sp = 0; while (cond) { __builtin_amdgcn_s_sleep(1); \
    if ((++_sp & 255u) == 0u) { if (xb_ld(&(bar)[XB_TMO])) break; if (_sp > XB_SPIN_CAP) { atomicAdd(&(bar)[XB_TMO], 1u); break; } } } } while (0)
struct XcdBarrier { unsigned* bar; unsigned x; unsigned* st; };
DEV void xcd_barrier_complete(unsigned* bar, unsigned x, unsigned& nloc, unsigned& nx) {
  const unsigned G = gridDim.x;
  unsigned sum, cnt, mine, sp = 0u;
  for (;;) {
    sum = 0u; cnt = 0u; mine = 0u;
#pragma unroll
    for (unsigned j = 0; j < 16; ++j) { const unsigned c = xb_ld(&bar[XB_XCNT(j)]); sum += c; cnt += (c > 0u) ? 1u : 0u; mine = (j == x) ? c : mine; }
    if (sum == G) break;
    __builtin_amdgcn_s_sleep(1);
    if ((++sp & 255u) == 0u) { if (xb_ld(&bar[XB_TMO])) break; if (sp > XB_SPIN_CAP) { atomicAdd(&bar[XB_TMO], 1u); break; } }
  }
  nloc = mine > 0u ? mine : 1u; nx = cnt > 0u ? cnt : 1u;
}
DEV void xcd_barrier(const XcdBarrier& b) {
  asm volatile("s_waitcnt vmcnt(0)" ::: "memory");
  __syncthreads();
  if (threadIdx.x == 0) {
    unsigned* bar = b.bar;
    __builtin_amdgcn_s_waitcnt(0);
    unsigned nloc = b.st[0], nx = b.st[1];
    if (nloc == 0u) { xcd_barrier_complete(bar, b.x, nloc, nx); b.st[0] = nloc; b.st[1] = nx; }
    const unsigned old = xb_add(&bar[XB_XSUB(b.x)], 1u);
    const unsigned gen = old / nloc;
    if (old + 1u == (gen + 1u) * nloc) {
      __builtin_amdgcn_fence(__ATOMIC_RELEASE, "agent");
      asm volatile("s_waitcnt vmcnt(0)" ::: "memory");
      const unsigned og = xb_add(&bar[XB_TOP], 1u);
      const unsigned tg = og / nx;
      if (og + 1u == (tg + 1u) * nx) xb_add(&bar[XB_TOPGEN], 1u);
      else XB_SPIN(xb_ld(&bar[XB_TOPGEN]) == tg, bar);
      __builtin_amdgcn_fence(__ATOMIC_ACQUIRE, "agent");
      xb_add(&bar[XB_XGEN(b.x)], 1u);
      asm volatile("s_waitcnt vmcnt(0)" ::: "memory");
    } else {
      XB_SPIN(xb_ld(&bar[XB_XGEN(b.x)]) == gen, bar);
      __builtin_amdgcn_fence(__ATOMIC_ACQUIRE, "agent");
      asm volatile("s_waitcnt vmcnt(0)" ::: "memory");
    }
  }
  __syncthreads();
}

__global__ void __launch_bounds__(NT) mega(Params p) {
  __shared__ __attribute__((aligned(16))) char smem[LDS_BYTES + 16];
  cg::grid_group grid = cg::this_grid();
  XcdBarrier xb; xb.bar = (unsigned*)(p.ws + OFF_XB); xb.x = xb_xcc_id(); xb.st = (unsigned*)(smem + LDS_BYTES);
  if (threadIdx.x == 0) { xb.st[0] = 0u; xb.st[1] = 0u; (void)xb_add(&xb.bar[XB_XCNT(xb.x)], 1u); }
  __syncthreads();
#if STAGE == 0
  {
    const size_t n4 = (size_t)T_ * 1024 / 4;
    for (size_t i = (size_t)blockIdx.x * NT + threadIdx.x; i < n4; i += (size_t)gridDim.x * NT) ((float4*)p.out)[i] = ((const float4*)p.x)[i];
  }
#endif
  phase_mod(p, smem);
  if (gridDim.x == 0x7fffffffu) grid.sync();
  xcd_barrier(xb);
#if PH(1)
  for (int rep = 0; rep < PROBE_HN; rep++) phase_hnorm(p);
#endif
#if PH(0)
  for (int rep = 0; rep < PROBE_P0; rep++) phase0(p, smem);
#endif
  xcd_barrier(xb);
#if STAGE >= 1 && PH(2)
  for (int rep = 0; rep < PROBE_P1; rep++) phase1(p, smem);
#endif
  xcd_barrier(xb);
#if STAGE >= 2 && PH(3)
  for (int rep = 0; rep < PROBE_SSDA; rep++)
  for (int it = blockIdx.x; it < 512; it += gridDim.x) { ssdA_item(p, it >> 5, (it >> 1) & 15, it & 1, smem); }
#endif
#if STAGE >= 4 && PH(4)
  for (int rep = 0; rep < PROBE_DSA; rep++)
  for (int k = 0; k < 4; k++) {
    const int i = blockIdx.x + k * gridDim.x;
    if (gridDim.x == 256) {
      const int rr = i & 255; const int b = rr & 15, a = rr >> 4;
      const int qt = (k == 0) ? a : (k == 1) ? 31 - a : (k == 2) ? 32 + a : 63 - a;
      dsa_item(p, b, qt, smem);
    }
  }
  if (gridDim.x != 256) { for (int i = blockIdx.x; i < 1024; i += gridDim.x) dsa_item(p, i & 15, 63 - (i >> 4), smem); }
#if STAGE >= 2
  xcd_barrier(xb);
#endif
  for (int it = blockIdx.x; it < 512; it += gridDim.x) ssdS_item(p, it >> 5, (it >> 2) & 7, it & 3);
#elif STAGE >= 2 && STAGE < 4
  {
    u16* cat = (u16*)(p.ws + OFF_HBUF);
    for (size_t i = (size_t)blockIdx.x * NT + threadIdx.x; i < (size_t)T_ * 64; i += (size_t)gridDim.x * NT) {
      const size_t t = i >> 6, cc = i & 63;
      *(uint4*)(cat + t * 1024 + cc * 8) = make_uint4(0, 0, 0, 0);
    }
  }
#endif
  xcd_barrier(xb);
#if STAGE >= 2 && PH(5)
  for (int rep = 0; rep < PROBE_SSDB; rep++)
  for (int it = blockIdx.x; it < 256; it += gridDim.x) ssdB_item(p, it >> 4, it & 15, smem);
#endif
  xcd_barrier(xb);
#if STAGE >= 3 && PH(6)
  if (gridDim.x == 256) {
    if (blockIdx.x & 1) convert_fp8_rows(p.peer_v, p.ws + OFF_V, (float*)(p.ws + OFF_SV));
    phase3_tile(p, blockIdx.x, smem);
    if (!(blockIdx.x & 1)) convert_fp8_rows(p.peer_v, p.ws + OFF_V, (float*)(p.ws + OFF_SV));
    xcd_barrier(xb);
    p3_ustage(p, blockIdx.x * 128, smem);
    xcd_barrier(xb);
    p3_vstage(p, blockIdx.x * 128, smem);
  } else {
    convert_fp8_rows(p.peer_v, p.ws + OFF_V, (float*)(p.ws + OFF_SV));
    xcd_barrier(xb);
    for (int mt = blockIdx.x; mt < 256; mt += gridDim.x) { phase3_tile(p, mt, smem); p3_ustage(p, mt * 128, smem); p3_vstage(p, mt * 128, smem); __syncthreads(); }
  }
#endif
}

extern "C" void kernel_launch(void* const* d_in, const int* in_sizes, int n_in, void* d_out, int out_size, void* d_ws, size_t ws_size, hipStream_t stream) {
  static int grid_blocks = 0;
  if (!grid_blocks) {
    int dev = 0, cus = 0, per_cu = 0;
    hipGetDevice(&dev);
    hipDeviceGetAttribute(&cus, hipDeviceAttributeMultiprocessorCount, dev);
    hipOccupancyMaxActiveBlocksPerMultiprocessor(&per_cu, mega, NT, 0);
    if (per_cu < 1) { fprintf(stderr, "occupancy query says %d blocks/CU\n", per_cu); per_cu = 1; }
    grid_blocks = cus;
    if (ws_size < WS_END) fprintf(stderr, "workspace too small: %zu < %zu\n", ws_size, (size_t)WS_END);
  }
  Params p{};
  p.x = (const float*)d_in[0]; p.c = (const float*)d_in[1]; p.pos = (const int*)d_in[2]; p.w_ada = (const float*)d_in[3]; p.b_ada = (const float*)d_in[4];
  p.pre_mix_g = (const float*)d_in[5]; p.post_mix_g = (const float*)d_in[6]; p.w_in = (const float*)d_in[7]; p.conv_w = (const float*)d_in[8]; p.conv_b = (const float*)d_in[9];
  p.dt_bias = (const float*)d_in[10]; p.a_log = (const float*)d_in[11]; p.d_skip = (const float*)d_in[12]; p.ssd_norm_g = (const float*)d_in[13]; p.w_out = (const float*)d_in[14];
  p.pre_ffn_g = (const float*)d_in[15]; p.post_ffn_g = (const float*)d_in[16]; p.w_q = (const float*)d_in[17]; p.sub_keys = (const float*)d_in[18]; p.peer_u = (const float*)d_in[19];
  p.peer_v = (const float*)d_in[20]; p.out = (float*)d_out; p.ws = (unsigned char*)d_ws;
  if (hipMemsetAsync((unsigned char*)d_ws + OFF_XB, 0, 16384, stream) != hipSuccess) fprintf(stderr, "memset of the barrier words failed\n");
  void* args[] = {&p};
  hipError_t e = hipLaunchCooperativeKernel((void*)mega, dim3(grid_blocks), dim3(NT), args, 0, stream);
  if (e != hipSuccess) fprintf(stderr, "cooperative launch failed: %s (grid %d)\n", hipGetErrorString(e), grid_blocks);
}
```

```cpp
#include <hip/hip_runtime.h>
#include <hip/hip_cooperative_groups.h>
#include <stdint.h>
#include <stdio.h>
namespace cg = cooperative_groups;

#ifndef STAGE
#define STAGE 99
#endif
#ifndef ONLY
#define ONLY -1
#endif
#define PH(n) (ONLY < 0 || ONLY == (n))
#ifndef PROBE_P0
#define PROBE_P0 1
#endif
#ifndef PROBE_HN
#define PROBE_HN 1
#endif
#ifndef PROBE_P1
#define PROBE_P1 1
#endif
#ifndef PROBE_SSDA
#define PROBE_SSDA 1
#endif
#ifndef PROBE_DSA
#define PROBE_DSA 1
#endif
#ifndef PROBE_SSDB
#define PROBE_SSDB 1
#endif
#ifndef PROBE_UHOT
#define PROBE_UHOT 0
#endif
#ifndef PROBE_VHOT
#define PROBE_VHOT 0
#endif
#ifndef PROBE_DSA_SC
#define PROBE_DSA_SC 1
#endif
#ifndef PROBE_DSA_BIS
#define PROBE_DSA_BIS 1
#endif
#ifndef PROBE_DSA_ATT
#define PROBE_DSA_ATT 1
#endif
#ifndef PROBE_U
#define PROBE_U 1
#endif
#ifndef PROBE_V
#define PROBE_V 1
#endif
#ifndef PROBE_ROUTE
#define PROBE_ROUTE 1
#endif
#ifndef PROBE_G3
#define PROBE_G3 1
#endif

#define NT 512
typedef unsigned short u16;
typedef __attribute__((ext_vector_type(8))) short bf16x8;
typedef __attribute__((ext_vector_type(16))) float f32x16;
typedef __attribute__((ext_vector_type(16))) unsigned u32x16;

#define DEV __device__ __forceinline__

constexpr int B_ = 16, S_ = 2048, D_ = 1024, T_ = B_ * S_;
constexpr int NPROJ = 2896, NPAD = 3072;
constexpr int SV_ = 2048 + 64;
constexpr float NEG_INF = -__builtin_huge_valf();

constexpr size_t OFF_MOD = 0;
constexpr size_t OFF_COS = OFF_MOD + 786432;
constexpr size_t OFF_SIN = OFF_COS + (size_t)T_ * 32 * 4;
constexpr size_t OFF_HBUF = OFF_SIN + (size_t)T_ * 32 * 4;
constexpr size_t OFF_WTIN = OFF_HBUF + (size_t)T_ * 1024 * 2;
constexpr size_t OFF_WTOUT = OFF_WTIN + (size_t)NPAD * 1024 * 2;
constexpr size_t OFF_WTQ = OFF_WTOUT + (size_t)1024 * 1024 * 2;
constexpr size_t OFF_SK = OFF_WTQ + (size_t)1024 * 1024 * 2;
constexpr size_t OFF_U = OFF_SK + (size_t)16 * 128 * 64 * 2;
constexpr size_t OFF_V = OFF_U + (size_t)16384 * 1024;
constexpr size_t OFF_SU = OFF_V + (size_t)16384 * 1024;
constexpr size_t OFF_SV = OFF_SU + (size_t)16384 * 4;
constexpr size_t OFF_Q = OFF_SV + (size_t)16384 * 4;
constexpr size_t OFF_QI = OFF_Q + (size_t)T_ * 512 * 2;
constexpr size_t OFF_XBC = OFF_QI + (size_t)T_ * 512 * 2;
constexpr size_t OFF_SIN_ST = OFF_XBC;
constexpr size_t OFF_MIX = OFF_Q;
constexpr size_t OFF_K = OFF_XBC + (size_t)T_ * 1024 * 2;
constexpr size_t OFF_VT = OFF_K + (size_t)T_ * 128 * 2;
constexpr size_t OFF_KI = OFF_VT + (size_t)16 * 2 * 64 * SV_ * 2;
constexpr size_t OFF_WI = OFF_KI + (size_t)T_ * 64 * 2;
constexpr size_t OFF_DT = OFF_WI + (size_t)T_ * 8 * 4;
constexpr size_t OFF_Z = OFF_DT + (size_t)T_ * 8 * 4;
constexpr size_t OFF_EIDX = OFF_Z;
constexpr size_t OFF_GATE = OFF_Z + (size_t)T_ * 128 * 4;
constexpr size_t OFF_ST = OFF_Z + (size_t)T_ * 512 * 2;
constexpr size_t OFF_YP_ = OFF_ST + (size_t)16 * 16 * 8 * 64 * 128 * 4 + (size_t)16 * 16 * 8 * 128 * 4;
constexpr size_t OFF_X1 = OFF_ST;
constexpr size_t OFF_QP = OFF_YP_;
constexpr size_t OFF_ACUM = OFF_ST + (size_t)16 * 16 * 8 * 64 * 128 * 4;
constexpr size_t OFF_YP = OFF_ACUM + (size_t)16 * 16 * 8 * 128 * 4;
static_assert(OFF_YP_ == OFF_YP, "alias");
constexpr size_t OFF_CC = OFF_YP + (size_t)T_ * 512 * 4;
constexpr size_t OFF_BAR = OFF_CC + (size_t)T_ * 256 * 2;
constexpr size_t OFF_XB = OFF_BAR + 256;
constexpr size_t OFF_H2Q = OFF_XB + 16384;
constexpr size_t OFF_SH = OFF_H2Q + (size_t)T_ * 1024;
constexpr size_t WS_END = OFF_SH + (size_t)T_ * 4;

constexpr int LDS_BYTES = 156672;

struct Params {
  const float* x; const float* c; const int* pos; const float* w_ada; const float* b_ada;
  const float* pre_mix_g; const float* post_mix_g; const float* w_in; const float* conv_w; const float* conv_b;
  const float* dt_bias; const float* a_log; const float* d_skip; const float* ssd_norm_g; const float* w_out;
  const float* pre_ffn_g; const float* post_ffn_g; const float* w_q; const float* sub_keys; const float* peer_u;
  const float* peer_v; float* out; unsigned char* ws;
};

__constant__ float c_inv_freq[32] = {
  1.000000000e+00f, 7.498942614e-01f, 5.623413324e-01f, 4.216965139e-01f, 3.162277639e-01f, 2.371373773e-01f, 1.778279394e-01f, 1.333521307e-01f,
  1.000000015e-01f, 7.498941571e-02f, 5.623413250e-02f, 4.216965288e-02f, 3.162277490e-02f, 2.371373773e-02f, 1.778279431e-02f, 1.333521493e-02f,
  9.999999776e-03f, 7.498941850e-03f, 5.623413250e-03f, 4.216964822e-03f, 3.162277630e-03f, 2.371373586e-03f, 1.778279431e-03f, 1.333521446e-03f,
  1.000000047e-03f, 7.498942432e-04f, 5.623413017e-04f, 4.216965172e-04f, 3.162277571e-04f, 2.371373703e-04f, 1.778279402e-04f, 1.333521504e-04f};

DEV int opaque_tid() { int t = threadIdx.x; asm volatile("" : "+v"(t)); return t; }
DEV u16 f2bf(float f) { unsigned u = __float_as_uint(f); u += 0x7FFFu + ((u >> 16) & 1u); return (u16)(u >> 16); }
DEV float bf2f(u16 h) { return __uint_as_float(((unsigned)h) << 16); }
DEV unsigned pack2(float a, float b) { unsigned r; asm("v_cvt_pk_bf16_f32 %0, %1, %2" : "=v"(r) : "v"(a), "v"(b)); return r; }
DEV float bflo(unsigned u) { return __uint_as_float(u << 16); }
DEV float bfhi(unsigned u) { return __uint_as_float(u & 0xFFFF0000u); }
DEV float wave_sum(float v) {
#pragma unroll
  for (int o = 32; o > 0; o >>= 1) v += __shfl_xor(v, o);
  return v;
}
#define DPP_ADD(v, ctrl, rmask) v += __int_as_float(__builtin_amdgcn_update_dpp(0, __float_as_int(v), ctrl, rmask, 0xF, false))
DEV float wave_sum63(float v) {
  DPP_ADD(v, 0xB1, 0xF);
  DPP_ADD(v, 0x4E, 0xF);
  DPP_ADD(v, 0x141, 0xF);
  DPP_ADD(v, 0x140, 0xF);
  DPP_ADD(v, 0x142, 0xA);
  DPP_ADD(v, 0x143, 0xC);
  return v;
}
DEV f32x16 mfma32(bf16x8 a, bf16x8 b, f32x16 c) { return __builtin_amdgcn_mfma_f32_32x32x16_bf16(a, b, c, 0, 0, 0); }
DEV f32x16 zero16() { f32x16 z;
#pragma unroll
  for (int i = 0; i < 16; i++) z[i] = 0.f;
  return z; }
DEV int rowmap(int reg, int hh) { return (reg & 3) + 8 * (reg >> 2) + 4 * hh; }
DEV float silu_f(float v) { return v / (1.f + expf(-v)); }
DEV unsigned ordkey(float f) { unsigned b = __float_as_uint(f); unsigned m = (unsigned)((int)b >> 31) | 0x80000000u; return b ^ m; }
DEV bf16x8 mk_frag(uint2 lo, uint2 hi) { union { uint4 u; bf16x8 v; } t; t.u = make_uint4(lo.x, lo.y, hi.x, hi.y); return t.v; }
DEV bf16x8 pack_frag(const f32x16& v, int base) {
  union { uint4 u; bf16x8 f; } t;
  t.u = make_uint4(pack2(v[base + 0], v[base + 1]), pack2(v[base + 2], v[base + 3]), pack2(v[base + 4], v[base + 5]), pack2(v[base + 6], v[base + 7]));
  return t.f;
}

DEV float4 ldmod(const float* mod, int off) {
  const float4 a = *(const float4*)(mod + off), b = *(const float4*)(mod + 98304 + off);
  return make_float4(a.x + b.x, a.y + b.y, a.z + b.z, a.w + b.w);
}
DEV void phase_mod(const Params& p, char* smem) {
  float* s_silu = (float*)smem;
  float* s_red = (float*)(smem + 32768);
  float* mod = (float*)(p.ws + OFF_MOD);
  const int tid = threadIdx.x;
  for (int item = blockIdx.x; item < 192; item += gridDim.x) {
    const int cgp = item >> 1, ks = item & 1;
    __syncthreads();
    for (int e = tid; e < 8192; e += NT) { int b = e >> 9, i = e & 511; s_silu[i * 16 + b] = silu_f(p.c[b * 1024 + ks * 512 + i]); }
    __syncthreads();
    const int kg = tid >> 6, col = tid & 63;
    float acc[16];
#pragma unroll
    for (int b = 0; b < 16; b++) acc[b] = 0.f;
    const float* w = p.w_ada + (size_t)(ks * 512 + kg * 64) * 6144 + cgp * 64 + col;
#pragma unroll 1
    for (int i0 = 0; i0 < 64; i0 += 16) {
      float wreg[16];
#pragma unroll
      for (int u = 0; u < 16; u++) wreg[u] = w[(size_t)(i0 + u) * 6144];
#pragma unroll
      for (int u = 0; u < 16; u++) {
        const float wv = wreg[u];
        const float4* sp = (const float4*)(s_silu + (kg * 64 + i0 + u) * 16);
        float4 s0 = sp[0], s1 = sp[1], s2 = sp[2], s3 = sp[3];
        acc[0] += s0.x * wv; acc[1] += s0.y * wv; acc[2] += s0.z * wv; acc[3] += s0.w * wv;
        acc[4] += s1.x * wv; acc[5] += s1.y * wv; acc[6] += s1.z * wv; acc[7] += s1.w * wv;
        acc[8] += s2.x * wv; acc[9] += s2.y * wv; acc[10] += s2.z * wv; acc[11] += s2.w * wv;
        acc[12] += s3.x * wv; acc[13] += s3.y * wv; acc[14] += s3.z * wv; acc[15] += s3.w * wv;
      }
    }
#pragma unroll
    for (int b = 0; b < 16; b++) s_red[(kg * 64 + col) * 16 + b] = acc[b];
    __syncthreads();
    for (int e = tid; e < 1024; e += NT) {
      int cc = e >> 4, b = e & 15; float sum = 0.f;
#pragma unroll
      for (int k = 0; k < 8; k++) sum += s_red[(k * 64 + cc) * 16 + b];
      int j = cgp * 64 + cc;
      mod[ks * 98304 + b * 6144 + j] = sum + (ks == 0 ? p.b_ada[j] : 0.f);
    }
  }
}

DEV int remap_col(int n) {
  if (n < 1344) return n;
  if (n < 1352) return 2880 + (n - 1344);
  if (n < 2888) return n - 8;
  return n;
}

DEV void transpose_convert(const float* __restrict__ src, int N, u16* __restrict__ dst, bool remap, char* smem) {
  float* tile = (float*)smem;
  const int tid = threadIdx.x;
  const int ntn = (N + 63) >> 6;
  const int nitems = 16 * ntn;
  for (int item = blockIdx.x; item < nitems; item += gridDim.x) {
    const int kt = item / ntn, nt = item - kt * ntn;
    const int k0 = kt * 64, n0 = nt * 64;
    __syncthreads();
    for (int e = tid; e < 4096; e += NT) {
      int r = e >> 6, ci = e & 63, n = n0 + ci;
      tile[r * 65 + ci] = (n < N) ? src[(size_t)(k0 + r) * N + n] : 0.f;
    }
    __syncthreads();
    for (int e = tid; e < 4096; e += NT) {
      int nn = e >> 6, kk = e & 63, n = n0 + nn;
      if (n < N) { int n2 = remap ? remap_col(n) : n; dst[(size_t)n2 * 1024 + k0 + kk] = f2bf(tile[kk * 65 + nn]); }
    }
  }
}

DEV void convert_bf16(const float* __restrict__ src, u16* __restrict__ dst, size_t n8) {
  const size_t g = (size_t)blockIdx.x * NT + threadIdx.x, gs = (size_t)gridDim.x * NT;
  for (size_t i = g; i < n8; i += gs) {
    const float4 a = ((const float4*)src)[2 * i], b = ((const float4*)src)[2 * i + 1];
    ((uint4*)dst)[i] = make_uint4(pack2(a.x, a.y), pack2(a.z, a.w), pack2(b.x, b.y), pack2(b.z, b.w));
  }
}

DEV void convert_fp8_rows(const float* __restrict__ src, unsigned char* __restrict__ dst, float* __restrict__ scl) {
  const int tid_ = opaque_tid(); const int lane = tid_ & 63, wave = __builtin_amdgcn_readfirstlane(tid_ >> 6);
  for (int e0 = ((blockIdx.x >> 1) * 8 + wave) * 4 + (blockIdx.x & 1) * 8192; e0 < 8192 + (blockIdx.x & 1) * 8192; e0 += (gridDim.x >> 1) * 32) {
    float4 v[4][4];
#pragma unroll
    for (int u = 0; u < 4; u++)
#pragma unroll
      for (int j = 0; j < 4; j++) v[u][j] = *(const float4*)(src + (size_t)(e0 + u) * 1024 + j * 256 + lane * 4);
#pragma unroll
    for (int u = 0; u < 4; u++) {
      float mx = 0.f;
#pragma unroll
      for (int j = 0; j < 4; j++) mx = fmaxf(mx, fmaxf(fmaxf(fabsf(v[u][j].x), fabsf(v[u][j].y)), fmaxf(fabsf(v[u][j].z), fabsf(v[u][j].w))));
#pragma unroll
      for (int o = 32; o > 0; o >>= 1) mx = fmaxf(mx, __shfl_xor(mx, o));
      const float inv = (mx > 0.f) ? 384.f / mx : 0.f;
      int wd[4];
#pragma unroll
      for (int j = 0; j < 4; j++) {
        int t = 0;
        t = __builtin_amdgcn_cvt_pk_fp8_f32(v[u][j].x * inv, v[u][j].y * inv, t, false);
        t = __builtin_amdgcn_cvt_pk_fp8_f32(v[u][j].z * inv, v[u][j].w * inv, t, true);
        wd[j] = t;
      }
      *(uint4*)(dst + (size_t)(e0 + u) * 1024 + lane * 16) = make_uint4((unsigned)wd[0], (unsigned)wd[1], (unsigned)wd[2], (unsigned)wd[3]);
      if (lane == 0) scl[e0 + u] = mx * (1.f / 384.f);
    }
  }
}

DEV unsigned pack_i8x4(float a, float b, float c, float d) {
  const int ia = (int)rintf(a), ib = (int)rintf(b), ic = (int)rintf(c), id = (int)rintf(d);
  return (unsigned)(ia & 255) | ((unsigned)(ib & 255) << 8) | ((unsigned)(ic & 255) << 16) | ((unsigned)id << 24);
}
DEV void convert_i8_rows(const float* __restrict__ src, unsigned char* __restrict__ dst, float* __restrict__ scl) {
  const int tid_ = opaque_tid(); const int lane = tid_ & 63, wave = __builtin_amdgcn_readfirstlane(tid_ >> 6);
  for (int e0 = ((blockIdx.x >> 1) * 8 + wave) * 4 + (blockIdx.x & 1) * 8192; e0 < 8192 + (blockIdx.x & 1) * 8192; e0 += (gridDim.x >> 1) * 32) {
    float4 v[4][4];
#pragma unroll
    for (int u = 0; u < 4; u++)
#pragma unroll
      for (int j = 0; j < 4; j++) v[u][j] = *(const float4*)(src + (size_t)(e0 + u) * 1024 + j * 256 + lane * 4);
#pragma unroll
    for (int u = 0; u < 4; u++) {
      float mx = 0.f;
#pragma unroll
      for (int j = 0; j < 4; j++) mx = fmaxf(mx, fmaxf(fmaxf(fabsf(v[u][j].x), fabsf(v[u][j].y)), fmaxf(fabsf(v[u][j].z), fabsf(v[u][j].w))));
#pragma unroll
      for (int o = 32; o > 0; o >>= 1) mx = fmaxf(mx, __shfl_xor(mx, o));
      const float inv = (mx > 0.f) ? 127.f / mx : 0.f;
      unsigned wd[4];
#pragma unroll
      for (int j = 0; j < 4; j++) wd[j] = pack_i8x4(v[u][j].x * inv, v[u][j].y * inv, v[u][j].z * inv, v[u][j].w * inv);
      *(uint4*)(dst + (size_t)(e0 + u) * 1024 + lane * 16) = make_uint4(wd[0], wd[1], wd[2], wd[3]);
      if (lane == 0) scl[e0 + u] = mx * (1.f / 127.f);
    }
  }
}

DEV void phase0(const Params& p, char* smem) {
  {
    float* cosT = (float*)(p.ws + OFF_COS); float* sinT = (float*)(p.ws + OFF_SIN);
    const int g = blockIdx.x * NT + threadIdx.x, gs = gridDim.x * NT;
    for (int e = g; e < T_ * 32; e += gs) {
      int t = e >> 5, j = e & 31;
      float ang = (float)p.pos[t] * c_inv_freq[j];
      double rev = (double)ang * 0.15915494309189533577;
      rev -= rint(rev);
      float fr = (float)rev;
      cosT[e] = __builtin_amdgcn_cosf(fr);
      sinT[e] = __builtin_amdgcn_sinf(fr);
    }
  }
  transpose_convert(p.w_in, NPROJ, (u16*)(p.ws + OFF_WTIN), true, smem);
  {
    uint4* z = (uint4*)(p.ws + OFF_WTIN + (size_t)NPROJ * 1024 * 2);
    const int n = (NPAD - NPROJ) * 1024 * 2 / 16;
    for (int i = blockIdx.x * NT + threadIdx.x; i < n; i += gridDim.x * NT) z[i] = make_uint4(0, 0, 0, 0);
  }
  transpose_convert(p.w_out, 1024, (u16*)(p.ws + OFF_WTOUT), false, smem);
  transpose_convert(p.w_q, 1024, (u16*)(p.ws + OFF_WTQ), false, smem);
  convert_bf16(p.sub_keys, (u16*)(p.ws + OFF_SK), (size_t)16 * 128 * 64 / 8);
}

DEV void phase_hnorm(const Params& p) {
  const int tid_ = opaque_tid(); const int lane = tid_ & 63, wave = __builtin_amdgcn_readfirstlane(tid_ >> 6);
  const float* mod = (const float*)(p.ws + OFF_MOD);
  u16* h = (u16*)(p.ws + OFF_HBUF);
#pragma unroll 2
  for (int t = blockIdx.x * 8 + wave; t < T_; t += gridDim.x * 8) {
    const int b = t >> 11;
    const float4* xr = (const float4*)(p.x + (size_t)t * 1024);
    float4 v[4]; float ss = 0.f;
#pragma unroll
    for (int i = 0; i < 4; i++) { v[i] = xr[i * 64 + lane]; ss += v[i].x * v[i].x + v[i].y * v[i].y + v[i].z * v[i].z + v[i].w * v[i].w; }
    ss = wave_sum(ss);
    const float rstd = rsqrtf(ss * (1.f / 1024.f) + 1e-6f);
#pragma unroll
    for (int i = 0; i < 4; i++) {
      const int col = (i * 64 + lane) * 4;
      const float4 g = *(const float4*)(p.pre_mix_g + col);
      const float4 sh = ldmod(mod, b * 6144 + col);
      const float4 sc = ldmod(mod, b * 6144 + 1024 + col);
      float y0 = (v[i].x * rstd * g.x) * (1.f + sc.x) + sh.x;
      float y1 = (v[i].y * rstd * g.y) * (1.f + sc.y) + sh.y;
      float y2 = (v[i].z * rstd * g.z) * (1.f + sc.z) + sh.z;
      float y3 = (v[i].w * rstd * g.w) * (1.f + sc.w) + sh.w;
      *(uint2*)(h + (size_t)t * 1024 + col) = make_uint2(pack2(y0, y1), pack2(y2, y3));
    }
  }
}

constexpr int G_ROWB = 144;
constexpr int G_ABYTES = 128 * G_ROWB;
constexpr int G_STAGE = (128 + 256) * G_ROWB;
constexpr int G_SROW = 68;

template <class Epi>
DEV void gemm_tile(const u16* __restrict__ A, int lda, const u16* __restrict__ Bt, int ldb, int K, char* smem, Epi& epi) {
  const int tid = opaque_tid(), lane = tid & 63, wave = __builtin_amdgcn_readfirstlane(tid >> 6), wm = wave >> 2, wn = wave & 3;
  const int r = lane & 31, hh = lane >> 5;
  f32x16 acc00 = zero16(), acc01 = zero16(), acc10 = zero16(), acc11 = zero16();
  uint4 pa0, pa1, pb0, pb1, pb2, pb3;
  uint4 qa0, qa1, qb0, qb1, qb2, qb3;
  const int crow = tid >> 3, ckc = tid & 7;
  const u16* Ap = A + (size_t)crow * lda + ckc * 8;
  const u16* Bp = Bt + (size_t)crow * ldb + ckc * 8;
  const size_t a64 = (size_t)64 * lda, b64 = (size_t)64 * ldb;
  const int loff = crow * G_ROWB + ckc * 16;
#define G_LOAD(S, k0) { S##a0 = *(const uint4*)(Ap + (k0)); S##a1 = *(const uint4*)(Ap + a64 + (k0)); \
    S##b0 = *(const uint4*)(Bp + (k0)); S##b1 = *(const uint4*)(Bp + b64 + (k0)); S##b2 = *(const uint4*)(Bp + 2 * b64 + (k0)); S##b3 = *(const uint4*)(Bp + 3 * b64 + (k0)); }
#define G_STORE(S, buf) { char* sb_ = smem + (buf) * G_STAGE + loff; *(uint4*)(sb_) = S##a0; *(uint4*)(sb_ + 64 * G_ROWB) = S##a1; \
    char* sc_ = sb_ + G_ABYTES; *(uint4*)(sc_) = S##b0; *(uint4*)(sc_ + 64 * G_ROWB) = S##b1; *(uint4*)(sc_ + 128 * G_ROWB) = S##b2; *(uint4*)(sc_ + 192 * G_ROWB) = S##b3; }
#define G_COMPUTE(buf) { const char* sb = smem + (buf) * G_STAGE; _Pragma("unroll") for (int s = 0; s < 4; s++) { \
      const bf16x8 a0 = *(const bf16x8*)(sb + aoff + s * 32); const bf16x8 a1 = *(const bf16x8*)(sb + aoff + 32 * G_ROWB + s * 32); \
      const bf16x8 b0 = *(const bf16x8*)(sb + boff + s * 32); const bf16x8 b1 = *(const bf16x8*)(sb + boff + 32 * G_ROWB + s * 32); \
      acc00 = mfma32(a0, b0, acc00); acc01 = mfma32(a0, b1, acc01); acc10 = mfma32(a1, b0, acc10); acc11 = mfma32(a1, b1, acc11); } }
  const int nk = K >> 6;
  const int aoff = (wm * 64 + r) * G_ROWB + hh * 16;
  const int boff = G_ABYTES + (wn * 64 + r) * G_ROWB + hh * 16;
  G_LOAD(p, 0); G_LOAD(q, 64);
  __syncthreads();
  G_STORE(p, 0);
  __syncthreads();
  for (int kt = 0; kt < nk; kt += 2) {
    if (kt + 2 < nk) G_LOAD(p, (kt + 2) * 64);
    G_COMPUTE(0);
    G_STORE(q, 1);
    __syncthreads();
    if (kt + 3 < nk) G_LOAD(q, (kt + 3) * 64);
    G_COMPUTE(1);
    if (kt + 2 < nk) G_STORE(p, 0);
    __syncthreads();
  }
#undef G_LOAD
#undef G_STORE
#undef G_COMPUTE
  {
    float* stage = (float*)(smem + wave * (64 * G_SROW * 4));
#pragma unroll
    for (int reg = 0; reg < 16; reg++) {
      const int row = (reg & 3) + 8 * (reg >> 2) + 4 * hh;
      stage[row * G_SROW + r] = acc00[reg];
      stage[row * G_SROW + 32 + r] = acc01[reg];
      stage[(32 + row) * G_SROW + r] = acc10[reg];
      stage[(32 + row) * G_SROW + 32 + r] = acc11[reg];
    }
    epi.apply(stage, wm * 64, wn * 64, lane);
  }
}

DEV void ld16(const float* src, float* x) {
  const float4 a = *(const float4*)src, b = *(const float4*)(src + 4), c = *(const float4*)(src + 8), d = *(const float4*)(src + 12);
  x[0] = a.x; x[1] = a.y; x[2] = a.z; x[3] = a.w; x[4] = b.x; x[5] = b.y; x[6] = b.z; x[7] = b.w;
  x[8] = c.x; x[9] = c.y; x[10] = c.z; x[11] = c.w; x[12] = d.x; x[13] = d.y; x[14] = d.z; x[15] = d.w;
}
DEV void st16_bf(u16* dst, const float* x) {
  *(uint4*)dst = make_uint4(pack2(x[0], x[1]), pack2(x[2], x[3]), pack2(x[4], x[5]), pack2(x[6], x[7]));
  *(uint4*)(dst + 8) = make_uint4(pack2(x[8], x[9]), pack2(x[10], x[11]), pack2(x[12], x[13]), pack2(x[14], x[15]));
}
DEV void st16_f(float* dst, const float* x) {
  *(float4*)dst = make_float4(x[0], x[1], x[2], x[3]); *(float4*)(dst + 4) = make_float4(x[4], x[5], x[6], x[7]);
  *(float4*)(dst + 8) = make_float4(x[8], x[9], x[10], x[11]); *(float4*)(dst + 12) = make_float4(x[12], x[13], x[14], x[15]);
}

struct EpiInProj {
  const Params* p; int m0, n0;
  DEV void apply(const float* stage, int rbase, int cbase, int lane) { apply_s<G_SROW>(stage, rbase, cbase, lane); }
  template <int SROW>
  DEV void apply_s(const float* stage, int rbase, int cbase, int lane) {
    const int nb = n0 + cbase;
    unsigned char* ws = p->ws;
    const int tb = m0 + rbase;
    if (nb < 640 || (nb >= 768 && nb < 1344)) {
      u16* dst; int ld, cb;
      if (nb < 512) { dst = (u16*)(ws + OFF_Q); ld = 512; cb = nb; }
      else if (nb < 640) { dst = (u16*)(ws + OFF_K); ld = 128; cb = nb - 512; }
      else if (nb < 1280) { dst = (u16*)(ws + OFF_QI); ld = 512; cb = nb - 768; }
      else { dst = (u16*)(ws + OFF_KI); ld = 64; cb = 0; }
      const float* cosT = (const float*)(ws + OFF_COS); const float* sinT = (const float*)(ws + OFF_SIN);
      const int cg = lane & 1;
#pragma unroll 1
      for (int i = 0; i < 2; i++) {
        const int row = (lane >> 1) + 32 * i; const int t = tb + row;
        float x1[16], x2[16], cs[16], sn[16], o1[16], o2[16];
        ld16(stage + row * SROW + cg * 16, x1); ld16(stage + row * SROW + 32 + cg * 16, x2);
        ld16(cosT + (size_t)t * 32 + cg * 16, cs); ld16(sinT + (size_t)t * 32 + cg * 16, sn);
#pragma unroll
        for (int k = 0; k < 16; k++) { o1[k] = x1[k] * cs[k] - x2[k] * sn[k]; o2[k] = x2[k] * cs[k] + x1[k] * sn[k]; }
        st16_bf(dst + (size_t)t * ld + cb + cg * 16, o1); st16_bf(dst + (size_t)t * ld + cb + 32 + cg * 16, o2);
      }
    } else if (nb >= 640 && nb < 768) {
      u16* vt = (u16*)(ws + OFF_VT);
      const int kvh = (nb - 640) >> 6;
      const int b = tb >> 11, s0 = tb & 2047;
      u16* dp = vt + ((size_t)(b * 2 + kvh) * 64 + lane) * SV_ + s0;
#pragma unroll 1
      for (int q8 = 0; q8 < 8; q8++) {
        float x[8];
#pragma unroll
        for (int k = 0; k < 8; k++) x[k] = stage[(q8 * 8 + k) * SROW + lane];
        *(uint4*)(dp + q8 * 8) = make_uint4(pack2(x[0], x[1]), pack2(x[2], x[3]), pack2(x[4], x[5]), pack2(x[6], x[7]));
      }
    } else if (nb >= 1344 && nb < 2880) {
      u16* dst; int ld, cb;
      if (nb < 1856) { dst = (u16*)(ws + OFF_Z); ld = 512; cb = nb - 1344; }
      else { dst = (u16*)(ws + OFF_XBC); ld = 1024; cb = nb - 1856; }
      const int cg = lane & 1;
#pragma unroll 1
      for (int i = 0; i < 2; i++) {
        const int row = (lane >> 1) + 32 * i; const int t = tb + row;
        float x1[16], x2[16];
        ld16(stage + row * SROW + cg * 16, x1); ld16(stage + row * SROW + 32 + cg * 16, x2);
        st16_bf(dst + (size_t)t * ld + cb + cg * 16, x1); st16_bf(dst + (size_t)t * ld + cb + 32 + cg * 16, x2);
      }
    } else if (nb == 2880) {
      float* wi = (float*)(ws + OFF_WI); float* dtr = (float*)(ws + OFF_DT);
      const int t = tb + lane;
      float x[16];
      ld16(stage + lane * SROW, x);
      const float sc = 0.044194173824159216f;
      *(float4*)(wi + (size_t)t * 8) = make_float4(x[0] * sc, x[1] * sc, x[2] * sc, x[3] * sc);
      *(float4*)(wi + (size_t)t * 8 + 4) = make_float4(x[4] * sc, x[5] * sc, x[6] * sc, x[7] * sc);
      *(float4*)(dtr + (size_t)t * 8) = make_float4(x[8], x[9], x[10], x[11]);
      *(float4*)(dtr + (size_t)t * 8 + 4) = make_float4(x[12], x[13], x[14], x[15]);
    }
  }
};

struct EpiStoreF32 {
  float* dst; int n0;
  DEV void apply(const float* stage, int rbase, int cbase, int lane) {
    const int cg = lane & 1;
#pragma unroll 1
    for (int i = 0; i < 2; i++) {
      const int row = (lane >> 1) + 32 * i;
      float x1[16], x2[16];
      ld16(stage + row * G_SROW + cg * 16, x1); ld16(stage + row * G_SROW + 32 + cg * 16, x2);
      float* d = dst + (size_t)(rbase + row) * 1024 + n0 + cbase + cg * 16;
      st16_f(d, x1); st16_f(d + 32, x2);
    }
  }
};
struct EpiStoreBf16 {
  u16* dst; int n0;
  DEV void apply(const float* stage, int rbase, int cbase, int lane) {
    const int cg = lane & 1;
#pragma unroll 1
    for (int i = 0; i < 2; i++) {
      const int row = (lane >> 1) + 32 * i;
      float x1[16], x2[16];
      ld16(stage + row * G_SROW + cg * 16, x1); ld16(stage + row * G_SROW + 32 + cg * 16, x2);
      u16* d = dst + (size_t)(rbase + row) * 1024 + n0 + cbase + cg * 16;
      st16_bf(d, x1); st16_bf(d + 32, x2);
    }
  }
};

typedef __attribute__((ext_vector_type(4))) float f32x4v;
constexpr int P8_HT = 128 * 64;
constexpr int P8_SROW = 260;
DEV int p8_lds_byte(int r, int c) {
  const int st = (r >> 4) * 2 + (c >> 5), rr = r & 15, cc = c & 31, ob = rr * 64 + cc * 2;
  return st * 1024 + (ob ^ (((ob >> 9) & 1) << 5));
}
DEV void p8_stage_rc(int b, int& R, int& C) {
  const int st = b / 1024, sb = b % 1024, swz = sb ^ (((sb >> 9) & 1) << 5);
  R = (st >> 1) * 16 + swz / 64; C = (st & 1) * 32 + (swz % 64) / 2;
}
template <class Epi>
DEV void gemm256_8phase(const u16* __restrict__ A, const u16* __restrict__ Bt, int brow, int bcol, char* smem, Epi& epi) {
  constexpr int K = 1024, BK = 64, HALF = 128;
  u16* shm = (u16*)smem;
  const int tid = opaque_tid();
#define SA(b,h) (shm+((b)*2+(h))*P8_HT)
#define SB(b,h) (shm+(4+(b)*2+(h))*P8_HT)
#define P8STAGE(P,BASE,br,kt) do{ const long _g=(long)(br)*K+(long)(kt)*BK; \
    _Pragma("unroll") for(int _i=0;_i<2;++_i){ const int _b=tid*16+_i*8192; int _r,_c; p8_stage_rc(_b,_r,_c); \
      __builtin_amdgcn_global_load_lds((const unsigned*)(BASE+_g+(long)_r*K+_c), (__attribute__((address_space(3))) unsigned*)((char*)(P)+_b),16,0,0);} }while(0)
#define LDA(dst,b,h) _Pragma("unroll") for(int m=0;m<4;++m) _Pragma("unroll") for(int k=0;k<2;++k) \
    dst[m][k]=*reinterpret_cast<const bf16x8*>((char*)SA(b,h)+p8_lds_byte(wr*64+m*16+fr,k*32+fq*8))
#define LDB(dst,b,h) _Pragma("unroll") for(int n=0;n<2;++n) _Pragma("unroll") for(int k=0;k<2;++k) \
    dst[n][k]=*reinterpret_cast<const bf16x8*>((char*)SB(b,h)+p8_lds_byte(wc*32+n*16+fr,k*32+fq*8))
#define MMA(ai,bj,At,Bt_) do{ __builtin_amdgcn_s_setprio(1); \
    _Pragma("unroll") for(int m=0;m<4;++m) _Pragma("unroll") for(int n=0;n<2;++n) _Pragma("unroll") for(int k=0;k<2;++k) \
      acc[ai][bj][m][n]=__builtin_amdgcn_mfma_f32_16x16x32_bf16(At[m][k],Bt_[n][k],acc[ai][bj][m][n],0,0,0); \
    __builtin_amdgcn_s_setprio(0);}while(0)
#define WAIT_V(n) asm volatile("s_waitcnt vmcnt(" #n ")":::"memory")
#define WAIT_L(n) asm volatile("s_waitcnt lgkmcnt(" #n ")":::"memory")
#define BAR __builtin_amdgcn_s_barrier()
#define SCHED __builtin_amdgcn_sched_barrier(0)
  const int wid = __builtin_amdgcn_readfirstlane(tid >> 6), lane = tid & 63, wr = wid >> 2, wc = wid & 3, fr = lane & 15, fq = lane >> 4;
  f32x4v acc[2][2][4][2];
#pragma unroll
  for (int a_ = 0; a_ < 2; a_++)
#pragma unroll
    for (int b_ = 0; b_ < 2; b_++)
#pragma unroll
      for (int m = 0; m < 4; m++)
#pragma unroll
        for (int n = 0; n < 2; n++) acc[a_][b_][m][n] = (f32x4v){0.f, 0.f, 0.f, 0.f};
  bf16x8 At[4][2], B0[2][2], B1[2][2];
  constexpr int nt = K / BK;
  asm volatile("s_waitcnt vmcnt(0) lgkmcnt(0)" ::: "memory");
  __syncthreads();
  P8STAGE(SB(0,0),Bt,bcol,0); P8STAGE(SA(0,0),A,brow,0);
  P8STAGE(SB(0,1),Bt,bcol+HALF,0); P8STAGE(SA(0,1),A,brow+HALF,0);
  if(wr==1)BAR;
  WAIT_V(4); BAR;
  P8STAGE(SB(1,0),Bt,bcol,1); P8STAGE(SA(1,0),A,brow,1); P8STAGE(SB(1,1),Bt,bcol+HALF,1);
  WAIT_V(6); BAR;
#pragma unroll 1
  for(int t=0;t<nt-2;t+=2){
    LDB(B0,0,0); SCHED; LDA(At,0,0); P8STAGE(SA(1,1),A,brow+HALF,t+1);
    WAIT_L(8); BAR; WAIT_L(0); MMA(0,0,At,B0); BAR; SCHED;
    LDB(B1,0,1); P8STAGE(SB(0,0),Bt,bcol,t+2);
    BAR; WAIT_L(0); MMA(0,1,At,B1); BAR;
    LDA(At,0,1); P8STAGE(SA(0,0),A,brow,t+2);
    BAR; WAIT_L(0); MMA(1,0,At,B0); BAR; SCHED;
    P8STAGE(SB(0,1),Bt,bcol+HALF,t+2);
    WAIT_V(6); BAR; MMA(1,1,At,B1); BAR;
    LDB(B0,1,0); SCHED; LDA(At,1,0); P8STAGE(SA(0,1),A,brow+HALF,t+2);
    WAIT_L(8); BAR; WAIT_L(0); MMA(0,0,At,B0); BAR; SCHED;
    LDB(B1,1,1); P8STAGE(SB(1,0),Bt,bcol,t+3);
    BAR; WAIT_L(0); MMA(0,1,At,B1); BAR;
    LDA(At,1,1); P8STAGE(SA(1,0),A,brow,t+3);
    BAR; WAIT_L(0); MMA(1,0,At,B0); BAR; SCHED;
    P8STAGE(SB(1,1),Bt,bcol+HALF,t+3);
    WAIT_V(6); BAR; MMA(1,1,At,B1); BAR;
  }
  { LDB(B0,0,0); LDA(At,0,0); P8STAGE(SA(1,1),A,brow+HALF,nt-1);
    BAR; WAIT_L(0); MMA(0,0,At,B0); BAR;
    LDB(B1,0,1); BAR; WAIT_L(0); MMA(0,1,At,B1); BAR;
    LDA(At,0,1); WAIT_V(4); BAR; WAIT_L(0); MMA(1,0,At,B0); MMA(1,1,At,B1); BAR; }
  { LDB(B0,1,0); LDA(At,1,0); WAIT_V(2); BAR; WAIT_L(0); MMA(0,0,At,B0); BAR;
    LDB(B1,1,1); WAIT_V(0); BAR; WAIT_L(0); MMA(0,1,At,B1); BAR;
    LDA(At,1,1); BAR; WAIT_L(0); MMA(1,0,At,B0); MMA(1,1,At,B1); BAR; }
  if(wr==0)BAR;
  float* img = (float*)smem;
#pragma unroll
  for (int ai = 0; ai < 2; ai++) {
    __syncthreads();
#pragma unroll
    for (int bj = 0; bj < 2; bj++)
#pragma unroll
      for (int m = 0; m < 4; m++)
#pragma unroll
        for (int n = 0; n < 2; n++)
#pragma unroll
          for (int j = 0; j < 4; j++)
            img[(wr * 64 + m * 16 + fq * 4 + j) * P8_SROW + bj * HALF + wc * 32 + n * 16 + fr] = acc[ai][bj][m][n][j];
    __syncthreads();
    epi.template apply_s<P8_SROW>(img + (wid >> 2) * 64 * P8_SROW + (wid & 3) * 64, ai * 128 + (wid >> 2) * 64, (wid & 3) * 64, lane);
  }
  __syncthreads();
#undef SA
#undef SB
#undef P8STAGE
#undef LDA
#undef LDB
#undef MMA
#undef WAIT_V
#undef WAIT_L
#undef BAR
#undef SCHED
}

DEV void phase1(const Params& p, char* smem) {
  const u16* h = (const u16*)(p.ws + OFF_HBUF);
  const u16* wt = (const u16*)(p.ws + OFF_WTIN);
  if (blockIdx.x & 1) convert_i8_rows(p.peer_u, p.ws + OFF_U, (float*)(p.ws + OFF_SU));
  const int ntiles = 128 * 12;
  for (int tile = blockIdx.x; tile < ntiles; tile += gridDim.x) {
    const int mt = tile % 128, nt = tile / 128;
    EpiInProj epi{&p, mt * 256, nt * 256};
    gemm256_8phase(h, wt, mt * 256, nt * 256, smem, epi);
  }
  if (!(blockIdx.x & 1)) convert_i8_rows(p.peer_u, p.ws + OFF_U, (float*)(p.ws + OFF_SU));
}

constexpr int DS_QROW = 1040;
constexpr int DS_CNT = 32 * DS_QROW;
constexpr int DS_MASK = DS_CNT + 2 * 8 * 32 * 4;
constexpr int DS_WQ = DS_MASK + 64 * 64 * 2;
constexpr int DS_KV = DS_WQ + 1024;
constexpr int DS_KVSTAGE = 2 * 32 * 144 + 2 * 64 * 72;
constexpr int DS_VOFF = 2 * 32 * 144;

DEV int dsa_reduce(int c, unsigned* cbuf, int& par, int r, int hh, int w) {
  c += __shfl_xor(c, 32);
  unsigned* bq = cbuf + par * 256;
  if (hh == 0) bq[w * 32 + r] = (unsigned)c;
  __syncthreads();
  int tot = 0;
#pragma unroll
  for (int k = 0; k < 8; k++) tot += (int)bq[k * 32 + r];
  par ^= 1;
  return tot;
}

DEV void dsa_item(const Params& p, int b, int qt, char* smem) {
  const int tid = opaque_tid(), lane = tid & 63, w = __builtin_amdgcn_readfirstlane(tid >> 6), r = lane & 31, hh = lane >> 5;
  const int q0 = qt * 32; const size_t tb = (size_t)b * 2048;
  const u16* qi = (const u16*)(p.ws + OFF_QI);
  const u16* ki = (const u16*)(p.ws + OFF_KI);
  const float* wi = (const float*)(p.ws + OFF_WI);
  unsigned* cbuf = (unsigned*)(smem + DS_CNT);
  u16* maskb = (u16*)(smem + DS_MASK);
  const bool need_sel = (qt >= 8);
  __syncthreads();
  if (need_sel) {
#pragma unroll
    for (int i = 0; i < 4; i++) {
      int c = tid + i * 512; int row = c >> 6, cc = c & 63;
      *(uint4*)(smem + row * DS_QROW + cc * 16) = *(const uint4*)(qi + (tb + q0 + row) * 512 + cc * 8);
    }
    if (tid < 256) ((float*)(smem + DS_WQ))[tid] = wi[(tb + q0) * 8 + tid];
  }
  __syncthreads();
  if (need_sel) {
    const float* wql = (const float*)(smem + DS_WQ) + r * 8;
    u32x16 uk[8];
#pragma unroll
    for (int i = 0; i < 8; i++) {
      const int kt = w + 8 * i;
      if (kt <= qt) {
        const u16* kp = ki + (tb + kt * 32 + r) * 64 + hh * 8;
        bf16x8 ka[4];
#pragma unroll
        for (int s = 0; s < 4; s++) ka[s] = *(const bf16x8*)(kp + s * 16);
        f32x16 scr = zero16();
#pragma unroll 2
        for (int h8 = 0; h8 < 8; h8++) {
          f32x16 a = zero16();
          const char* qrow = smem + r * DS_QROW + h8 * 128 + hh * 16;
#pragma unroll
          for (int s = 0; s < 4; s++) {
            const bf16x8 qb = *(const bf16x8*)(qrow + s * 32);
            a = mfma32(ka[s], qb, a);
          }
          const float wv = wql[h8];
#pragma unroll
          for (int reg = 0; reg < 16; reg++) scr[reg] = fmaf(wv, fmaxf(a[reg], 0.f), scr[reg]);
        }
#pragma unroll
        for (int reg = 0; reg < 16; reg++) {
          float v = scr[reg];
          if (kt == qt && ((reg & 3) + 8 * (reg >> 2)) > r - 4 * hh) v = NEG_INF;
          uk[i][reg] = ordkey(v);
        }
      } else {
#pragma unroll
        for (int reg = 0; reg < 16; reg++) uk[i][reg] = 0u;
      }
    }
    int par = 0;
    unsigned T = 0u;
    unsigned* lst = (unsigned*)(smem + DS_KV);
    unsigned* lcnt = (unsigned*)(smem + DS_KV + 16384);
    unsigned* lhic = lcnt + 32;
    unsigned* ltp = lcnt + 64;
    for (int rep_b = 0; rep_b < PROBE_DSA_BIS; rep_b++) {
    T = 0u;
    if (tid < 32) lcnt[tid] = 0u;
    for (int it = 0; it < 12; ++it) {
      const unsigned cand = T | (0x80000000u >> it);
      int c = 0;
#pragma unroll
      for (int i = 0; i < 8; i++) {
        if (w + 8 * i <= qt) {
#pragma unroll
          for (int reg = 0; reg < 16; reg++) c += (uk[i][reg] >= cand) ? 1 : 0;
        }
      }
      if (dsa_reduce(c, cbuf, par, r, hh, w) >= 256) T = cand;
    }
    int hic;
    {
      const bool ovf = (T >= 0xFFF00000u);
      const unsigned hi = T + 0x00100000u;
      int c = 0;
      if (!ovf) {
#pragma unroll
        for (int i = 0; i < 8; i++) {
          if (w + 8 * i <= qt) {
#pragma unroll
            for (int reg = 0; reg < 16; reg++) c += (uk[i][reg] >= hi) ? 1 : 0;
          }
        }
      }
      hic = dsa_reduce(c, cbuf, par, r, hh, w);
    }
#pragma unroll
    for (int i = 0; i < 8; i++) {
      if (w + 8 * i <= qt) {
#pragma unroll
        for (int reg = 0; reg < 16; reg++) {
          const unsigned d = uk[i][reg] - T;
          if (d < 0x00100000u) { const unsigned pos = atomicAdd(&lcnt[r], 1u); if (pos < 128u) lst[r * 128 + pos] = d; }
        }
      }
    }
    if (w == 0 && hh == 0) { lhic[r] = (unsigned)hic; ltp[r] = T; }
    __syncthreads();
    if (!__syncthreads_or(lcnt[r] > 128u)) {
      const int qsub = lane >> 4, l16 = lane & 15, q = 4 * w + qsub;
      const int n = (int)lcnt[q];
      const int kp = 256 - (int)lhic[q];
      unsigned v[8];
#pragma unroll
      for (int j = 0; j < 8; j++) { const int ix = l16 + 16 * j; v[j] = (ix < n) ? lst[q * 128 + ix] : 0u; }
      unsigned Tl = 0u;
#pragma unroll 1
      for (int bit = 19; bit >= 0; --bit) {
        const unsigned cand = Tl | (1u << bit);
        int c = 0;
#pragma unroll
        for (int j = 0; j < 8; j++) c += (v[j] >= cand) ? 1 : 0;
        c += __builtin_amdgcn_update_dpp(0, c, 0xB1, 0xF, 0xF, false);
        c += __builtin_amdgcn_update_dpp(0, c, 0x4E, 0xF, 0xF, false);
        c += __builtin_amdgcn_update_dpp(0, c, 0x141, 0xF, 0xF, false);
        c += __builtin_amdgcn_update_dpp(0, c, 0x140, 0xF, 0xF, false);
        if (c >= kp) Tl = cand;
      }
      const unsigned tq = ltp[q] | Tl;
      __syncthreads();
      if (l16 == 0) ltp[q] = tq;
      __syncthreads();
      T = ltp[r];
    } else {
      for (int it = 12; it < 32; ++it) {
        const unsigned cand = T | (0x80000000u >> it);
        int c = 0;
#pragma unroll
        for (int i = 0; i < 8; i++) {
          if (w + 8 * i <= qt) {
#pragma unroll
            for (int reg = 0; reg < 16; reg++) c += (uk[i][reg] >= cand) ? 1 : 0;
          }
        }
        if (dsa_reduce(c, cbuf, par, r, hh, w) >= 256) T = cand;
      }
    }
    }
    int cge;
    {
      int c = 0;
      unsigned Tv = T;
      asm volatile("" : "+v"(Tv));
#pragma unroll
      for (int i = 0; i < 8; i++) {
        if (w + 8 * i <= qt) {
#pragma unroll
          for (int reg = 0; reg < 16; reg++) c += (uk[i][reg] >= Tv) ? 1 : 0;
        }
      }
      cge = dsa_reduce(c, cbuf, par, r, hh, w);
    }
    unsigned J = 4095u;
    if (__syncthreads_or(cge != 256)) {
      int need;
      {
        int c = 0;
        unsigned Tv = T;
        asm volatile("" : "+v"(Tv));
#pragma unroll
        for (int i = 0; i < 8; i++) {
          if (w + 8 * i <= qt) {
#pragma unroll
            for (int reg = 0; reg < 16; reg++) c += (uk[i][reg] > Tv) ? 1 : 0;
          }
        }
        need = 256 - dsa_reduce(c, cbuf, par, r, hh, w);
      }
      J = 0u;
      for (int it = 0; it < 12; ++it) {
        const unsigned cj = J | (2048u >> it);
        int c = 0;
        unsigned Tv = T;
        asm volatile("" : "+v"(Tv));
#pragma unroll
        for (int i = 0; i < 8; i++) {
          if (w + 8 * i <= qt) {
            const int lim = (int)cj - ((w + 8 * i) * 32 + 4 * hh);
#pragma unroll
            for (int reg = 0; reg < 16; reg++) c += (uk[i][reg] == Tv && ((reg & 3) + 8 * (reg >> 2)) < lim) ? 1 : 0;
          }
        }
        if (dsa_reduce(c, cbuf, par, r, hh, w) <= need) J = cj;
      }
    }
#pragma unroll
    for (int i = 0; i < 8; i++) {
      const int kt = w + 8 * i;
      if (kt <= qt) {
        const int lim = (int)J - (kt * 32 + 4 * hh);
        unsigned bits = 0u;
#pragma unroll
        for (int reg = 0; reg < 16; reg++) {
          const unsigned u = uk[i][reg];
          const bool sel = (u > T) || (u == T && ((reg & 3) + 8 * (reg >> 2)) < lim);
          bits |= (sel ? 1u : 0u) << reg;
        }
        maskb[kt * 64 + lane] = (u16)bits;
      }
    }
  } else {
#pragma unroll
    for (int i = 0; i < 8; i++) {
      const int kt = w + 8 * i;
      if (kt <= qt) {
        unsigned bits = 0xFFFFu;
        if (kt == qt) {
          bits = 0u;
#pragma unroll
          for (int reg = 0; reg < 16; reg++) bits |= ((((reg & 3) + 8 * (reg >> 2)) <= r - 4 * hh) ? 1u : 0u) << reg;
        }
        maskb[kt * 64 + lane] = (u16)bits;
      }
    }
  }
  for (int rep_a = 0; rep_a < PROBE_DSA_ATT; rep_a++)
  {
    const int head = w, kvh = w >> 2;
    const u16* q = (const u16*)(p.ws + OFF_Q);
    const u16* kk = (const u16*)(p.ws + OFF_K);
    const u16* vt = (const u16*)(p.ws + OFF_VT);
    bf16x8 qf[4];
    {
      const u16* qp = q + (tb + q0 + r) * 512 + head * 64 + hh * 8;
#pragma unroll
      for (int s = 0; s < 4; s++) qf[s] = *(const bf16x8*)(qp + s * 16);
    }
    const int l_kvh = tid >> 8;
    const int k_row = (tid >> 3) & 31, k_ch = tid & 7;
    const int v_d = (tid >> 2) & 63, v_ch = tid & 3;
    const u16* gk = kk + (tb + k_row) * 128 + l_kvh * 64 + k_ch * 8;
    const u16* gv = vt + ((size_t)(b * 2 + l_kvh) * 64 + v_d) * SV_ + v_ch * 8;
    const int lk = DS_KV + l_kvh * (32 * 144) + k_row * 144 + k_ch * 16;
    const int lv = DS_KV + DS_VOFF + l_kvh * (64 * 72) + v_d * 72 + v_ch * 16;
    const int fk = DS_KV + kvh * (32 * 144) + r * 144 + hh * 16;
    const int fv = DS_KV + DS_VOFF + kvh * (64 * 72) + r * 72 + hh * 8;
    const int nsteps = (qt + 2) >> 1;
    uint4 rkA, rvA, rkB, rvB;
#define AT_LOAD(j_) { const int ka_ = 2 * (j_), kb_ = (2 * (j_) + 1 <= qt) ? 2 * (j_) + 1 : qt; \
      rkA = *(const uint4*)(gk + (size_t)ka_ * 32 * 128); rvA = *(const uint4*)(gv + ka_ * 32); \
      rkB = *(const uint4*)(gk + (size_t)kb_ * 32 * 128); rvB = *(const uint4*)(gv + kb_ * 32); }
#define AT_STORE(sb_) { char* d_ = smem + (sb_) * (2 * DS_KVSTAGE); \
      *(uint4*)(d_ + lk) = rkA; *(uint2*)(d_ + lv) = make_uint2(rvA.x, rvA.y); *(uint2*)(d_ + lv + 8) = make_uint2(rvA.z, rvA.w); \
      *(uint4*)(d_ + DS_KVSTAGE + lk) = rkB; *(uint2*)(d_ + DS_KVSTAGE + lv) = make_uint2(rvB.x, rvB.y); *(uint2*)(d_ + DS_KVSTAGE + lv + 8) = make_uint2(rvB.z, rvB.w); }
    AT_LOAD(0);
    __syncthreads();
    AT_STORE(0);
    __syncthreads();
    f32x16 o0 = zero16(), o1 = zero16();
    float m = NEG_INF, l = 0.f;
    const float SC = 0.125f * 1.4426950408889634f;
    for (int j = 0; j < nsteps; ++j) {
      const char* stg = smem + (j & 1) * (2 * DS_KVSTAGE);
      if (j + 1 < nsteps) AT_LOAD(j + 1);
      f32x16 sa = zero16(), sb = zero16();
#pragma unroll
      for (int s = 0; s < 4; s++) {
        const bf16x8 kfa = *(const bf16x8*)(stg + fk + s * 32);
        const bf16x8 kfb = *(const bf16x8*)(stg + DS_KVSTAGE + fk + s * 32);
        sa = mfma32(kfa, qf[s], sa); sb = mfma32(kfb, qf[s], sb);
      }
      const unsigned bitsA = maskb[(2 * j) * 64 + lane];
      const unsigned bitsB = (2 * j + 1 <= qt) ? (unsigned)maskb[(2 * j + 1) * 64 + lane] : 0u;
#pragma unroll
      for (int reg = 0; reg < 16; reg++) { sa[reg] = ((bitsA >> reg) & 1u) ? sa[reg] : NEG_INF; sb[reg] = ((bitsB >> reg) & 1u) ? sb[reg] : NEG_INF; }
      float tmax = fmaxf(fmaxf(sa[0], sb[0]), fmaxf(sa[1], sb[1]));
#pragma unroll
      for (int reg = 2; reg < 16; reg += 2) tmax = fmaxf(tmax, fmaxf(fmaxf(sa[reg], sb[reg]), fmaxf(sa[reg + 1], sb[reg + 1])));
      tmax = fmaxf(tmax, __shfl_xor(tmax, 32));
      const float mn = fmaxf(m, tmax);
      const float ms = (mn == NEG_INF) ? 0.f : mn;
      const float nmsc = -ms * SC;
      float ps = 0.f, ps2 = 0.f;
#pragma unroll
      for (int reg = 0; reg < 16; reg++) {
        const float pa = __builtin_amdgcn_exp2f(fmaf(sa[reg], SC, nmsc)), pb = __builtin_amdgcn_exp2f(fmaf(sb[reg], SC, nmsc));
        sa[reg] = pa; sb[reg] = pb; ps += pa; ps2 += pb;
      }
      if (__any(mn != m)) {
        const float alpha = __builtin_amdgcn_exp2f(fmaf(m, SC, nmsc));
        l *= alpha;
#pragma unroll
        for (int reg = 0; reg < 16; reg++) { o0[reg] *= alpha; o1[reg] *= alpha; }
      }
      l += ps + ps2; m = mn;
      {
        const bf16x8 pf0 = pack_frag(sa, 0), pf1 = pack_frag(sa, 8);
        const char* vb = stg + fv;
        const bf16x8 v00 = mk_frag(*(const uint2*)(vb), *(const uint2*)(vb + 16));
        const bf16x8 v01 = mk_frag(*(const uint2*)(vb + 32), *(const uint2*)(vb + 48));
        const bf16x8 v10 = mk_frag(*(const uint2*)(vb + 32 * 72), *(const uint2*)(vb + 32 * 72 + 16));
        const bf16x8 v11 = mk_frag(*(const uint2*)(vb + 32 * 72 + 32), *(const uint2*)(vb + 32 * 72 + 48));
        o0 = mfma32(v00, pf0, o0); o1 = mfma32(v10, pf0, o1);
        o0 = mfma32(v01, pf1, o0); o1 = mfma32(v11, pf1, o1);
      }
      {
        const bf16x8 pf0 = pack_frag(sb, 0), pf1 = pack_frag(sb, 8);
        const char* vb = stg + DS_KVSTAGE + fv;
        const bf16x8 v00 = mk_frag(*(const uint2*)(vb), *(const uint2*)(vb + 16));
        const bf16x8 v01 = mk_frag(*(const uint2*)(vb + 32), *(const uint2*)(vb + 48));
        const bf16x8 v10 = mk_frag(*(const uint2*)(vb + 32 * 72), *(const uint2*)(vb + 32 * 72 + 16));
        const bf16x8 v11 = mk_frag(*(const uint2*)(vb + 32 * 72 + 32), *(const uint2*)(vb + 32 * 72 + 48));
        o0 = mfma32(v00, pf0, o0); o1 = mfma32(v10, pf0, o1);
        o0 = mfma32(v01, pf1, o0); o1 = mfma32(v11, pf1, o1);
      }
      if (j + 1 < nsteps) AT_STORE((j + 1) & 1);
      __syncthreads();
    }
#undef AT_LOAD
#undef AT_STORE
    const float lt = l + __shfl_xor(l, 32);
    const float inv = 1.f / lt;
    u16* cat = (u16*)(p.ws + OFF_HBUF);
    u16* op = cat + (tb + q0 + r) * 1024 + head * 64 + 4 * hh;
#pragma unroll
    for (int gq = 0; gq < 4; gq++) {
      *(uint2*)(op + 8 * gq) = make_uint2(pack2(o0[4 * gq] * inv, o0[4 * gq + 1] * inv), pack2(o0[4 * gq + 2] * inv, o0[4 * gq + 3] * inv));
      *(uint2*)(op + 32 + 8 * gq) = make_uint2(pack2(o1[4 * gq] * inv, o1[4 * gq + 1] * inv), pack2(o1[4 * gq + 2] * inv, o1[4 * gq + 3] * inv));
    }
  }
}

constexpr int SA_ROW = 272;
constexpr int SA_XROW = 144;
constexpr int SA_C = 0, SA_B = 128 * SA_ROW;
constexpr int SA_XDT = 2 * 128 * SA_ROW;
constexpr int SA_XDS = SA_XDT + 128 * SA_XROW;
constexpr int SA_FL = SA_XDS + 128 * SA_XROW;

DEV float silu_fast(float v) { return v * __builtin_amdgcn_rcpf(1.f + __builtin_amdgcn_exp2f(-1.4426950408889634f * v)); }

DEV void conv_pair8(const u16* __restrict__ xbc, const float* __restrict__ cw, const float* __restrict__ cbias, size_t tb, int pos0, int ch, float* o0, float* o1) {
  const float2 w0 = *(const float2*)(cw + ch), w1 = *(const float2*)(cw + 1024 + ch), w2 = *(const float2*)(cw + 2048 + ch), w3 = *(const float2*)(cw + 3072 + ch);
  const float2 bs = *(const float2*)(cbias + ch);
  unsigned xr[11];
#pragma unroll
  for (int j = 0; j < 11; j++) { const int sp = pos0 - 3 + j; xr[j] = (sp >= 0) ? *(const unsigned*)(xbc + (tb + sp) * 1024 + ch) : 0u; }
#pragma unroll
  for (int j = 0; j < 8; j++) {
    float a = bs.x, c = bs.y;
    a = fmaf(w0.x, bflo(xr[j]), a); c = fmaf(w0.y, bfhi(xr[j]), c);
    a = fmaf(w1.x, bflo(xr[j + 1]), a); c = fmaf(w1.y, bfhi(xr[j + 1]), c);
    a = fmaf(w2.x, bflo(xr[j + 2]), a); c = fmaf(w2.y, bfhi(xr[j + 2]), c);
    a = fmaf(w3.x, bflo(xr[j + 3]), a); c = fmaf(w3.y, bfhi(xr[j + 3]), c);
    o0[j] = silu_fast(a); o1[j] = silu_fast(c);
  }
}

DEV bf16x8 gather8(const char* base, int stride, bool perm) {
  unsigned v[8];
#pragma unroll
  for (int j = 0; j < 8; j++) { const int row = perm ? ((j & 3) + 8 * (j >> 2)) : j; v[j] = *(const u16*)(base + row * stride); }
  union { uint4 u; bf16x8 f; } t;
  t.u = make_uint4(v[0] | (v[1] << 16), v[2] | (v[3] << 16), v[4] | (v[5] << 16), v[6] | (v[7] << 16));
  return t.f;
}

DEV void ssdA_item(const Params& p, int b, int c, int g, char* smem) {
  const int tid = opaque_tid(), lane = tid & 63, w = __builtin_amdgcn_readfirstlane(tid >> 6), r = lane & 31, hh = lane >> 5;
  const size_t tb = (size_t)b * 2048;
  const u16* xbc = (const u16*)(p.ws + OFF_XBC);
  const float* dtraw = (const float*)(p.ws + OFF_DT);
  __syncthreads();
  {
    u16* ccg = (u16*)(p.ws + OFF_CC);
#pragma unroll 1
    for (int k = 0; k < 4; k++) {
      const int e = tid + k * 512;
      const int pr = e & 63, lb = (e >> 6) & 15, which = e >> 10;
      const int n = 2 * pr, l0 = lb * 8;
      float o0[8], o1[8];
      conv_pair8(xbc, p.conv_w, p.conv_b, tb, c * 128 + l0, 512 + which * 256 + g * 128 + n, o0, o1);
      char* dst = smem + (which ? SA_C : SA_B) + l0 * SA_ROW + n * 2;
#pragma unroll
      for (int j = 0; j < 8; j++) {
        const unsigned pk = pack2(o0[j], o1[j]);
        *(unsigned*)(dst + j * SA_ROW) = pk;
        if (which) *(unsigned*)(ccg + (tb + c * 128 + l0 + j) * 256 + g * 128 + n) = pk;
      }
    }
  }
  if (w < 4) {
    const int h = g * 4 + w;
    float* dtv_ = (float*)(smem + SA_FL) + w * 384; float* acum_ = dtv_ + 128; float* decs_ = dtv_ + 256;
    {
      const float A = -expf(p.a_log[h]);
      const float bias = p.dt_bias[h];
      float x0 = dtraw[(tb + c * 128 + lane) * 8 + h] + bias;
      float x1 = dtraw[(tb + c * 128 + 64 + lane) * 8 + h] + bias;
      float d0 = (x0 > 20.f) ? x0 : log1pf(expf(x0));
      float d1 = (x1 > 20.f) ? x1 : log1pf(expf(x1));
      dtv_[lane] = d0; dtv_[64 + lane] = d1;
      float v0 = d0 * A, v1 = d1 * A;
#pragma unroll
      for (int o = 1; o < 64; o <<= 1) { float n0 = __shfl_up(v0, o), n1 = __shfl_up(v1, o); if (lane >= o) { v0 += n0; v1 += n1; } }
      const float tot0 = __shfl(v0, 63);
      v1 += tot0;
      acum_[lane] = v0; acum_[64 + lane] = v1;
      const float atot = __shfl(v1, 63);
      decs_[lane] = expf(atot - v0); decs_[64 + lane] = expf(atot - v1);
    }
  }
#pragma unroll 1
  for (int h4 = 0; h4 < 4; h4++) {
    const int h = g * 4 + h4;
    float* dtv = (float*)(smem + SA_FL) + h4 * 384; float* acum = dtv + 128; float* decs = dtv + 256;
    __syncthreads();
    {
      const int pr = tid & 31, lb = tid >> 5;
      const int pp = 2 * pr, l0 = lb * 8;
      float o0[8], o1[8];
      conv_pair8(xbc, p.conv_w, p.conv_b, tb, c * 128 + l0, h * 64 + pp, o0, o1);
#pragma unroll
      for (int j = 0; j < 8; j++) {
        const float d = dtv[l0 + j], ds = decs[l0 + j];
        const float a0 = o0[j] * d, a1 = o1[j] * d;
        *(unsigned*)(smem + SA_XDT + (l0 + j) * SA_XROW + pp * 2) = pack2(a0, a1);
        *(unsigned*)(smem + SA_XDS + (l0 + j) * SA_XROW + pp * 2) = pack2(a0 * ds, a1 * ds);
      }
    }
    __syncthreads();
    {
      const int pt = w & 1, lt = w >> 1;
      const int lidx = lt * 32 + r;
      const float acl = acum[lidx];
      f32x16 yT = zero16();
      for (int st = 0; st <= lt; ++st) {
        f32x16 cb = zero16();
#pragma unroll
        for (int ks = 0; ks < 8; ks++) {
          const bf16x8 a = *(const bf16x8*)(smem + SA_B + (st * 32 + r) * SA_ROW + ks * 32 + hh * 16);
          const bf16x8 bq = *(const bf16x8*)(smem + SA_C + (lt * 32 + r) * SA_ROW + ks * 32 + hh * 16);
          cb = mfma32(a, bq, cb);
        }
#pragma unroll
        for (int reg = 0; reg < 16; reg++) {
          const int sidx = st * 32 + rowmap(reg, hh);
          const float as = acum[sidx];
          cb[reg] = (sidx <= lidx) ? cb[reg] * __builtin_amdgcn_exp2f((acl - as) * 1.4426950408889634f) : 0.f;
        }
        const bf16x8 mf0 = pack_frag(cb, 0), mf1 = pack_frag(cb, 8);
        const char* xb = smem + SA_XDT + (st * 32 + 4 * hh) * SA_XROW + (pt * 32 + r) * 2;
        const bf16x8 x0 = gather8(xb, SA_XROW, true);
        const bf16x8 x1 = gather8(xb + 16 * SA_XROW, SA_XROW, true);
        yT = mfma32(x0, mf0, yT); yT = mfma32(x1, mf1, yT);
      }
      const float dsk = p.d_skip[h] / dtv[lidx];
      float* yp = (float*)(p.ws + OFF_YP) + (tb + c * 128 + lidx) * 512 + h * 64 + pt * 32 + 4 * hh;
#pragma unroll
      for (int gq = 0; gq < 4; gq++) {
        const uint2 xv = *(const uint2*)(smem + SA_XDT + lidx * SA_XROW + (pt * 32 + 8 * gq + 4 * hh) * 2);
        *(float4*)(yp + 8 * gq) = make_float4(yT[4 * gq] + dsk * bflo(xv.x), yT[4 * gq + 1] + dsk * bfhi(xv.x), yT[4 * gq + 2] + dsk * bflo(xv.y), yT[4 * gq + 3] + dsk * bfhi(xv.y));
      }
      const int nt = w >> 1;
      f32x16 sacc = zero16();
#pragma unroll
      for (int ks = 0; ks < 8; ks++) {
        const bf16x8 a = gather8(smem + SA_XDS + (ks * 16 + hh * 8) * SA_XROW + (pt * 32 + r) * 2, SA_XROW, false);
        const bf16x8 bq = gather8(smem + SA_B + (ks * 16 + hh * 8) * SA_ROW + (nt * 32 + r) * 2, SA_ROW, false);
        sacc = mfma32(a, bq, sacc);
      }
      float* stp = (float*)(p.ws + OFF_ST) + ((size_t)((b * 16 + c) * 8 + h) * 64) * 128;
#pragma unroll
      for (int reg = 0; reg < 16; reg++) stp[(pt * 32 + rowmap(reg, hh)) * 128 + nt * 32 + r] = sacc[reg];
      if (tid < 128) ((float*)(p.ws + OFF_ACUM))[((b * 16 + c) * 8 + h) * 128 + tid] = acum[tid];
    }
  }
}

DEV void ssdS_item(const Params& p, int b, int h, int q) {
  const int tid = opaque_tid();
  const float* stb = (const float*)(p.ws + OFF_ST);
  const float* acg = (const float*)(p.ws + OFF_ACUM);
  u16* sin = (u16*)(p.ws + OFF_SIN_ST);
  const int off = q * 2048 + tid * 4;
  float4 S = make_float4(0.f, 0.f, 0.f, 0.f);
  float4 ld[4];
#pragma unroll
  for (int j = 0; j < 4; j++) ld[j] = *(const float4*)(stb + (size_t)((b * 16 + j) * 8 + h) * 8192 + off);
#pragma unroll
  for (int c4 = 0; c4 < 16; c4 += 4) {
    float4 nx[4];
    if (c4 + 4 < 16) {
#pragma unroll
      for (int j = 0; j < 4; j++) nx[j] = *(const float4*)(stb + (size_t)((b * 16 + c4 + 4 + j) * 8 + h) * 8192 + off);
    }
#pragma unroll
    for (int j = 0; j < 4; j++) {
      const int c = c4 + j;
      *(uint2*)(sin + (size_t)((b * 16 + c) * 8 + h) * 8192 + off) = make_uint2(pack2(S.x, S.y), pack2(S.z, S.w));
      const float dec = expf(acg[((b * 16 + c) * 8 + h) * 128 + 127]);
      S.x = fmaf(S.x, dec, ld[j].x); S.y = fmaf(S.y, dec, ld[j].y); S.z = fmaf(S.z, dec, ld[j].z); S.w = fmaf(S.w, dec, ld[j].w);
    }
    if (c4 + 4 < 16) {
#pragma unroll
      for (int j = 0; j < 4; j++) ld[j] = nx[j];
    }
  }
}

DEV void ssdB_item(const Params& p, int b, int c, char* smem) {
  const int tid = opaque_tid(), lane = tid & 63, h = __builtin_amdgcn_readfirstlane(tid >> 6), r = lane & 31, hh = lane >> 5;
  const size_t tb = (size_t)b * 2048;
  const int g = h >> 2;
  float* ssq = (float*)smem;
  const float* acg = (const float*)(p.ws + OFF_ACUM);
  __syncthreads();
  bf16x8 sf[2][8];
  if (c > 0) {
    const u16* sin = (const u16*)(p.ws + OFF_SIN_ST) + (size_t)((b * 16 + c) * 8 + h) * 8192;
#pragma unroll
    for (int pt = 0; pt < 2; pt++)
#pragma unroll
      for (int ks = 0; ks < 8; ks++) sf[pt][ks] = *(const bf16x8*)(sin + (pt * 32 + r) * 128 + ks * 16 + hh * 8);
  }
  const u16* ccg = (const u16*)(p.ws + OFF_CC);
  const u16* zb = (const u16*)(p.ws + OFF_Z);
  const float* ypb = (const float*)(p.ws + OFF_YP);
  u16* cat = (u16*)(p.ws + OFF_HBUF);
#pragma unroll 1
  for (int lt = 0; lt < 4; ++lt) {
    const int lidx = lt * 32 + r;
    const size_t t = tb + c * 128 + lidx;
    f32x16 y0 = zero16(), y1 = zero16();
    if (c > 0) {
#pragma unroll
      for (int ks = 0; ks < 8; ks++) {
        const bf16x8 cf = *(const bf16x8*)(ccg + t * 256 + g * 128 + ks * 16 + hh * 8);
        y0 = mfma32(sf[0][ks], cf, y0); y1 = mfma32(sf[1][ks], cf, y1);
      }
      const float e = expf(acg[((b * 16 + c) * 8 + h) * 128 + lidx]);
#pragma unroll
      for (int reg = 0; reg < 16; reg++) { y0[reg] *= e; y1[reg] *= e; }
    }
    float ss = 0.f;
#pragma unroll
    for (int gq = 0; gq < 4; gq++) {
      const int pb = 8 * gq + 4 * hh;
      const float4 a0 = *(const float4*)(ypb + t * 512 + h * 64 + pb);
      const float4 a1 = *(const float4*)(ypb + t * 512 + h * 64 + 32 + pb);
      const uint2 z0 = *(const uint2*)(zb + t * 512 + h * 64 + pb);
      const uint2 z1 = *(const uint2*)(zb + t * 512 + h * 64 + 32 + pb);
      y0[4 * gq + 0] = (y0[4 * gq + 0] + a0.x) * silu_f(bflo(z0.x)); y0[4 * gq + 1] = (y0[4 * gq + 1] + a0.y) * silu_f(bfhi(z0.x));
      y0[4 * gq + 2] = (y0[4 * gq + 2] + a0.z) * silu_f(bflo(z0.y)); y0[4 * gq + 3] = (y0[4 * gq + 3] + a0.w) * silu_f(bfhi(z0.y));
      y1[4 * gq + 0] = (y1[4 * gq + 0] + a1.x) * silu_f(bflo(z1.x)); y1[4 * gq + 1] = (y1[4 * gq + 1] + a1.y) * silu_f(bfhi(z1.x));
      y1[4 * gq + 2] = (y1[4 * gq + 2] + a1.z) * silu_f(bflo(z1.y)); y1[4 * gq + 3] = (y1[4 * gq + 3] + a1.w) * silu_f(bfhi(z1.y));
#pragma unroll
      for (int j = 0; j < 4; j++) ss += y0[4 * gq + j] * y0[4 * gq + j] + y1[4 * gq + j] * y1[4 * gq + j];
    }
    ss += __shfl_xor(ss, 32);
    if (hh == 0) ssq[(lt * 32 + r) * 8 + h] = ss;
    __syncthreads();
    float tot = 0.f;
#pragma unroll
    for (int k = 0; k < 8; k++) tot += ssq[(lt * 32 + r) * 8 + k];
    const float rstd = rsqrtf(tot * (1.f / 512.f) + 1e-6f);
#pragma unroll
    for (int gq = 0; gq < 4; gq++) {
      const int pb = 8 * gq + 4 * hh;
      const float4 g0 = *(const float4*)(p.ssd_norm_g + h * 64 + pb);
      const float4 g1 = *(const float4*)(p.ssd_norm_g + h * 64 + 32 + pb);
      *(uint2*)(cat + t * 1024 + 512 + h * 64 + pb) = make_uint2(pack2(y0[4 * gq] * rstd * g0.x, y0[4 * gq + 1] * rstd * g0.y), pack2(y0[4 * gq + 2] * rstd * g0.z, y0[4 * gq + 3] * rstd * g0.w));
      *(uint2*)(cat + t * 1024 + 512 + h * 64 + 32 + pb) = make_uint2(pack2(y1[4 * gq] * rstd * g1.x, y1[4 * gq + 1] * rstd * g1.y), pack2(y1[4 * gq + 2] * rstd * g1.z, y1[4 * gq + 3] * rstd * g1.w));
    }
  }
}


DEV void p3_rows1(const Params& p, int m0) {
  const int tid_ = opaque_tid(); const int lane = tid_ & 63, w = __builtin_amdgcn_readfirstlane(tid_ >> 6);
  const u16* mix = (const u16*)(p.ws + OFF_MIX);
  const float* mod = (const float*)(p.ws + OFF_MOD);
  u16* h2 = (u16*)(p.ws + OFF_HBUF);
#pragma unroll 2
  for (int i = 0; i < 16; i++) {
    const int t = m0 + w * 16 + i; const int b = t >> 11;
    float4 mv[4], xv[4]; float ss = 0.f;
#pragma unroll
    for (int k = 0; k < 4; k++) {
      { const uint2 mq = *(const uint2*)(mix + (size_t)t * 1024 + (k * 64 + lane) * 4); mv[k] = make_float4(bflo(mq.x), bfhi(mq.x), bflo(mq.y), bfhi(mq.y)); }
      xv[k] = *(const float4*)(p.x + (size_t)t * 1024 + (k * 64 + lane) * 4);
      ss += mv[k].x * mv[k].x + mv[k].y * mv[k].y + mv[k].z * mv[k].z + mv[k].w * mv[k].w;
    }
    ss = wave_sum(ss);
    const float rstd = rsqrtf(ss * (1.f / 1024.f) + 1e-6f);
    float s2 = 0.f;
#pragma unroll
    for (int k = 0; k < 4; k++) {
      const int col = (k * 64 + lane) * 4;
      const float4 pg = *(const float4*)(p.post_mix_g + col);
      const float4 g1 = ldmod(mod, b * 6144 + 2048 + col);
      xv[k].x += g1.x * (mv[k].x * rstd * pg.x); xv[k].y += g1.y * (mv[k].y * rstd * pg.y);
      xv[k].z += g1.z * (mv[k].z * rstd * pg.z); xv[k].w += g1.w * (mv[k].w * rstd * pg.w);
      s2 += xv[k].x * xv[k].x + xv[k].y * xv[k].y + xv[k].z * xv[k].z + xv[k].w * xv[k].w;
      *(uint2*)((u16*)(p.ws + OFF_X1) + (size_t)t * 1024 + col) = make_uint2(pack2(xv[k].x, xv[k].y), pack2(xv[k].z, xv[k].w));
    }
    s2 = wave_sum(s2);
    const float rstd2 = rsqrtf(s2 * (1.f / 1024.f) + 1e-6f);
#pragma unroll
    for (int k = 0; k < 4; k++) {
      const int col = (k * 64 + lane) * 4;
      const float4 fg = *(const float4*)(p.pre_ffn_g + col);
      const float4 sh = ldmod(mod, b * 6144 + 3072 + col);
      const float4 sc = ldmod(mod, b * 6144 + 4096 + col);
      const float y0 = (xv[k].x * rstd2 * fg.x) * (1.f + sc.x) + sh.x;
      const float y1 = (xv[k].y * rstd2 * fg.y) * (1.f + sc.y) + sh.y;
      const float y2 = (xv[k].z * rstd2 * fg.z) * (1.f + sc.z) + sh.z;
      const float y3 = (xv[k].w * rstd2 * fg.w) * (1.f + sc.w) + sh.w;
      *(uint2*)(h2 + (size_t)t * 1024 + col) = make_uint2(pack2(y0, y1), pack2(y2, y3));
      xv[k] = make_float4(y0, y1, y2, y3);
    }
    {
      float mx = 0.f;
#pragma unroll
      for (int k = 0; k < 4; k++) mx = fmaxf(mx, fmaxf(fmaxf(fabsf(xv[k].x), fabsf(xv[k].y)), fmaxf(fabsf(xv[k].z), fabsf(xv[k].w))));
#pragma unroll
      for (int o = 32; o > 0; o >>= 1) mx = fmaxf(mx, __shfl_xor(mx, o));
      const float inv = (mx > 0.f) ? 127.f / mx : 0.f;
      unsigned wd[4];
#pragma unroll
      for (int k = 0; k < 4; k++) wd[k] = pack_i8x4(xv[k].x * inv, xv[k].y * inv, xv[k].z * inv, xv[k].w * inv);
      *(uint4*)(p.ws + OFF_H2Q + (size_t)t * 1024 + lane * 16) = make_uint4(wd[0], wd[1], wd[2], wd[3]);
      if (lane == 0) ((float*)(p.ws + OFF_SH))[t] = mx * (1.f / 127.f);
    }
  }
}

#define INS16(L, x) { _Pragma("unroll") for (int j_ = 0; j_ < 16; j_++) { const unsigned hi_ = max(L[j_], x); x = min(L[j_], x); L[j_] = hi_; } }
#define CEX(L, a_, b_) { const unsigned hi_ = max(L[a_], L[b_]); const unsigned lo_ = min(L[a_], L[b_]); L[a_] = hi_; L[b_] = lo_; }
DEV float unordkey(unsigned u) { const unsigned b = (u & 0x80000000u) ? (u ^ 0x80000000u) : ~u; return __uint_as_float(b); }

#define SORT16(L) { \
  _Pragma("unroll") for (int k_ = 2; k_ <= 16; k_ <<= 1) { \
    _Pragma("unroll") for (int j_ = k_ >> 1; j_ > 0; j_ >>= 1) { \
      _Pragma("unroll") for (int i_ = 0; i_ < 16; i_++) { \
        const int l_ = i_ ^ j_; \
        if (l_ > i_) { \
          const unsigned a_ = L[i_], b_ = L[l_]; \
          const bool desc_ = ((i_ & k_) == 0); \
          L[i_] = desc_ ? max(a_, b_) : min(a_, b_); L[l_] = desc_ ? min(a_, b_) : max(a_, b_); \
        } } } } }
#define MERGE16(A, B) { \
  _Pragma("unroll") for (int j_ = 0; j_ < 16; j_++) A[j_] = max(A[j_], B[15 - j_]); \
  _Pragma("unroll") for (int j_ = 0; j_ < 8; j_++) CEX(A, j_, j_ + 8); \
  _Pragma("unroll") for (int j_ = 0; j_ < 16; j_++) if ((j_ & 4) == 0) CEX(A, j_, j_ + 4); \
  _Pragma("unroll") for (int j_ = 0; j_ < 16; j_++) if ((j_ & 2) == 0) CEX(A, j_, j_ + 2); \
  _Pragma("unroll") for (int j_ = 0; j_ < 16; j_ += 2) CEX(A, j_, j_ + 1); }

constexpr int RT_LROW = 36;

DEV void p3_route(const Params& p, int m0, char* smem) {
  const int tid = opaque_tid(), lane = tid & 63, w = __builtin_amdgcn_readfirstlane(tid >> 6), r = lane & 31, hh = lane >> 5;
  const u16* qp = (const u16*)(p.ws + OFF_QP);
  const u16* sk = (const u16*)(p.ws + OFF_SK);
  unsigned* lists = (unsigned*)smem;
  int* eidx = (int*)(p.ws + OFF_EIDX);
  float* gate = (float*)(p.ws + OFF_GATE);
  __syncthreads();
  {
    const int h = w;
#pragma unroll 1
    for (int i = 0; i < 2; i++) {
      bf16x8 af[4][4];
#pragma unroll
      for (int kt4 = 0; kt4 < 4; kt4++)
#pragma unroll
        for (int ks = 0; ks < 4; ks++) af[kt4][ks] = *(const bf16x8*)(sk + ((size_t)(h * 2 + i) * 128 + kt4 * 32 + r) * 64 + ks * 16 + hh * 8);
#pragma unroll 1
      for (int tt = 0; tt < 4; tt++) {
        bf16x8 bq[4];
#pragma unroll
        for (int ks = 0; ks < 4; ks++) bq[ks] = *(const bf16x8*)(qp + (size_t)(m0 + tt * 32 + r) * 1024 + h * 128 + i * 64 + ks * 16 + hh * 8);
        unsigned L0[16], L1[16], L2[16], L3[16];
#define RT_TILE(LL, kt4) { f32x16 acc = zero16(); \
          _Pragma("unroll") for (int ks = 0; ks < 4; ks++) acc = mfma32(af[kt4][ks], bq[ks], acc); \
          const unsigned kb = (unsigned)(127 - (kt4) * 32 - 4 * hh); \
          _Pragma("unroll") for (int reg = 0; reg < 16; reg++) LL[reg] = (ordkey(acc[reg]) & 0xFFFFFF80u) | (kb - (unsigned)((reg & 3) + 8 * (reg >> 2))); \
          SORT16(LL); }
        RT_TILE(L0, 0); RT_TILE(L1, 1);
        MERGE16(L0, L1);
        RT_TILE(L2, 2); RT_TILE(L3, 3);
        MERGE16(L2, L3);
        MERGE16(L0, L2);
#undef RT_TILE
        unsigned C[16];
#pragma unroll
        for (int j = 0; j < 16; j++) C[j] = (unsigned)__shfl_xor((int)L0[j], 32);
        MERGE16(L0, C);
#pragma unroll
        for (int j = 0; j < 16; j++) C[j] = L0[j];
        if (hh == 0) {
          uint4* dst = (uint4*)(lists + ((size_t)(h * 128 + tt * 32 + r)) * RT_LROW + i * 16);
          dst[0] = make_uint4(C[0], C[1], C[2], C[3]); dst[1] = make_uint4(C[4], C[5], C[6], C[7]);
          dst[2] = make_uint4(C[8], C[9], C[10], C[11]); dst[3] = make_uint4(C[12], C[13], C[14], C[15]);
        }
      }
    }
  }
  __syncthreads();
#pragma unroll 1
  for (int k = 0; k < 2; k++) {
    const int task = tid + k * 512;
    const int h = task >> 7, t = task & 127;
    const uint4* src = (const uint4*)(lists + (size_t)(h * 128 + t) * RT_LROW);
    unsigned K0[16], K1[16];
#pragma unroll
    for (int q = 0; q < 4; q++) {
      const uint4 a = src[q], bb = src[4 + q];
      K0[4 * q] = a.x; K0[4 * q + 1] = a.y; K0[4 * q + 2] = a.z; K0[4 * q + 3] = a.w;
      K1[4 * q] = bb.x; K1[4 * q + 1] = bb.y; K1[4 * q + 2] = bb.z; K1[4 * q + 3] = bb.w;
    }
    float s0[16], s1[16];
#pragma unroll
    for (int j = 0; j < 16; j++) { s0[j] = unordkey(K0[j] & 0xFFFFFF80u); s1[j] = unordkey(K1[j] & 0xFFFFFF80u); }
    unsigned L[16];
#pragma unroll
    for (int j = 0; j < 16; j++) L[j] = 0u;
#pragma unroll
    for (int a = 0; a < 16; a++) {
#pragma unroll
      for (int bb = 0; bb < 16; bb++) {
        if ((a + 1) * (bb + 1) <= 16) {
          unsigned x = (ordkey(s0[a] + s1[bb]) & 0xFFFFFF00u) | (unsigned)(255 - (a * 16 + bb));
          INS16(L, x);
        }
      }
    }
    float fv[16]; int ei[16]; float mx = NEG_INF;
#pragma unroll
    for (int j = 0; j < 16; j++) {
      const int code = 255 - (int)(L[j] & 255u); const int a = code >> 4, bb = code & 15;
      const unsigned ka = ((const unsigned*)src)[a], kb2 = ((const unsigned*)src)[16 + bb];
      const float va = unordkey(ka & 0xFFFFFF80u), vb = unordkey(kb2 & 0xFFFFFF80u);
      fv[j] = va + vb;
      ei[j] = (127 - (int)(ka & 127u)) * 128 + (127 - (int)(kb2 & 127u));
      mx = fmaxf(mx, fv[j]);
    }
    float sum = 0.f;
#pragma unroll
    for (int j = 0; j < 16; j++) { fv[j] = __expf(fv[j] - mx); sum += fv[j]; }
    const float inv = 1.f / sum;
    int* ep = eidx + (size_t)(m0 + t) * 128 + h * 16;
    float* gp = gate + (size_t)(m0 + t) * 128 + h * 16;
#pragma unroll
    for (int q = 0; q < 4; q++) {
      *(int4*)(ep + 4 * q) = make_int4(ei[4 * q], ei[4 * q + 1], ei[4 * q + 2], ei[4 * q + 3]);
      *(float4*)(gp + 4 * q) = make_float4(fv[4 * q] * inv, fv[4 * q + 1] * inv, fv[4 * q + 2] * inv, fv[4 * q + 3] * inv);
    }
  }
}

typedef __attribute__((ext_vector_type(2))) float f32x2;
DEV void dec16(const uint4& q, float* f) {
  f32x2 t;
  t = __builtin_amdgcn_cvt_pk_f32_fp8((int)q.x, false); f[0] = t[0]; f[1] = t[1];
  t = __builtin_amdgcn_cvt_pk_f32_fp8((int)q.x, true);  f[2] = t[0]; f[3] = t[1];
  t = __builtin_amdgcn_cvt_pk_f32_fp8((int)q.y, false); f[4] = t[0]; f[5] = t[1];
  t = __builtin_amdgcn_cvt_pk_f32_fp8((int)q.y, true);  f[6] = t[0]; f[7] = t[1];
  t = __builtin_amdgcn_cvt_pk_f32_fp8((int)q.z, false); f[8] = t[0]; f[9] = t[1];
  t = __builtin_amdgcn_cvt_pk_f32_fp8((int)q.z, true);  f[10] = t[0]; f[11] = t[1];
  t = __builtin_amdgcn_cvt_pk_f32_fp8((int)q.w, false); f[12] = t[0]; f[13] = t[1];
  t = __builtin_amdgcn_cvt_pk_f32_fp8((int)q.w, true);  f[14] = t[0]; f[15] = t[1];
}

constexpr int PX_ROW = 132;
constexpr int PX_Z = 0;
constexpr int PX_E = 8 * 16 * PX_ROW * 4;
constexpr int PX_SS = 2 * PX_E;
constexpr int PX_CL = PX_SS + 512;

DEV void p3_ustage(const Params& p, int m0, char* smem) {
  const int tid_ = opaque_tid(); const int lane = tid_ & 63, w = __builtin_amdgcn_readfirstlane(tid_ >> 6);
  const int sl = lane >> 3, ch = lane & 7;
  const unsigned char* h2q = p.ws + OFF_H2Q;
  const unsigned char* U = p.ws + OFF_U;
  const int* eidx = (const int*)(p.ws + OFF_EIDX);
  float* zb = (float*)(smem + PX_Z) + w * 16 * PX_ROW;
  int* eb = (int*)(smem + PX_E) + w * 16 * PX_ROW;
  int* cl = (int*)(smem + PX_CL) + w * 128;
#pragma unroll 1
  for (int i = 0; i < 16; i++) {
    const int t = m0 + w * 16 + i;
    eb[i * PX_ROW + lane] = eidx[(size_t)t * 128 + lane]; eb[i * PX_ROW + 64 + lane] = eidx[(size_t)t * 128 + 64 + lane];
  }
  if (lane < 16) ((float*)(smem + PX_SS))[w * 16 + lane] = 0.f;
#define U_LOAD8(Q, E) { const unsigned char* up_ = U + (size_t)(E) * 1024 + ch * 16; _Pragma("unroll") for (int k_ = 0; k_ < 8; k_++) Q[k_] = *(const uint4*)(up_ + k_ * 128); }
#pragma unroll 1
  for (int rep = 0; rep < PROBE_U; rep++)
#pragma unroll 1
  for (int x = 0; x < 8; x++) {
    float* zbase = zb;
    uint4 hqn[8];
#pragma unroll
    for (int k = 0; k < 8; k++) hqn[k] = *(const uint4*)(h2q + (size_t)(m0 + w * 16) * 1024 + k * 128 + ch * 16);
#pragma unroll 1
    for (int i = 0; i < 16; i++) {
      uint4 hq[8];
#pragma unroll
      for (int k = 0; k < 8; k++) hq[k] = hqn[k];
      const int ev0 = eb[i * PX_ROW + lane], ev1 = eb[i * PX_ROW + 64 + lane];
      const bool f0 = (ev0 >> 11) == x, f1 = (ev1 >> 11) == x;
      const unsigned long long mk0 = __ballot(f0), mk1 = __ballot(f1);
      const int n0 = __builtin_popcountll(mk0), n = n0 + __builtin_popcountll(mk1);
      const int r0 = __builtin_amdgcn_mbcnt_hi((unsigned)(mk0 >> 32), __builtin_amdgcn_mbcnt_lo((unsigned)mk0, 0));
      const int r1 = n0 + __builtin_amdgcn_mbcnt_hi((unsigned)(mk1 >> 32), __builtin_amdgcn_mbcnt_lo((unsigned)mk1, 0));
      if (f0) cl[r0] = ev0 | (lane << 16);
      if (f1) cl[r1] = ev1 | ((64 + lane) << 16);
      float* zrow = zbase + i * PX_ROW;
      uint4 qA[8]; int ceA = 0;
      if (n > 0) { ceA = cl[(sl < n) ? sl : 0]; U_LOAD8(qA, ceA & 0xFFFF); }
      {
        const unsigned char* hp = h2q + (size_t)(m0 + w * 16 + ((i < 15) ? i + 1 : i)) * 1024 + ch * 16;
#pragma unroll
        for (int k = 0; k < 8; k++) hqn[k] = *(const uint4*)(hp + k * 128);
      }
#pragma unroll 1
      for (int bb = 0; bb < n; bb += 8) {
        uint4 qB[8]; int ceB = 0;
        const bool more = (bb + 8 < n);
        if (more) { const int ix = bb + 8 + sl; ceB = cl[(ix < n) ? ix : bb + 8]; U_LOAD8(qB, ceB & 0xFFFF); }
        int d = 0;
#pragma unroll
        for (int k = 0; k < 8; k++) {
          d = __builtin_amdgcn_sdot4((int)qA[k].x, (int)hq[k].x, d, false);
          d = __builtin_amdgcn_sdot4((int)qA[k].y, (int)hq[k].y, d, false);
          d = __builtin_amdgcn_sdot4((int)qA[k].z, (int)hq[k].z, d, false);
          d = __builtin_amdgcn_sdot4((int)qA[k].w, (int)hq[k].w, d, false);
        }
        d += __builtin_amdgcn_update_dpp(0, d, 0xB1, 0xF, 0xF, false);
        d += __builtin_amdgcn_update_dpp(0, d, 0x4E, 0xF, 0xF, false);
        d += __builtin_amdgcn_update_dpp(0, d, 0x141, 0xF, 0xF, false);
        if (ch == 0 && bb + sl < n) zrow[ceA >> 16] = (float)d;
        if (more) {
#pragma unroll
          for (int k = 0; k < 8; k++) qA[k] = qB[k];
          ceA = ceB;
        }
      }
    }
  }
#undef U_LOAD8
  {
    const float* su = (const float*)(p.ws + OFF_SU);
    const float* sv = (const float*)(p.ws + OFF_SV);
    const float* shs = (const float*)(p.ws + OFF_SH);
    const float* gate = (const float*)(p.ws + OFF_GATE);
#pragma unroll 1
    for (int i = 0; i < 16; i++) {
      const int t = m0 + w * 16 + i;
      const float st = shs[t];
#pragma unroll
      for (int half = 0; half < 2; half++) {
        const int e = eb[i * PX_ROW + half * 64 + lane];
        const float z = zb[i * PX_ROW + half * 64 + lane] * (su[e] * st);
        zb[i * PX_ROW + half * 64 + lane] = 0.5f * z * (1.f + erff(z * 0.70710678118654752f)) * gate[(size_t)t * 128 + half * 64 + lane] * sv[e];
      }
    }
  }
}

DEV void p3_vstage(const Params& p, int m0, char* smem) {
  const int tid_ = opaque_tid(); const int lane = tid_ & 63, w = __builtin_amdgcn_readfirstlane(tid_ >> 6);
  const unsigned char* V = p.ws + OFF_V;
  const float* ab = (const float*)(smem + PX_Z) + w * 16 * PX_ROW;
  const int* eb = (const int*)(smem + PX_E) + w * 16 * PX_ROW;
  float* ssq = (float*)(smem + PX_SS) + w * 16;
  u16* F = (u16*)(p.ws + OFF_MIX + (size_t)T_ * 1024 * 2);
  const int ts = lane >> 3, ch = lane & 7;
#define V_LOAD4(Q, E4) { Q[0] = *(const uint4*)(vb + (size_t)(E4).x * 1024); Q[1] = *(const uint4*)(vb + (size_t)(E4).y * 1024); \
    Q[2] = *(const uint4*)(vb + (size_t)(E4).z * 1024); Q[3] = *(const uint4*)(vb + (size_t)(E4).w * 1024); }
#pragma unroll 1
  for (int rep = 0; rep < PROBE_V; rep++)
#pragma unroll 1
  for (int x = 0; x < 8; x++) {
    const unsigned char* vb = V + x * 128 + ch * 16;
#pragma unroll 1
    for (int grp = 0; grp < 2; grp++) {
      const int i = grp * 8 + ts;
      const int t = m0 + w * 16 + i;
      const int4* ep = (const int4*)(eb + i * PX_ROW);
      const float4* ap = (const float4*)(ab + i * PX_ROW);
      f32x2 acc[8];
#pragma unroll
      for (int k = 0; k < 8; k++) acc[k] = (f32x2){0.f, 0.f};
      uint4 qA[4], qB[4];
      int4 e4 = ep[0];
      V_LOAD4(qA, e4);
      e4 = ep[1];
      V_LOAD4(qB, e4);
#pragma unroll 1
      for (int pb = 0; pb < 32; pb += 2) {
#pragma unroll
        for (int half = 0; half < 2; half++) {
          const float4 a4 = ap[pb + half];
          const float av[4] = {a4.x, a4.y, a4.z, a4.w};
#pragma unroll
          for (int u = 0; u < 4; u++) {
            const uint4 qq = half ? qB[u] : qA[u];
            const f32x2 a2 = {av[u], av[u]};
            const unsigned wds[4] = {qq.x, qq.y, qq.z, qq.w};
#pragma unroll
            for (int k2 = 0; k2 < 4; k2++) {
              acc[2 * k2] = __builtin_elementwise_fma(a2, __builtin_amdgcn_cvt_pk_f32_fp8((int)wds[k2], false), acc[2 * k2]);
              acc[2 * k2 + 1] = __builtin_elementwise_fma(a2, __builtin_amdgcn_cvt_pk_f32_fp8((int)wds[k2], true), acc[2 * k2 + 1]);
            }
          }
          const int nx = pb + 2 + half;
          if (nx < 32) { const int4 en = ep[nx]; if (half) { V_LOAD4(qB, en); } else { V_LOAD4(qA, en); } }
        }
      }
      float ss = 0.f;
#pragma unroll
      for (int k = 0; k < 8; k++) ss = fmaf(acc[k][0], acc[k][0], fmaf(acc[k][1], acc[k][1], ss));
      ss += __int_as_float(__builtin_amdgcn_update_dpp(0, __float_as_int(ss), 0xB1, 0xF, 0xF, false));
      ss += __int_as_float(__builtin_amdgcn_update_dpp(0, __float_as_int(ss), 0x4E, 0xF, 0xF, false));
      ss += __int_as_float(__builtin_amdgcn_update_dpp(0, __float_as_int(ss), 0x141, 0xF, 0xF, false));
      if (rep < PROBE_V) {
        u16* fp = F + (size_t)t * 1024 + x * 128 + ch * 16;
        *(uint4*)(fp) = make_uint4(pack2(acc[0][0], acc[0][1]), pack2(acc[1][0], acc[1][1]), pack2(acc[2][0], acc[2][1]), pack2(acc[3][0], acc[3][1]));
        *(uint4*)(fp + 8) = make_uint4(pack2(acc[4][0], acc[4][1]), pack2(acc[5][0], acc[5][1]), pack2(acc[6][0], acc[6][1]), pack2(acc[7][0], acc[7][1]));
        if (ch == 0 && rep == 0) ssq[i] += ss;
      }
    }
  }
#undef V_LOAD4
  {
    const float* mod = (const float*)(p.ws + OFF_MOD);
#pragma unroll 2
    for (int i = 0; i < 16; i++) {
      const int t = m0 + w * 16 + i; const int b = t >> 11;
      const float rstd = rsqrtf(ssq[i] * (1.f / 1024.f) + 1e-6f);
#pragma unroll
      for (int j = 0; j < 4; j++) {
        const uint2 fq = *(const uint2*)(F + (size_t)t * 1024 + lane * 16 + j * 4);
        const float4 f = make_float4(bflo(fq.x), bfhi(fq.x), bflo(fq.y), bfhi(fq.y));
        const int col = j * 256 + lane * 4;
        const uint2 xq = *(const uint2*)((const u16*)(p.ws + OFF_X1) + (size_t)t * 1024 + col);
        const float4 x1 = make_float4(bflo(xq.x), bfhi(xq.x), bflo(xq.y), bfhi(xq.y));
        const float4 fg = *(const float4*)(p.post_ffn_g + col);
        const float4 g2 = ldmod(mod, b * 6144 + 5120 + col);
        float4 o;
        o.x = x1.x + g2.x * (f.x * rstd * fg.x); o.y = x1.y + g2.y * (f.y * rstd * fg.y);
        o.z = x1.z + g2.z * (f.z * rstd * fg.z); o.w = x1.w + g2.w * (f.w * rstd * fg.w);
        *(float4*)(p.out + (size_t)t * 1024 + col) = o;
      }
    }
  }
}

DEV void phase3_tile(const Params& p, int mt, char* smem) {
  const int m0 = mt * 128;
  const u16* cat = (const u16*)(p.ws + OFF_HBUF) + (size_t)m0 * 1024;
  {
    const u16* wt = (const u16*)(p.ws + OFF_WTOUT);
    for (int rep = 0; rep < PROBE_G3; rep++)
    for (int nc = 0; nc < 4; nc++) {
      EpiStoreBf16 epi{(u16*)(p.ws + OFF_MIX) + (size_t)m0 * 1024, nc * 256};
      gemm_tile(cat, 1024, wt + (size_t)nc * 256 * 1024, 1024, 1024, smem, epi);
    }
  }
  __syncthreads();
  p3_rows1(p, m0);
#if STAGE >= 6
  __syncthreads();
  {
    const u16* wt = (const u16*)(p.ws + OFF_WTQ);
    for (int rep = 0; rep < PROBE_G3; rep++)
    for (int nc = 0; nc < 4; nc++) {
      EpiStoreBf16 epi{(u16*)(p.ws + OFF_QP) + (size_t)m0 * 1024, nc * 256};
      gemm_tile(cat, 1024, wt + (size_t)nc * 256 * 1024, 1024, 1024, smem, epi);
    }
  }
  __syncthreads();
  for (int rep = 0; rep < PROBE_ROUTE; rep++) p3_route(p, m0, smem);
  __syncthreads();
#endif
}

DEV void grid_barrier(unsigned* counter, unsigned& target) {
  asm volatile("s_waitcnt vmcnt(0)" ::: "memory");
  __syncthreads();
  if (threadIdx.x == 0) {
    __builtin_amdgcn_fence(__ATOMIC_RELEASE, "agent");
    asm volatile("s_waitcnt vmcnt(0)" ::: "memory");
    target += gridDim.x;
    __hip_atomic_fetch_add(counter, 1u, __ATOMIC_RELAXED, __HIP_MEMORY_SCOPE_AGENT);
    while (__hip_atomic_load(counter, __ATOMIC_RELAXED, __HIP_MEMORY_SCOPE_AGENT) < target) __builtin_amdgcn_s_sleep(1);
    __builtin_amdgcn_fence(__ATOMIC_ACQUIRE, "agent");
    asm volatile("s_waitcnt vmcnt(0)" ::: "memory");
  }
  __syncthreads();
}

#define XB_TMO      128
#define XB_XCNT(j)  (256  + 64 * (j))
#define XB_XSUB(j)  (1280 + 64 * (j))
#define XB_XGEN(j)  (2304 + 64 * (j))
#define XB_TOP      3328
#define XB_TOPGEN   3392
#define XB_SPIN_CAP (1u << 22)
DEV unsigned xb_ld(unsigned* p) { return __hip_atomic_load(p, __ATOMIC_RELAXED, __HIP_MEMORY_SCOPE_AGENT); }
DEV unsigned xb_add(unsigned* p, unsigned v) { return __hip_atomic_fetch_add(p, v, __ATOMIC_RELAXED, __HIP_MEMORY_SCOPE_AGENT); }
DEV unsigned xb_xcc_id() { return (unsigned)__builtin_amdgcn_s_getreg((3 << 11) | 20) & 0xFu; }
#define XB_SPIN(cond, bar) do { unsigned _sp = 0; while (cond) { __builtin_amdgcn_s_sleep(1); \
    if ((++_sp & 255u) == 0u) { if (xb_ld(&(bar)[XB_TMO])) break; if (_sp > XB_SPIN_CAP) { atomicAdd(&(bar)[XB_TMO], 1u); break; } } } } while (0)
struct XcdBarrier { unsigned* bar; unsigned x; unsigned* st; };
DEV void xcd_barrier_complete(unsigned* bar, unsigned x, unsigned& nloc, unsigned& nx) {
  const unsigned G = gridDim.x;
  unsigned sum, cnt, mine, sp = 0u;
  for (;;) {
    sum = 0u; cnt = 0u; mine = 0u;
#pragma unroll
    for (unsigned j = 0; j < 16; ++j) { const unsigned c = xb_ld(&bar[XB_XCNT(j)]); sum += c; cnt += (c > 0u) ? 1u : 0u; mine = (j == x) ? c : mine; }
    if (sum == G) break;
    __builtin_amdgcn_s_sleep(1);
    if ((++sp & 255u) == 0u) { if (xb_ld(&bar[XB_TMO])) break; if (sp > XB_SPIN_CAP) { atomicAdd(&bar[XB_TMO], 1u); break; } }
  }
  nloc = mine > 0u ? mine : 1u; nx = cnt > 0u ? cnt : 1u;
}
DEV void xcd_barrier(const XcdBarrier& b) {
  asm volatile("s_waitcnt vmcnt(0)" ::: "memory");
  __syncthreads();
  if (threadIdx.x == 0) {
    unsigned* bar = b.bar;
    __builtin_amdgcn_s_waitcnt(0);
    unsigned nloc = b.st[0], nx = b.st[1];
    if (nloc == 0u) { xcd_barrier_complete(bar, b.x, nloc, nx); b.st[0] = nloc; b.st[1] = nx; }
    const unsigned old = xb_add(&bar[XB_XSUB(b.x)], 1u);
    const unsigned gen = old / nloc;
    if (old + 1u == (gen + 1u) * nloc) {
      __builtin_amdgcn_fence(__ATOMIC_RELEASE, "agent");
      asm volatile("s_waitcnt vmcnt(0)" ::: "memory");
      const unsigned og = xb_add(&bar[XB_TOP], 1u);
      const unsigned tg = og / nx;
      if (og + 1u == (tg + 1u) * nx) xb_add(&bar[XB_TOPGEN], 1u);
      else XB_SPIN(xb_ld(&bar[XB_TOPGEN]) == tg, bar);
      __builtin_amdgcn_fence(__ATOMIC_ACQUIRE, "agent");
      xb_add(&bar[XB_XGEN(b.x)], 1u);
      asm volatile("s_waitcnt vmcnt(0)" ::: "memory");
    } else {
      XB_SPIN(xb_ld(&bar[XB_XGEN(b.x)]) == gen, bar);
      __builtin_amdgcn_fence(__ATOMIC_ACQUIRE, "agent");
      asm volatile("s_waitcnt vmcnt(0)" ::: "memory");
    }
  }
  __syncthreads();
}

__global__ void __launch_bounds__(NT) mega(Params p) {
  __shared__ __attribute__((aligned(16))) char smem[LDS_BYTES + 16];
  cg::grid_group grid = cg::this_grid();
  XcdBarrier xb; xb.bar = (unsigned*)(p.ws + OFF_XB); xb.x = xb_xcc_id(); xb.st = (unsigned*)(smem + LDS_BYTES);
  if (threadIdx.x == 0) { xb.st[0] = 0u; xb.st[1] = 0u; (void)xb_add(&xb.bar[XB_XCNT(xb.x)], 1u); }
  __syncthreads();
#if STAGE == 0
  {
    const size_t n4 = (size_t)T_ * 1024 / 4;
    for (size_t i = (size_t)blockIdx.x * NT + threadIdx.x; i < n4; i += (size_t)gridDim.x * NT) ((float4*)p.out)[i] = ((const float4*)p.x)[i];
  }
#endif
  phase_mod(p, smem);
  if (gridDim.x == 0x7fffffffu) grid.sync();
  xcd_barrier(xb);
#if PH(1)
  for (int rep = 0; rep < PROBE_HN; rep++) phase_hnorm(p);
#endif
#if PH(0)
  for (int rep = 0; rep < PROBE_P0; rep++) phase0(p, smem);
#endif
  xcd_barrier(xb);
#if STAGE >= 1 && PH(2)
  for (int rep = 0; rep < PROBE_P1; rep++) phase1(p, smem);
#endif
  xcd_barrier(xb);
#if STAGE >= 2 && PH(3)
  for (int rep = 0; rep < PROBE_SSDA; rep++)
  for (int it = blockIdx.x; it < 512; it += gridDim.x) { ssdA_item(p, it >> 5, (it >> 1) & 15, it & 1, smem); }
#endif
#if STAGE >= 4 && PH(4)
  for (int rep = 0; rep < PROBE_DSA; rep++)
  for (int k = 0; k < 4; k++) {
    const int i = blockIdx.x + k * gridDim.x;
    if (gridDim.x == 256) {
      const int rr = i & 255; const int b = rr & 15, a = rr >> 4;
      const int qt = (k == 0) ? a : (k == 1) ? 31 - a : (k == 2) ? 32 + a : 63 - a;
      dsa_item(p, b, qt, smem);
    }
  }
  if (gridDim.x != 256) { for (int i = blockIdx.x; i < 1024; i += gridDim.x) dsa_item(p, i & 15, 63 - (i >> 4), smem); }
#if STAGE >= 2
  xcd_barrier(xb);
#endif
  for (int it = blockIdx.x; it < 512; it += gridDim.x) ssdS_item(p, it >> 5, (it >> 2) & 7, it & 3);
#elif STAGE >= 2 && STAGE < 4
  {
    u16* cat = (u16*)(p.ws + OFF_HBUF);
    for (size_t i = (size_t)blockIdx.x * NT + threadIdx.x; i < (size_t)T_ * 64; i += (size_t)gridDim.x * NT) {
      const size_t t = i >> 6, cc = i & 63;
      *(uint4*)(cat + t * 1024 + cc * 8) = make_uint4(0, 0, 0, 0);
    }
  }
#endif
  xcd_barrier(xb);
#if STAGE >= 2 && PH(5)
  for (int rep = 0; rep < PROBE_SSDB; rep++)
  for (int it = blockIdx.x; it < 256; it += gridDim.x) ssdB_item(p, it >> 4, it & 15, smem);
#endif
  xcd_barrier(xb);
#if STAGE >= 3 && PH(6)
  if (gridDim.x == 256) {
    if (blockIdx.x & 1) convert_fp8_rows(p.peer_v, p.ws + OFF_V, (float*)(p.ws + OFF_SV));
    phase3_tile(p, blockIdx.x, smem);
    if (!(blockIdx.x & 1)) convert_fp8_rows(p.peer_v, p.ws + OFF_V, (float*)(p.ws + OFF_SV));
    xcd_barrier(xb);
    p3_ustage(p, blockIdx.x * 128, smem);
    xcd_barrier(xb);
    p3_vstage(p, blockIdx.x * 128, smem);
  } else {
    convert_fp8_rows(p.peer_v, p.ws + OFF_V, (float*)(p.ws + OFF_SV));
    xcd_barrier(xb);
    for (int mt = blockIdx.x; mt < 256; mt += gridDim.x) { phase3_tile(p, mt, smem); p3_ustage(p, mt * 128, smem); p3_vstage(p, mt * 128, smem); __syncthreads(); }
  }
#endif
}

extern "C" void kernel_launch(void* const* d_in, const int* in_sizes, int n_in, void* d_out, int out_size, void* d_ws, size_t ws_size, hipStream_t stream) {
  static int grid_blocks = 0;
  if (!grid_blocks) {
    int dev = 0, cus = 0, per_cu = 0;
    hipGetDevice(&dev);
    hipDeviceGetAttribute(&cus, hipDeviceAttributeMultiprocessorCount, dev);
    hipOccupancyMaxActiveBlocksPerMultiprocessor(&per_cu, mega, NT, 0);
    if (per_cu < 1) { fprintf(stderr, "occupancy query says %d blocks/CU\n", per_cu); per_cu = 1; }
    grid_blocks = cus;
    if (ws_size < WS_END) fprintf(stderr, "workspace too small: %zu < %zu\n", ws_size, (size_t)WS_END);
  }
  Params p{};
  p.x = (const float*)d_in[0]; p.c = (const float*)d_in[1]; p.pos = (const int*)d_in[2]; p.w_ada = (const float*)d_in[3]; p.b_ada = (const float*)d_in[4];
  p.pre_mix_g = (const float*)d_in[5]; p.post_mix_g = (const float*)d_in[6]; p.w_in = (const float*)d_in[7]; p.conv_w = (const float*)d_in[8]; p.conv_b = (const float*)d_in[9];
  p.dt_bias = (const float*)d_in[10]; p.a_log = (const float*)d_in[11]; p.d_skip = (const float*)d_in[12]; p.ssd_norm_g = (const float*)d_in[13]; p.w_out = (const float*)d_in[14];
  p.pre_ffn_g = (const float*)d_in[15]; p.post_ffn_g = (const float*)d_in[16]; p.w_q = (const float*)d_in[17]; p.sub_keys = (const float*)d_in[18]; p.peer_u = (const float*)d_in[19];
  p.peer_v = (const float*)d_in[20]; p.out = (float*)d_out; p.ws = (unsigned char*)d_ws;
  if (hipMemsetAsync((unsigned char*)d_ws + OFF_XB, 0, 16384, stream) != hipSuccess) fprintf(stderr, "memset of the barrier words failed\n");
  void* args[] = {&p};
  hipError_t e = hipLaunchCooperativeKernel((void*)mega, dim3(grid_blocks), dim3(NT), args, 0, stream);
  if (e != hipSuccess) fprintf(stderr, "cooperative launch failed: %s (grid %d)\n", hipGetErrorString(e), grid_blocks);
}
```

```cpp
#include <hip/hip_runtime.h>
#include <hip/hip_cooperative_groups.h>
#include <stdint.h>
#include <stdio.h>
namespace cg = cooperative_groups;

#ifndef STAGE
#define STAGE 99
#endif
#ifndef ONLY
#define ONLY -1
#endif
#define PH(n) (ONLY < 0 || ONLY == (n))
#ifndef PROBE_P0
#define PROBE_P0 1
#endif
#ifndef PROBE_HN
#define PROBE_HN 1
#endif
#ifndef PROBE_P1
#define PROBE_P1 1
#endif
#ifndef PROBE_SSDA
#define PROBE_SSDA 1
#endif
#ifndef PROBE_DSA
#define PROBE_DSA 1
#endif
#ifndef PROBE_SSDB
#define PROBE_SSDB 1
#endif
#ifndef PROBE_UHOT
#define PROBE_UHOT 0
#endif
#ifndef PROBE_VHOT
#define PROBE_VHOT 0
#endif
#ifndef PROBE_DSA_SC
#define PROBE_DSA_SC 1
#endif
#ifndef PROBE_DSA_BIS
#define PROBE_DSA_BIS 1
#endif
#ifndef PROBE_DSA_ATT
#define PROBE_DSA_ATT 1
#endif
#ifndef PROBE_U
#define PROBE_U 1
#endif
#ifndef PROBE_V
#define PROBE_V 1
#endif
#ifndef PROBE_ROUTE
#define PROBE_ROUTE 1
#endif
#ifndef PROBE_G3
#define PROBE_G3 1
#endif

#define NT 512
typedef unsigned short u16;
typedef __attribute__((ext_vector_type(8))) short bf16x8;
typedef __attribute__((ext_vector_type(16))) float f32x16;
typedef __attribute__((ext_vector_type(16))) unsigned u32x16;

#define DEV __device__ __forceinline__

constexpr int B_ = 16, S_ = 2048, D_ = 1024, T_ = B_ * S_;
constexpr int NPROJ = 2896, NPAD = 3072;
constexpr int SV_ = 2048 + 64;
constexpr float NEG_INF = -__builtin_huge_valf();

constexpr size_t OFF_MOD = 0;
constexpr size_t OFF_COS = OFF_MOD + 786432;
constexpr size_t OFF_SIN = OFF_COS + (size_t)T_ * 32 * 4;
constexpr size_t OFF_HBUF = OFF_SIN + (size_t)T_ * 32 * 4;
constexpr size_t OFF_WTIN = OFF_HBUF + (size_t)T_ * 1024 * 2;
constexpr size_t OFF_WTOUT = OFF_WTIN + (size_t)NPAD * 1024 * 2;
constexpr size_t OFF_WTQ = OFF_WTOUT + (size_t)1024 * 1024 * 2;
constexpr size_t OFF_SK = OFF_WTQ + (size_t)1024 * 1024 * 2;
constexpr size_t OFF_U = OFF_SK + (size_t)16 * 128 * 64 * 2;
constexpr size_t OFF_V = OFF_U + (size_t)16384 * 1024;
constexpr size_t OFF_SU = OFF_V + (size_t)16384 * 1024;
constexpr size_t OFF_SV = OFF_SU + (size_t)16384 * 4;
constexpr size_t OFF_Q = OFF_SV + (size_t)16384 * 4;
constexpr size_t OFF_QI = OFF_Q + (size_t)T_ * 512 * 2;
constexpr size_t OFF_XBC = OFF_QI + (size_t)T_ * 512 * 2;
constexpr size_t OFF_SIN_ST = OFF_XBC;
constexpr size_t OFF_MIX = OFF_Q;
constexpr size_t OFF_K = OFF_XBC + (size_t)T_ * 1024 * 2;
constexpr size_t OFF_VT = OFF_K + (size_t)T_ * 128 * 2;
constexpr size_t OFF_KI = OFF_VT + (size_t)16 * 2 * 64 * SV_ * 2;
constexpr size_t OFF_WI = OFF_KI + (size_t)T_ * 64 * 2;
constexpr size_t OFF_DT = OFF_WI + (size_t)T_ * 8 * 4;
constexpr size_t OFF_Z = OFF_DT + (size_t)T_ * 8 * 4;
constexpr size_t OFF_EIDX = OFF_Z;
constexpr size_t OFF_GATE = OFF_Z + (size_t)T_ * 128 * 4;
constexpr size_t OFF_ST = OFF_Z + (size_t)T_ * 512 * 2;
constexpr size_t OFF_YP_ = OFF_ST + (size_t)16 * 16 * 8 * 64 * 128 * 4 + (size_t)16 * 16 * 8 * 128 * 4;
constexpr size_t OFF_X1 = OFF_ST;
constexpr size_t OFF_QP = OFF_YP_;
constexpr size_t OFF_ACUM = OFF_ST + (size_t)16 * 16 * 8 * 64 * 128 * 4;
constexpr size_t OFF_YP = OFF_ACUM + (size_t)16 * 16 * 8 * 128 * 4;
static_assert(OFF_YP_ == OFF_YP, "alias");
constexpr size_t OFF_CC = OFF_YP + (size_t)T_ * 512 * 4;
constexpr size_t OFF_BAR = OFF_CC + (size_t)T_ * 256 * 2;
constexpr size_t OFF_XB = OFF_BAR + 256;
constexpr size_t OFF_H2Q = OFF_XB + 16384;
constexpr size_t OFF_SH = OFF_H2Q + (size_t)T_ * 1024;
constexpr size_t WS_END = OFF_SH + (size_t)T_ * 4;

constexpr int LDS_BYTES = 156672;

struct Params {
  const float* x; const float* c; const int* pos; const float* w_ada; const float* b_ada;
  const float* pre_mix_g; const float* post_mix_g; const float* w_in; const float* conv_w; const float* conv_b;
  const float* dt_bias; const float* a_log; const float* d_skip; const float* ssd_norm_g; const float* w_out;
  const float* pre_ffn_g; const float* post_ffn_g; const float* w_q; const float* sub_keys; const float* peer_u;
  const float* peer_v; float* out; unsigned char* ws;
};

__constant__ float c_inv_freq[32] = {
  1.000000000e+00f, 7.498942614e-01f, 5.623413324e-01f, 4.216965139e-01f, 3.162277639e-01f, 2.371373773e-01f, 1.778279394e-01f, 1.333521307e-01f,
  1.000000015e-01f, 7.498941571e-02f, 5.623413250e-02f, 4.216965288e-02f, 3.162277490e-02f, 2.371373773e-02f, 1.778279431e-02f, 1.333521493e-02f,
  9.999999776e-03f, 7.498941850e-03f, 5.623413250e-03f, 4.216964822e-03f, 3.162277630e-03f, 2.371373586e-03f, 1.778279431e-03f, 1.333521446e-03f,
  1.000000047e-03f, 7.498942432e-04f, 5.623413017e-04f, 4.216965172e-04f, 3.162277571e-04f, 2.371373703e-04f, 1.778279402e-04f, 1.333521504e-04f};

DEV int opaque_tid() { int t = threadIdx.x; asm volatile("" : "+v"(t)); return t; }
DEV u16 f2bf(float f) { unsigned u = __float_as_uint(f); u += 0x7FFFu + ((u >> 16) & 1u); return (u16)(u >> 16); }
DEV float bf2f(u16 h) { return __uint_as_float(((unsigned)h) << 16); }
DEV unsigned pack2(float a, float b) { unsigned r; asm("v_cvt_pk_bf16_f32 %0, %1, %2" : "=v"(r) : "v"(a), "v"(b)); return r; }
DEV float bflo(unsigned u) { return __uint_as_float(u << 16); }
DEV float bfhi(unsigned u) { return __uint_as_float(u & 0xFFFF0000u); }
DEV float wave_sum(float v) {
#pragma unroll
  for (int o = 32; o > 0; o >>= 1) v += __shfl_xor(v, o);
  return v;
}
#define DPP_ADD(v, ctrl, rmask) v += __int_as_float(__builtin_amdgcn_update_dpp(0, __float_as_int(v), ctrl, rmask, 0xF, false))
DEV float wave_sum63(float v) {
  DPP_ADD(v, 0xB1, 0xF);
  DPP_ADD(v, 0x4E, 0xF);
  DPP_ADD(v, 0x141, 0xF);
  DPP_ADD(v, 0x140, 0xF);
  DPP_ADD(v, 0x142, 0xA);
  DPP_ADD(v, 0x143, 0xC);
  return v;
}
DEV f32x16 mfma32(bf16x8 a, bf16x8 b, f32x16 c) { return __builtin_amdgcn_mfma_f32_32x32x16_bf16(a, b, c, 0, 0, 0); }
DEV f32x16 zero16() { f32x16 z;
#pragma unroll
  for (int i = 0; i < 16; i++) z[i] = 0.f;
  return z; }
DEV int rowmap(int reg, int hh) { return (reg & 3) + 8 * (reg >> 2) + 4 * hh; }
DEV float silu_f(float v) { return v / (1.f + expf(-v)); }
DEV unsigned ordkey(float f) { unsigned b = __float_as_uint(f); unsigned m = (unsigned)((int)b >> 31) | 0x80000000u; return b ^ m; }
DEV bf16x8 mk_frag(uint2 lo, uint2 hi) { union { uint4 u; bf16x8 v; } t; t.u = make_uint4(lo.x, lo.y, hi.x, hi.y); return t.v; }
DEV bf16x8 pack_frag(const f32x16& v, int base) {
  union { uint4 u; bf16x8 f; } t;
  t.u = make_uint4(pack2(v[base + 0], v[base + 1]), pack2(v[base + 2], v[base + 3]), pack2(v[base + 4], v[base + 5]), pack2(v[base + 6], v[base + 7]));
  return t.f;
}

DEV float4 ldmod(const float* mod, int off) {
  const float4 a = *(const float4*)(mod + off), b = *(const float4*)(mod + 98304 + off);
  return make_float4(a.x + b.x, a.y + b.y, a.z + b.z, a.w + b.w);
}
DEV void phase_mod(const Params& p, char* smem) {
  float* s_silu = (float*)smem;
  float* s_red = (float*)(smem + 32768);
  float* mod = (float*)(p.ws + OFF_MOD);
  const int tid = threadIdx.x;
  for (int item = blockIdx.x; item < 192; item += gridDim.x) {
    const int cgp = item >> 1, ks = item & 1;
    __syncthreads();
    for (int e = tid; e < 8192; e += NT) { int b = e >> 9, i = e & 511; s_silu[i * 16 + b] = silu_f(p.c[b * 1024 + ks * 512 + i]); }
    __syncthreads();
    const int kg = tid >> 6, col = tid & 63;
    float acc[16];
#pragma unroll
    for (int b = 0; b < 16; b++) acc[b] = 0.f;
    const float* w = p.w_ada + (size_t)(ks * 512 + kg * 64) * 6144 + cgp * 64 + col;
#pragma unroll 1
    for (int i0 = 0; i0 < 64; i0 += 16) {
      float wreg[16];
#pragma unroll
      for (int u = 0; u < 16; u++) wreg[u] = w[(size_t)(i0 + u) * 6144];
#pragma unroll
      for (int u = 0; u < 16; u++) {
        const float wv = wreg[u];
        const float4* sp = (const float4*)(s_silu + (kg * 64 + i0 + u) * 16);
        float4 s0 = sp[0], s1 = sp[1], s2 = sp[2], s3 = sp[3];
        acc[0] += s0.x * wv; acc[1] += s0.y * wv; acc[2] += s0.z * wv; acc[3] += s0.w * wv;
        acc[4] += s1.x * wv; acc[5] += s1.y * wv; acc[6] += s1.z * wv; acc[7] += s1.w * wv;
        acc[8] += s2.x * wv; acc[9] += s2.y * wv; acc[10] += s2.z * wv; acc[11] += s2.w * wv;
        acc[12] += s3.x * wv; acc[13] += s3.y * wv; acc[14] += s3.z * wv; acc[15] += s3.w * wv;
      }
    }
#pragma unroll
    for (int b = 0; b < 16; b++) s_red[(kg * 64 + col) * 16 + b] = acc[b];
    __syncthreads();
    for (int e = tid; e < 1024; e += NT) {
      int cc = e >> 4, b = e & 15; float sum = 0.f;
#pragma unroll
      for (int k = 0; k < 8; k++) sum += s_red[(k * 64 + cc) * 16 + b];
      int j = cgp * 64 + cc;
      mod[ks * 98304 + b * 6144 + j] = sum + (ks == 0 ? p.b_ada[j] : 0.f);
    }
  }
}

DEV int remap_col(int n) {
  if (n < 1344) return n;
  if (n < 1352) return 2880 + (n - 1344);
  if (n < 2888) return n - 8;
  return n;
}

DEV void transpose_convert(const float* __restrict__ src, int N, u16* __restrict__ dst, bool remap, char* smem) {
  float* tile = (float*)smem;
  const int tid = threadIdx.x;
  const int ntn = (N + 63) >> 6;
  const int nitems = 16 * ntn;
  for (int item = blockIdx.x; item < nitems; item += gridDim.x) {
    const int kt = item / ntn, nt = item - kt * ntn;
    const int k0 = kt * 64, n0 = nt * 64;
    __syncthreads();
    for (int e = tid; e < 4096; e += NT) {
      int r = e >> 6, ci = e & 63, n = n0 + ci;
      tile[r * 65 + ci] = (n < N) ? src[(size_t)(k0 + r) * N + n] : 0.f;
    }
    __syncthreads();
    for (int e = tid; e < 4096; e += NT) {
      int nn = e >> 6, kk = e & 63, n = n0 + nn;
      if (n < N) { int n2 = remap ? remap_col(n) : n; dst[(size_t)n2 * 1024 + k0 + kk] = f2bf(tile[kk * 65 + nn]); }
    }
  }
}

DEV void convert_bf16(const float* __restrict__ src, u16* __restrict__ dst, size_t n8) {
  const size_t g = (size_t)blockIdx.x * NT + threadIdx.x, gs = (size_t)gridDim.x * NT;
  for (size_t i = g; i < n8; i += gs) {
    const float4 a = ((const float4*)src)[2 * i], b = ((const float4*)src)[2 * i + 1];
    ((uint4*)dst)[i] = make_uint4(pack2(a.x, a.y), pack2(a.z, a.w), pack2(b.x, b.y), pack2(b.z, b.w));
  }
}

DEV void convert_fp8_rows(const float* __restrict__ src, unsigned char* __restrict__ dst, float* __restrict__ scl) {
  const int tid_ = opaque_tid(); const int lane = tid_ & 63, wave = __builtin_amdgcn_readfirstlane(tid_ >> 6);
  for (int e0 = ((blockIdx.x >> 1) * 8 + wave) * 4 + (blockIdx.x & 1) * 8192; e0 < 8192 + (blockIdx.x & 1) * 8192; e0 += (gridDim.x >> 1) * 32) {
    float4 v[4][4];
#pragma unroll
    for (int u = 0; u < 4; u++)
#pragma unroll
      for (int j = 0; j < 4; j++) v[u][j] = *(const float4*)(src + (size_t)(e0 + u) * 1024 + j * 256 + lane * 4);
#pragma unroll
    for (int u = 0; u < 4; u++) {
      float mx = 0.f;
#pragma unroll
      for (int j = 0; j < 4; j++) mx = fmaxf(mx, fmaxf(fmaxf(fabsf(v[u][j].x), fabsf(v[u][j].y)), fmaxf(fabsf(v[u][j].z), fabsf(v[u][j].w))));
#pragma unroll
      for (int o = 32; o > 0; o >>= 1) mx = fmaxf(mx, __shfl_xor(mx, o));
      const float inv = (mx > 0.f) ? 384.f / mx : 0.f;
      int wd[4];
#pragma unroll
      for (int j = 0; j < 4; j++) {
        int t = 0;
        t = __builtin_amdgcn_cvt_pk_fp8_f32(v[u][j].x * inv, v[u][j].y * inv, t, false);
        t = __builtin_amdgcn_cvt_pk_fp8_f32(v[u][j].z * inv, v[u][j].w * inv, t, true);
        wd[j] = t;
      }
      *(uint4*)(dst + (size_t)(e0 + u) * 1024 + lane * 16) = make_uint4((unsigned)wd[0], (unsigned)wd[1], (unsigned)wd[2], (unsigned)wd[3]);
      if (lane == 0) scl[e0 + u] = mx * (1.f / 384.f);
    }
  }
}

DEV unsigned pack_i8x4(float a, float b, float c, float d) {
  const int ia = (int)rintf(a), ib = (int)rintf(b), ic = (int)rintf(c), id = (int)rintf(d);
  return (unsigned)(ia & 255) | ((unsigned)(ib & 255) << 8) | ((unsigned)(ic & 255) << 16) | ((unsigned)id << 24);
}
DEV void convert_i8_rows(const float* __restrict__ src, unsigned char* __restrict__ dst, float* __restrict__ scl) {
  const int tid_ = opaque_tid(); const int lane = tid_ & 63, wave = __builtin_amdgcn_readfirstlane(tid_ >> 6);
  for (int e0 = ((blockIdx.x >> 1) * 8 + wave) * 4 + (blockIdx.x & 1) * 8192; e0 < 8192 + (blockIdx.x & 1) * 8192; e0 += (gridDim.x >> 1) * 32) {
    float4 v[4][4];
#pragma unroll
    for (int u = 0; u < 4; u++)
#pragma unroll
      for (int j = 0; j < 4; j++) v[u][j] = *(const float4*)(src + (size_t)(e0 + u) * 1024 + j * 256 + lane * 4);
#pragma unroll
    for (int u = 0; u < 4; u++) {
      float mx = 0.f;
#pragma unroll
      for (int j = 0; j < 4; j++) mx = fmaxf(mx, fmaxf(fmaxf(fabsf(v[u][j].x), fabsf(v[u][j].y)), fmaxf(fabsf(v[u][j].z), fabsf(v[u][j].w))));
#pragma unroll
      for (int o = 32; o > 0; o >>= 1) mx = fmaxf(mx, __shfl_xor(mx, o));
      const float inv = (mx > 0.f) ? 127.f / mx : 0.f;
      unsigned wd[4];
#pragma unroll
      for (int j = 0; j < 4; j++) wd[j] = pack_i8x4(v[u][j].x * inv, v[u][j].y * inv, v[u][j].z * inv, v[u][j].w * inv);
      *(uint4*)(dst + (size_t)(e0 + u) * 1024 + lane * 16) = make_uint4(wd[0], wd[1], wd[2], wd[3]);
      if (lane == 0) scl[e0 + u] = mx * (1.f / 127.f);
    }
  }
}

DEV void phase0(const Params& p, char* smem) {
  {
    float* cosT = (float*)(p.ws + OFF_COS); float* sinT = (float*)(p.ws + OFF_SIN);
    const int g = blockIdx.x * NT + threadIdx.x, gs = gridDim.x * NT;
    for (int e = g; e < T_ * 32; e += gs) {
      int t = e >> 5, j = e & 31;
      float ang = (float)p.pos[t] * c_inv_freq[j];
      double rev = (double)ang * 0.15915494309189533577;
      rev -= rint(rev);
      float fr = (float)rev;
      cosT[e] = __builtin_amdgcn_cosf(fr);
      sinT[e] = __builtin_amdgcn_sinf(fr);
    }
  }
  transpose_convert(p.w_in, NPROJ, (u16*)(p.ws + OFF_WTIN), true, smem);
  {
    uint4* z = (uint4*)(p.ws + OFF_WTIN + (size_t)NPROJ * 1024 * 2);
    const int n = (NPAD - NPROJ) * 1024 * 2 / 16;
    for (int i = blockIdx.x * NT + threadIdx.x; i < n; i += gridDim.x * NT) z[i] = make_uint4(0, 0, 0, 0);
  }
  transpose_convert(p.w_out, 1024, (u16*)(p.ws + OFF_WTOUT), false, smem);
  transpose_convert(p.w_q, 1024, (u16*)(p.ws + OFF_WTQ), false, smem);
  convert_bf16(p.sub_keys, (u16*)(p.ws + OFF_SK), (size_t)16 * 128 * 64 / 8);
}

DEV void phase_hnorm(const Params& p) {
  const int tid_ = opaque_tid(); const int lane = tid_ & 63, wave = __builtin_amdgcn_readfirstlane(tid_ >> 6);
  const float* mod = (const float*)(p.ws + OFF_MOD);
  u16* h = (u16*)(p.ws + OFF_HBUF);
  for (int t0 = (blockIdx.x * 8 + wave) * 16; t0 < T_; t0 += gridDim.x * 128) {
    const int b = t0 >> 11;
    float4 gm[4], sh[4];
#pragma unroll
    for (int i = 0; i < 4; i++) {
      const int col = (i * 64 + lane) * 4;
      const float4 g = *(const float4*)(p.pre_mix_g + col);
      const float4 sc = ldmod(mod, b * 6144 + 1024 + col);
      sh[i] = ldmod(mod, b * 6144 + col);
      gm[i] = make_float4(g.x * (1.f + sc.x), g.y * (1.f + sc.y), g.z * (1.f + sc.z), g.w * (1.f + sc.w));
    }
#pragma unroll 2
    for (int r_ = 0; r_ < 16; r_++) {
      const int t = t0 + r_;
      const float4* xr = (const float4*)(p.x + (size_t)t * 1024);
      float4 v[4]; float ss = 0.f;
#pragma unroll
      for (int i = 0; i < 4; i++) { v[i] = xr[i * 64 + lane]; ss += v[i].x * v[i].x + v[i].y * v[i].y + v[i].z * v[i].z + v[i].w * v[i].w; }
      ss = wave_sum(ss);
      const float rstd = rsqrtf(ss * (1.f / 1024.f) + 1e-6f);
#pragma unroll
      for (int i = 0; i < 4; i++) {
        const int col = (i * 64 + lane) * 4;
        const float y0 = (v[i].x * rstd) * gm[i].x + sh[i].x, y1 = (v[i].y * rstd) * gm[i].y + sh[i].y;
        const float y2 = (v[i].z * rstd) * gm[i].z + sh[i].z, y3 = (v[i].w * rstd) * gm[i].w + sh[i].w;
        *(uint2*)(h + (size_t)t * 1024 + col) = make_uint2(pack2(y0, y1), pack2(y2, y3));
      }
    }
  }
}

constexpr int G_ROWB = 144;
constexpr int G_ABYTES = 128 * G_ROWB;
constexpr int G_STAGE = (128 + 256) * G_ROWB;
constexpr int G_SROW = 68;

template <class Epi>
DEV void gemm_tile(const u16* __restrict__ A, int lda, const u16* __restrict__ Bt, int ldb, int K, char* smem, Epi& epi) {
  const int tid = opaque_tid(), lane = tid & 63, wave = __builtin_amdgcn_readfirstlane(tid >> 6), wm = wave >> 2, wn = wave & 3;
  const int r = lane & 31, hh = lane >> 5;
  f32x16 acc00 = zero16(), acc01 = zero16(), acc10 = zero16(), acc11 = zero16();
  uint4 pa0, pa1, pb0, pb1, pb2, pb3;
  uint4 qa0, qa1, qb0, qb1, qb2, qb3;
  const int crow = tid >> 3, ckc = tid & 7;
  const u16* Ap = A + (size_t)crow * lda + ckc * 8;
  const u16* Bp = Bt + (size_t)crow * ldb + ckc * 8;
  const size_t a64 = (size_t)64 * lda, b64 = (size_t)64 * ldb;
  const int loff = crow * G_ROWB + ckc * 16;
#define G_LOAD(S, k0) { S##a0 = *(const uint4*)(Ap + (k0)); S##a1 = *(const uint4*)(Ap + a64 + (k0)); \
    S##b0 = *(const uint4*)(Bp + (k0)); S##b1 = *(const uint4*)(Bp + b64 + (k0)); S##b2 = *(const uint4*)(Bp + 2 * b64 + (k0)); S##b3 = *(const uint4*)(Bp + 3 * b64 + (k0)); }
#define G_STORE(S, buf) { char* sb_ = smem + (buf) * G_STAGE + loff; *(uint4*)(sb_) = S##a0; *(uint4*)(sb_ + 64 * G_ROWB) = S##a1; \
    char* sc_ = sb_ + G_ABYTES; *(uint4*)(sc_) = S##b0; *(uint4*)(sc_ + 64 * G_ROWB) = S##b1; *(uint4*)(sc_ + 128 * G_ROWB) = S##b2; *(uint4*)(sc_ + 192 * G_ROWB) = S##b3; }
#define G_COMPUTE(buf) { const char* sb = smem + (buf) * G_STAGE; _Pragma("unroll") for (int s = 0; s < 4; s++) { \
      const bf16x8 a0 = *(const bf16x8*)(sb + aoff + s * 32); const bf16x8 a1 = *(const bf16x8*)(sb + aoff + 32 * G_ROWB + s * 32); \
      const bf16x8 b0 = *(const bf16x8*)(sb + boff + s * 32); const bf16x8 b1 = *(const bf16x8*)(sb + boff + 32 * G_ROWB + s * 32); \
      acc00 = mfma32(a0, b0, acc00); acc01 = mfma32(a0, b1, acc01); acc10 = mfma32(a1, b0, acc10); acc11 = mfma32(a1, b1, acc11); } }
  const int nk = K >> 6;
  const int aoff = (wm * 64 + r) * G_ROWB + hh * 16;
  const int boff = G_ABYTES + (wn * 64 + r) * G_ROWB + hh * 16;
  G_LOAD(p, 0); G_LOAD(q, 64);
  __syncthreads();
  G_STORE(p, 0);
  __syncthreads();
  for (int kt = 0; kt < nk; kt += 2) {
    if (kt + 2 < nk) G_LOAD(p, (kt + 2) * 64);
    G_COMPUTE(0);
    G_STORE(q, 1);
    __syncthreads();
    if (kt + 3 < nk) G_LOAD(q, (kt + 3) * 64);
    G_COMPUTE(1);
    if (kt + 2 < nk) G_STORE(p, 0);
    __syncthreads();
  }
#undef G_LOAD
#undef G_STORE
#undef G_COMPUTE
  {
    float* stage = (float*)(smem + wave * (64 * G_SROW * 4));
#pragma unroll
    for (int reg = 0; reg < 16; reg++) {
      const int row = (reg & 3) + 8 * (reg >> 2) + 4 * hh;
      stage[row * G_SROW + r] = acc00[reg];
      stage[row * G_SROW + 32 + r] = acc01[reg];
      stage[(32 + row) * G_SROW + r] = acc10[reg];
      stage[(32 + row) * G_SROW + 32 + r] = acc11[reg];
    }
    epi.apply(stage, wm * 64, wn * 64, lane);
  }
}

DEV void ld16(const float* src, float* x) {
  const float4 a = *(const float4*)src, b = *(const float4*)(src + 4), c = *(const float4*)(src + 8), d = *(const float4*)(src + 12);
  x[0] = a.x; x[1] = a.y; x[2] = a.z; x[3] = a.w; x[4] = b.x; x[5] = b.y; x[6] = b.z; x[7] = b.w;
  x[8] = c.x; x[9] = c.y; x[10] = c.z; x[11] = c.w; x[12] = d.x; x[13] = d.y; x[14] = d.z; x[15] = d.w;
}
DEV void st16_bf(u16* dst, const float* x) {
  *(uint4*)dst = make_uint4(pack2(x[0], x[1]), pack2(x[2], x[3]), pack2(x[4], x[5]), pack2(x[6], x[7]));
  *(uint4*)(dst + 8) = make_uint4(pack2(x[8], x[9]), pack2(x[10], x[11]), pack2(x[12], x[13]), pack2(x[14], x[15]));
}
DEV void st16_f(float* dst, const float* x) {
  *(float4*)dst = make_float4(x[0], x[1], x[2], x[3]); *(float4*)(dst + 4) = make_float4(x[4], x[5], x[6], x[7]);
  *(float4*)(dst + 8) = make_float4(x[8], x[9], x[10], x[11]); *(float4*)(dst + 12) = make_float4(x[12], x[13], x[14], x[15]);
}

struct EpiInProj {
  const Params* p; int m0, n0;
  DEV void apply(const float* stage, int rbase, int cbase, int lane) { apply_s<G_SROW>(stage, rbase, cbase, lane); }
  template <int SROW>
  DEV void apply_s(const float* stage, int rbase, int cbase, int lane) {
    const int nb = n0 + cbase;
    unsigned char* ws = p->ws;
    const int tb = m0 + rbase;
    if (nb < 640 || (nb >= 768 && nb < 1344)) {
      u16* dst; int ld, cb;
      if (nb < 512) { dst = (u16*)(ws + OFF_Q); ld = 512; cb = nb; }
      else if (nb < 640) { dst = (u16*)(ws + OFF_K); ld = 128; cb = nb - 512; }
      else if (nb < 1280) { dst = (u16*)(ws + OFF_QI); ld = 512; cb = nb - 768; }
      else { dst = (u16*)(ws + OFF_KI); ld = 64; cb = 0; }
      const float* cosT = (const float*)(ws + OFF_COS); const float* sinT = (const float*)(ws + OFF_SIN);
      const int cg = lane & 1;
#pragma unroll 1
      for (int i = 0; i < 2; i++) {
        const int row = (lane >> 1) + 32 * i; const int t = tb + row;
        float x1[16], x2[16], cs[16], sn[16], o1[16], o2[16];
        ld16(stage + row * SROW + cg * 16, x1); ld16(stage + row * SROW + 32 + cg * 16, x2);
        ld16(cosT + (size_t)t * 32 + cg * 16, cs); ld16(sinT + (size_t)t * 32 + cg * 16, sn);
#pragma unroll
        for (int k = 0; k < 16; k++) { o1[k] = x1[k] * cs[k] - x2[k] * sn[k]; o2[k] = x2[k] * cs[k] + x1[k] * sn[k]; }
        st16_bf(dst + (size_t)t * ld + cb + cg * 16, o1); st16_bf(dst + (size_t)t * ld + cb + 32 + cg * 16, o2);
      }
    } else if (nb >= 640 && nb < 768) {
      u16* vt = (u16*)(ws + OFF_VT);
      const int kvh = (nb - 640) >> 6;
      const int b = tb >> 11, s0 = tb & 2047;
      u16* dp = vt + ((size_t)(b * 2 + kvh) * 64 + lane) * SV_ + s0;
#pragma unroll 1
      for (int q8 = 0; q8 < 8; q8++) {
        float x[8];
#pragma unroll
        for (int k = 0; k < 8; k++) x[k] = stage[(q8 * 8 + k) * SROW + lane];
        *(uint4*)(dp + q8 * 8) = make_uint4(pack2(x[0], x[1]), pack2(x[2], x[3]), pack2(x[4], x[5]), pack2(x[6], x[7]));
      }
    } else if (nb >= 1344 && nb < 2880) {
      u16* dst; int ld, cb;
      if (nb < 1856) { dst = (u16*)(ws + OFF_Z); ld = 512; cb = nb - 1344; }
      else { dst = (u16*)(ws + OFF_XBC); ld = 1024; cb = nb - 1856; }
      const int cg = lane & 1;
#pragma unroll 1
      for (int i = 0; i < 2; i++) {
        const int row = (lane >> 1) + 32 * i; const int t = tb + row;
        float x1[16], x2[16];
        ld16(stage + row * SROW + cg * 16, x1); ld16(stage + row * SROW + 32 + cg * 16, x2);
        st16_bf(dst + (size_t)t * ld + cb + cg * 16, x1); st16_bf(dst + (size_t)t * ld + cb + 32 + cg * 16, x2);
      }
    } else if (nb == 2880) {
      float* wi = (float*)(ws + OFF_WI); float* dtr = (float*)(ws + OFF_DT);
      const int t = tb + lane;
      float x[16];
      ld16(stage + lane * SROW, x);
      const float sc = 0.044194173824159216f;
      *(float4*)(wi + (size_t)t * 8) = make_float4(x[0] * sc, x[1] * sc, x[2] * sc, x[3] * sc);
      *(float4*)(wi + (size_t)t * 8 + 4) = make_float4(x[4] * sc, x[5] * sc, x[6] * sc, x[7] * sc);
      *(float4*)(dtr + (size_t)t * 8) = make_float4(x[8], x[9], x[10], x[11]);
      *(float4*)(dtr + (size_t)t * 8 + 4) = make_float4(x[12], x[13], x[14], x[15]);
    }
  }
};

struct EpiStoreF32 {
  float* dst; int n0;
  DEV void apply(const float* stage, int rbase, int cbase, int lane) {
    const int cg = lane & 1;
#pragma unroll 1
    for (int i = 0; i < 2; i++) {
      const int row = (lane >> 1) + 32 * i;
      float x1[16], x2[16];
      ld16(stage + row * G_SROW + cg * 16, x1); ld16(stage + row * G_SROW + 32 + cg * 16, x2);
      float* d = dst + (size_t)(rbase + row) * 1024 + n0 + cbase + cg * 16;
      st16_f(d, x1); st16_f(d + 32, x2);
    }
  }
};
struct EpiStoreBf16 {
  u16* dst; int n0;
  DEV void apply(const float* stage, int rbase, int cbase, int lane) {
    const int cg = lane & 1;
#pragma unroll 1
    for (int i = 0; i < 2; i++) {
      const int row = (lane >> 1) + 32 * i;
      float x1[16], x2[16];
      ld16(stage + row * G_SROW + cg * 16, x1); ld16(stage + row * G_SROW + 32 + cg * 16, x2);
      u16* d = dst + (size_t)(rbase + row) * 1024 + n0 + cbase + cg * 16;
      st16_bf(d, x1); st16_bf(d + 32, x2);
    }
  }
};

typedef __attribute__((ext_vector_type(4))) float f32x4v;
constexpr int P8_HT = 128 * 64;
constexpr int P8_SROW = 260;
DEV int p8_lds_byte(int r, int c) {
  const int st = (r >> 4) * 2 + (c >> 5), rr = r & 15, cc = c & 31, ob = rr * 64 + cc * 2;
  return st * 1024 + (ob ^ (((ob >> 9) & 1) << 5));
}
DEV void p8_stage_rc(int b, int& R, int& C) {
  const int st = b / 1024, sb = b % 1024, swz = sb ^ (((sb >> 9) & 1) << 5);
  R = (st >> 1) * 16 + swz / 64; C = (st & 1) * 32 + (swz % 64) / 2;
}
template <class Epi>
DEV void gemm256_8phase(const u16* __restrict__ A, const u16* __restrict__ Bt, int brow, int bcol, char* smem, Epi& epi) {
  constexpr int K = 1024, BK = 64, HALF = 128;
  u16* shm = (u16*)smem;
  const int tid = opaque_tid();
#define SA(b,h) (shm+((b)*2+(h))*P8_HT)
#define SB(b,h) (shm+(4+(b)*2+(h))*P8_HT)
#define P8STAGE(P,BASE,br,kt) do{ const long _g=(long)(br)*K+(long)(kt)*BK; \
    _Pragma("unroll") for(int _i=0;_i<2;++_i){ const int _b=tid*16+_i*8192; int _r,_c; p8_stage_rc(_b,_r,_c); \
      __builtin_amdgcn_global_load_lds((const unsigned*)(BASE+_g+(long)_r*K+_c), (__attribute__((address_space(3))) unsigned*)((char*)(P)+_b),16,0,0);} }while(0)
#define LDA(dst,b,h) _Pragma("unroll") for(int m=0;m<4;++m) _Pragma("unroll") for(int k=0;k<2;++k) \
    dst[m][k]=*reinterpret_cast<const bf16x8*>((char*)SA(b,h)+p8_lds_byte(wr*64+m*16+fr,k*32+fq*8))
#define LDB(dst,b,h) _Pragma("unroll") for(int n=0;n<2;++n) _Pragma("unroll") for(int k=0;k<2;++k) \
    dst[n][k]=*reinterpret_cast<const bf16x8*>((char*)SB(b,h)+p8_lds_byte(wc*32+n*16+fr,k*32+fq*8))
#define MMA(ai,bj,At,Bt_) do{ __builtin_amdgcn_s_setprio(1); \
    _Pragma("unroll") for(int m=0;m<4;++m) _Pragma("unroll") for(int n=0;n<2;++n) _Pragma("unroll") for(int k=0;k<2;++k) \
      acc[ai][bj][m][n]=__builtin_amdgcn_mfma_f32_16x16x32_bf16(At[m][k],Bt_[n][k],acc[ai][bj][m][n],0,0,0); \
    __builtin_amdgcn_s_setprio(0);}while(0)
#define WAIT_V(n) asm volatile("s_waitcnt vmcnt(" #n ")":::"memory")
#define WAIT_L(n) asm volatile("s_waitcnt lgkmcnt(" #n ")":::"memory")
#define BAR __builtin_amdgcn_s_barrier()
#define SCHED __builtin_amdgcn_sched_barrier(0)
  const int wid = __builtin_amdgcn_readfirstlane(tid >> 6), lane = tid & 63, wr = wid >> 2, wc = wid & 3, fr = lane & 15, fq = lane >> 4;
  f32x4v acc[2][2][4][2];
#pragma unroll
  for (int a_ = 0; a_ < 2; a_++)
#pragma unroll
    for (int b_ = 0; b_ < 2; b_++)
#pragma unroll
      for (int m = 0; m < 4; m++)
#pragma unroll
        for (int n = 0; n < 2; n++) acc[a_][b_][m][n] = (f32x4v){0.f, 0.f, 0.f, 0.f};
  bf16x8 At[4][2], B0[2][2], B1[2][2];
  constexpr int nt = K / BK;
  asm volatile("s_waitcnt vmcnt(0) lgkmcnt(0)" ::: "memory");
  __syncthreads();
  P8STAGE(SB(0,0),Bt,bcol,0); P8STAGE(SA(0,0),A,brow,0);
  P8STAGE(SB(0,1),Bt,bcol+HALF,0); P8STAGE(SA(0,1),A,brow+HALF,0);
  if(wr==1)BAR;
  WAIT_V(4); BAR;
  P8STAGE(SB(1,0),Bt,bcol,1); P8STAGE(SA(1,0),A,brow,1); P8STAGE(SB(1,1),Bt,bcol+HALF,1);
  WAIT_V(6); BAR;
#pragma unroll 1
  for(int t=0;t<nt-2;t+=2){
    LDB(B0,0,0); SCHED; LDA(At,0,0); P8STAGE(SA(1,1),A,brow+HALF,t+1);
    WAIT_L(8); BAR; WAIT_L(0); MMA(0,0,At,B0); BAR; SCHED;
    LDB(B1,0,1); P8STAGE(SB(0,0),Bt,bcol,t+2);
    BAR; WAIT_L(0); MMA(0,1,At,B1); BAR;
    LDA(At,0,1); P8STAGE(SA(0,0),A,brow,t+2);
    BAR; WAIT_L(0); MMA(1,0,At,B0); BAR; SCHED;
    P8STAGE(SB(0,1),Bt,bcol+HALF,t+2);
    WAIT_V(6); BAR; MMA(1,1,At,B1); BAR;
    LDB(B0,1,0); SCHED; LDA(At,1,0); P8STAGE(SA(0,1),A,brow+HALF,t+2);
    WAIT_L(8); BAR; WAIT_L(0); MMA(0,0,At,B0); BAR; SCHED;
    LDB(B1,1,1); P8STAGE(SB(1,0),Bt,bcol,t+3);
    BAR; WAIT_L(0); MMA(0,1,At,B1); BAR;
    LDA(At,1,1); P8STAGE(SA(1,0),A,brow,t+3);
    BAR; WAIT_L(0); MMA(1,0,At,B0); BAR; SCHED;
    P8STAGE(SB(1,1),Bt,bcol+HALF,t+3);
    WAIT_V(6); BAR; MMA(1,1,At,B1); BAR;
  }
  { LDB(B0,0,0); LDA(At,0,0); P8STAGE(SA(1,1),A,brow+HALF,nt-1);
    BAR; WAIT_L(0); MMA(0,0,At,B0); BAR;
    LDB(B1,0,1); BAR; WAIT_L(0); MMA(0,1,At,B1); BAR;
    LDA(At,0,1); WAIT_V(4); BAR; WAIT_L(0); MMA(1,0,At,B0); MMA(1,1,At,B1); BAR; }
  { LDB(B0,1,0); LDA(At,1,0); WAIT_V(2); BAR; WAIT_L(0); MMA(0,0,At,B0); BAR;
    LDB(B1,1,1); WAIT_V(0); BAR; WAIT_L(0); MMA(0,1,At,B1); BAR;
    LDA(At,1,1); BAR; WAIT_L(0); MMA(1,0,At,B0); MMA(1,1,At,B1); BAR; }
  if(wr==0)BAR;
  float* img = (float*)smem;
#pragma unroll
  for (int ai = 0; ai < 2; ai++) {
    __syncthreads();
#pragma unroll
    for (int bj = 0; bj < 2; bj++)
#pragma unroll
      for (int m = 0; m < 4; m++)
#pragma unroll
        for (int n = 0; n < 2; n++)
#pragma unroll
          for (int j = 0; j < 4; j++)
            img[(wr * 64 + m * 16 + fq * 4 + j) * P8_SROW + bj * HALF + wc * 32 + n * 16 + fr] = acc[ai][bj][m][n][j];
    __syncthreads();
    epi.template apply_s<P8_SROW>(img + (wid >> 2) * 64 * P8_SROW + (wid & 3) * 64, ai * 128 + (wid >> 2) * 64, (wid & 3) * 64, lane);
  }
  __syncthreads();
#undef SA
#undef SB
#undef P8STAGE
#undef LDA
#undef LDB
#undef MMA
#undef WAIT_V
#undef WAIT_L
#undef BAR
#undef SCHED
}

DEV void phase1(const Params& p, char* smem) {
  const u16* h = (const u16*)(p.ws + OFF_HBUF);
  const u16* wt = (const u16*)(p.ws + OFF_WTIN);
  if (blockIdx.x & 1) convert_i8_rows(p.peer_u, p.ws + OFF_U, (float*)(p.ws + OFF_SU));
  const int ntiles = 128 * 12;
  for (int tile = blockIdx.x; tile < ntiles; tile += gridDim.x) {
    const int mt = tile % 128, nt = tile / 128;
    EpiInProj epi{&p, mt * 256, nt * 256};
    gemm256_8phase(h, wt, mt * 256, nt * 256, smem, epi);
  }
  if (!(blockIdx.x & 1)) convert_i8_rows(p.peer_u, p.ws + OFF_U, (float*)(p.ws + OFF_SU));
}

constexpr int DS_QROW = 1040;
constexpr int DS_CNT = 32 * DS_QROW;
constexpr int DS_MASK = DS_CNT + 2 * 8 * 32 * 4;
constexpr int DS_WQ = DS_MASK + 64 * 64 * 2;
constexpr int DS_KV = DS_WQ + 1024;
constexpr int DS_KVSTAGE = 2 * 32 * 144 + 2 * 64 * 72;
constexpr int DS_VOFF = 2 * 32 * 144;

DEV int dsa_reduce(int c, unsigned* cbuf, int& par, int r, int hh, int w) {
  c += __shfl_xor(c, 32);
  unsigned* bq = cbuf + par * 256;
  if (hh == 0) bq[w * 32 + r] = (unsigned)c;
  __syncthreads();
  int tot = 0;
#pragma unroll
  for (int k = 0; k < 8; k++) tot += (int)bq[k * 32 + r];
  par ^= 1;
  return tot;
}

DEV void dsa_item(const Params& p, int b, int qt, char* smem) {
  const int tid = opaque_tid(), lane = tid & 63, w = __builtin_amdgcn_readfirstlane(tid >> 6), r = lane & 31, hh = lane >> 5;
  const int q0 = qt * 32; const size_t tb = (size_t)b * 2048;
  const u16* qi = (const u16*)(p.ws + OFF_QI);
  const u16* ki = (const u16*)(p.ws + OFF_KI);
  const float* wi = (const float*)(p.ws + OFF_WI);
  unsigned* cbuf = (unsigned*)(smem + DS_CNT);
  u16* maskb = (u16*)(smem + DS_MASK);
  const bool need_sel = (qt >= 8);
  __syncthreads();
  if (need_sel) {
#pragma unroll
    for (int i = 0; i < 4; i++) {
      int c = tid + i * 512; int row = c >> 6, cc = c & 63;
      *(uint4*)(smem + row * DS_QROW + cc * 16) = *(const uint4*)(qi + (tb + q0 + row) * 512 + cc * 8);
    }
    if (tid < 256) ((float*)(smem + DS_WQ))[tid] = wi[(tb + q0) * 8 + tid];
  }
  __syncthreads();
  if (need_sel) {
    const float* wql = (const float*)(smem + DS_WQ) + r * 8;
    u32x16 uk[8];
#pragma unroll
    for (int i = 0; i < 8; i++) {
      const int kt = w + 8 * i;
      if (kt <= qt) {
        const u16* kp = ki + (tb + kt * 32 + r) * 64 + hh * 8;
        bf16x8 ka[4];
#pragma unroll
        for (int s = 0; s < 4; s++) ka[s] = *(const bf16x8*)(kp + s * 16);
        f32x16 scr = zero16();
#pragma unroll 2
        for (int h8 = 0; h8 < 8; h8++) {
          f32x16 a = zero16();
          const char* qrow = smem + r * DS_QROW + h8 * 128 + hh * 16;
#pragma unroll
          for (int s = 0; s < 4; s++) {
            const bf16x8 qb = *(const bf16x8*)(qrow + s * 32);
            a = mfma32(ka[s], qb, a);
          }
          const float wv = wql[h8];
#pragma unroll
          for (int reg = 0; reg < 16; reg++) scr[reg] = fmaf(wv, fmaxf(a[reg], 0.f), scr[reg]);
        }
#pragma unroll
        for (int reg = 0; reg < 16; reg++) {
          float v = scr[reg];
          if (kt == qt && ((reg & 3) + 8 * (reg >> 2)) > r - 4 * hh) v = NEG_INF;
          uk[i][reg] = ordkey(v);
        }
      } else {
#pragma unroll
        for (int reg = 0; reg < 16; reg++) uk[i][reg] = 0u;
      }
    }
    int par = 0;
    unsigned T = 0u;
    unsigned* lst = (unsigned*)(smem + DS_KV);
    unsigned* lcnt = (unsigned*)(smem + DS_KV + 16384);
    unsigned* lhic = lcnt + 32;
    unsigned* ltp = lcnt + 64;
    for (int rep_b = 0; rep_b < PROBE_DSA_BIS; rep_b++) {
    T = 0u;
    if (tid < 32) lcnt[tid] = 0u;
    for (int it = 0; it < 12; ++it) {
      const unsigned cand = T | (0x80000000u >> it);
      int c = 0;
#pragma unroll
      for (int i = 0; i < 8; i++) {
        if (w + 8 * i <= qt) {
#pragma unroll
          for (int reg = 0; reg < 16; reg++) c += (uk[i][reg] >= cand) ? 1 : 0;
        }
      }
      if (dsa_reduce(c, cbuf, par, r, hh, w) >= 256) T = cand;
    }
    int hic;
    {
      const bool ovf = (T >= 0xFFF00000u);
      const unsigned hi = T + 0x00100000u;
      int c = 0;
      if (!ovf) {
#pragma unroll
        for (int i = 0; i < 8; i++) {
          if (w + 8 * i <= qt) {
#pragma unroll
            for (int reg = 0; reg < 16; reg++) c += (uk[i][reg] >= hi) ? 1 : 0;
          }
        }
      }
      hic = dsa_reduce(c, cbuf, par, r, hh, w);
    }
#pragma unroll
    for (int i = 0; i < 8; i++) {
      if (w + 8 * i <= qt) {
#pragma unroll
        for (int reg = 0; reg < 16; reg++) {
          const unsigned d = uk[i][reg] - T;
          if (d < 0x00100000u) { const unsigned pos = atomicAdd(&lcnt[r], 1u); if (pos < 128u) lst[r * 128 + pos] = d; }
        }
      }
    }
    if (w == 0 && hh == 0) { lhic[r] = (unsigned)hic; ltp[r] = T; }
    __syncthreads();
    if (!__syncthreads_or(lcnt[r] > 128u)) {
      const int qsub = lane >> 4, l16 = lane & 15, q = 4 * w + qsub;
      const int n = (int)lcnt[q];
      const int kp = 256 - (int)lhic[q];
      unsigned v[8];
#pragma unroll
      for (int j = 0; j < 8; j++) { const int ix = l16 + 16 * j; v[j] = (ix < n) ? lst[q * 128 + ix] : 0u; }
      unsigned Tl = 0u;
#pragma unroll 1
      for (int bit = 19; bit >= 0; --bit) {
        const unsigned cand = Tl | (1u << bit);
        int c = 0;
#pragma unroll
        for (int j = 0; j < 8; j++) c += (v[j] >= cand) ? 1 : 0;
        c += __builtin_amdgcn_update_dpp(0, c, 0xB1, 0xF, 0xF, false);
        c += __builtin_amdgcn_update_dpp(0, c, 0x4E, 0xF, 0xF, false);
        c += __builtin_amdgcn_update_dpp(0, c, 0x141, 0xF, 0xF, false);
        c += __builtin_amdgcn_update_dpp(0, c, 0x140, 0xF, 0xF, false);
        if (c >= kp) Tl = cand;
      }
      const unsigned tq = ltp[q] | Tl;
      __syncthreads();
      if (l16 == 0) ltp[q] = tq;
      __syncthreads();
      T = ltp[r];
    } else {
      for (int it = 12; it < 32; ++it) {
        const unsigned cand = T | (0x80000000u >> it);
        int c = 0;
#pragma unroll
        for (int i = 0; i < 8; i++) {
          if (w + 8 * i <= qt) {
#pragma unroll
            for (int reg = 0; reg < 16; reg++) c += (uk[i][reg] >= cand) ? 1 : 0;
          }
        }
        if (dsa_reduce(c, cbuf, par, r, hh, w) >= 256) T = cand;
      }
    }
    }
    int cge;
    {
      int c = 0;
      unsigned Tv = T;
      asm volatile("" : "+v"(Tv));
#pragma unroll
      for (int i = 0; i < 8; i++) {
        if (w + 8 * i <= qt) {
#pragma unroll
          for (int reg = 0; reg < 16; reg++) c += (uk[i][reg] >= Tv) ? 1 : 0;
        }
      }
      cge = dsa_reduce(c, cbuf, par, r, hh, w);
    }
    unsigned J = 4095u;
    if (__syncthreads_or(cge != 256)) {
      int need;
      {
        int c = 0;
        unsigned Tv = T;
        asm volatile("" : "+v"(Tv));
#pragma unroll
        for (int i = 0; i < 8; i++) {
          if (w + 8 * i <= qt) {
#pragma unroll
            for (int reg = 0; reg < 16; reg++) c += (uk[i][reg] > Tv) ? 1 : 0;
          }
        }
        need = 256 - dsa_reduce(c, cbuf, par, r, hh, w);
      }
      J = 0u;
      for (int it = 0; it < 12; ++it) {
        const unsigned cj = J | (2048u >> it);
        int c = 0;
        unsigned Tv = T;
        asm volatile("" : "+v"(Tv));
#pragma unroll
        for (int i = 0; i < 8; i++) {
          if (w + 8 * i <= qt) {
            const int lim = (int)cj - ((w + 8 * i) * 32 + 4 * hh);
#pragma unroll
            for (int reg = 0; reg < 16; reg++) c += (uk[i][reg] == Tv && ((reg & 3) + 8 * (reg >> 2)) < lim) ? 1 : 0;
          }
        }
        if (dsa_reduce(c, cbuf, par, r, hh, w) <= need) J = cj;
      }
    }
#pragma unroll
    for (int i = 0; i < 8; i++) {
      const int kt = w + 8 * i;
      if (kt <= qt) {
        const int lim = (int)J - (kt * 32 + 4 * hh);
        unsigned bits = 0u;
#pragma unroll
        for (int reg = 0; reg < 16; reg++) {
          const unsigned u = uk[i][reg];
          const bool sel = (u > T) || (u == T && ((reg & 3) + 8 * (reg >> 2)) < lim);
          bits |= (sel ? 1u : 0u) << reg;
        }
        maskb[kt * 64 + lane] = (u16)bits;
      }
    }
  } else {
#pragma unroll
    for (int i = 0; i < 8; i++) {
      const int kt = w + 8 * i;
      if (kt <= qt) {
        unsigned bits = 0xFFFFu;
        if (kt == qt) {
          bits = 0u;
#pragma unroll
          for (int reg = 0; reg < 16; reg++) bits |= ((((reg & 3) + 8 * (reg >> 2)) <= r - 4 * hh) ? 1u : 0u) << reg;
        }
        maskb[kt * 64 + lane] = (u16)bits;
      }
    }
  }
  for (int rep_a = 0; rep_a < PROBE_DSA_ATT; rep_a++)
  {
    const int head = w, kvh = w >> 2;
    const u16* q = (const u16*)(p.ws + OFF_Q);
    const u16* kk = (const u16*)(p.ws + OFF_K);
    const u16* vt = (const u16*)(p.ws + OFF_VT);
    bf16x8 qf[4];
    {
      const u16* qp = q + (tb + q0 + r) * 512 + head * 64 + hh * 8;
#pragma unroll
      for (int s = 0; s < 4; s++) qf[s] = *(const bf16x8*)(qp + s * 16);
    }
    const int l_kvh = tid >> 8;
    const int k_row = (tid >> 3) & 31, k_ch = tid & 7;
    const int v_d = (tid >> 2) & 63, v_ch = tid & 3;
    const u16* gk = kk + (tb + k_row) * 128 + l_kvh * 64 + k_ch * 8;
    const u16* gv = vt + ((size_t)(b * 2 + l_kvh) * 64 + v_d) * SV_ + v_ch * 8;
    const int lk = DS_KV + l_kvh * (32 * 144) + k_row * 144 + k_ch * 16;
    const int lv = DS_KV + DS_VOFF + l_kvh * (64 * 72) + v_d * 72 + v_ch * 16;
    const int fk = DS_KV + kvh * (32 * 144) + r * 144 + hh * 16;
    const int fv = DS_KV + DS_VOFF + kvh * (64 * 72) + r * 72 + hh * 8;
    const int nsteps = (qt + 2) >> 1;
    uint4 rkA, rvA, rkB, rvB;
#define AT_LOAD(j_) { const int ka_ = 2 * (j_), kb_ = (2 * (j_) + 1 <= qt) ? 2 * (j_) + 1 : qt; \
      rkA = *(const uint4*)(gk + (size_t)ka_ * 32 * 128); rvA = *(const uint4*)(gv + ka_ * 32); \
      rkB = *(const uint4*)(gk + (size_t)kb_ * 32 * 128); rvB = *(const uint4*)(gv + kb_ * 32); }
#define AT_STORE(sb_) { char* d_ = smem + (sb_) * (2 * DS_KVSTAGE); \
      *(uint4*)(d_ + lk) = rkA; *(uint2*)(d_ + lv) = make_uint2(rvA.x, rvA.y); *(uint2*)(d_ + lv + 8) = make_uint2(rvA.z, rvA.w); \
      *(uint4*)(d_ + DS_KVSTAGE + lk) = rkB; *(uint2*)(d_ + DS_KVSTAGE + lv) = make_uint2(rvB.x, rvB.y); *(uint2*)(d_ + DS_KVSTAGE + lv + 8) = make_uint2(rvB.z, rvB.w); }
    AT_LOAD(0);
    __syncthreads();
    AT_STORE(0);
    __syncthreads();
    f32x16 o0 = zero16(), o1 = zero16();
    float m = NEG_INF, l = 0.f;
    const float SC = 0.125f * 1.4426950408889634f;
    for (int j = 0; j < nsteps; ++j) {
      const char* stg = smem + (j & 1) * (2 * DS_KVSTAGE);
      if (j + 1 < nsteps) AT_LOAD(j + 1);
      f32x16 sa = zero16(), sb = zero16();
#pragma unroll
      for (int s = 0; s < 4; s++) {
        const bf16x8 kfa = *(const bf16x8*)(stg + fk + s * 32);
        const bf16x8 kfb = *(const bf16x8*)(stg + DS_KVSTAGE + fk + s * 32);
        sa = mfma32(kfa, qf[s], sa); sb = mfma32(kfb, qf[s], sb);
      }
      const unsigned bitsA = maskb[(2 * j) * 64 + lane];
      const unsigned bitsB = (2 * j + 1 <= qt) ? (unsigned)maskb[(2 * j + 1) * 64 + lane] : 0u;
#pragma unroll
      for (int reg = 0; reg < 16; reg++) { sa[reg] = ((bitsA >> reg) & 1u) ? sa[reg] : NEG_INF; sb[reg] = ((bitsB >> reg) & 1u) ? sb[reg] : NEG_INF; }
      float tmax = fmaxf(fmaxf(sa[0], sb[0]), fmaxf(sa[1], sb[1]));
#pragma unroll
      for (int reg = 2; reg < 16; reg += 2) tmax = fmaxf(tmax, fmaxf(fmaxf(sa[reg], sb[reg]), fmaxf(sa[reg + 1], sb[reg + 1])));
      tmax = fmaxf(tmax, __shfl_xor(tmax, 32));
      const float mn = fmaxf(m, tmax);
      const float ms = (mn == NEG_INF) ? 0.f : mn;
      const float nmsc = -ms * SC;
      float ps = 0.f, ps2 = 0.f;
#pragma unroll
      for (int reg = 0; reg < 16; reg++) {
        const float pa = __builtin_amdgcn_exp2f(fmaf(sa[reg], SC, nmsc)), pb = __builtin_amdgcn_exp2f(fmaf(sb[reg], SC, nmsc));
        sa[reg] = pa; sb[reg] = pb; ps += pa; ps2 += pb;
      }
      if (__any(mn != m)) {
        const float alpha = __builtin_amdgcn_exp2f(fmaf(m, SC, nmsc));
        l *= alpha;
#pragma unroll
        for (int reg = 0; reg < 16; reg++) { o0[reg] *= alpha; o1[reg] *= alpha; }
      }
      l += ps + ps2; m = mn;
      {
        const bf16x8 pf0 = pack_frag(sa, 0), pf1 = pack_frag(sa, 8);
        const char* vb = stg + fv;
        const bf16x8 v00 = mk_frag(*(const uint2*)(vb), *(const uint2*)(vb + 16));
        const bf16x8 v01 = mk_frag(*(const uint2*)(vb + 32), *(const uint2*)(vb + 48));
        const bf16x8 v10 = mk_frag(*(const uint2*)(vb + 32 * 72), *(const uint2*)(vb + 32 * 72 + 16));
        const bf16x8 v11 = mk_frag(*(const uint2*)(vb + 32 * 72 + 32), *(const uint2*)(vb + 32 * 72 + 48));
        o0 = mfma32(v00, pf0, o0); o1 = mfma32(v10, pf0, o1);
        o0 = mfma32(v01, pf1, o0); o1 = mfma32(v11, pf1, o1);
      }
      {
        const bf16x8 pf0 = pack_frag(sb, 0), pf1 = pack_frag(sb, 8);
        const char* vb = stg + DS_KVSTAGE + fv;
        const bf16x8 v00 = mk_frag(*(const uint2*)(vb), *(const uint2*)(vb + 16));
        const bf16x8 v01 = mk_frag(*(const uint2*)(vb + 32), *(const uint2*)(vb + 48));
        const bf16x8 v10 = mk_frag(*(const uint2*)(vb + 32 * 72), *(const uint2*)(vb + 32 * 72 + 16));
        const bf16x8 v11 = mk_frag(*(const uint2*)(vb + 32 * 72 + 32), *(const uint2*)(vb + 32 * 72 + 48));
        o0 = mfma32(v00, pf0, o0); o1 = mfma32(v10, pf0, o1);
        o0 = mfma32(v01, pf1, o0); o1 = mfma32(v11, pf1, o1);
      }
      if (j + 1 < nsteps) AT_STORE((j + 1) & 1);
      __syncthreads();
    }
#undef AT_LOAD
#undef AT_STORE
    const float lt = l + __shfl_xor(l, 32);
    const float inv = 1.f / lt;
    u16* cat = (u16*)(p.ws + OFF_HBUF);
    u16* op = cat + (tb + q0 + r) * 1024 + head * 64 + 4 * hh;
#pragma unroll
    for (int gq = 0; gq < 4; gq++) {
      *(uint2*)(op + 8 * gq) = make_uint2(pack2(o0[4 * gq] * inv, o0[4 * gq + 1] * inv), pack2(o0[4 * gq + 2] * inv, o0[4 * gq + 3] * inv));
      *(uint2*)(op + 32 + 8 * gq) = make_uint2(pack2(o1[4 * gq] * inv, o1[4 * gq + 1] * inv), pack2(o1[4 * gq + 2] * inv, o1[4 * gq + 3] * inv));
    }
  }
}

constexpr int SA_ROW = 272;
constexpr int SA_XROW = 144;
constexpr int SA_C = 0, SA_B = 128 * SA_ROW;
constexpr int SA_XDT = 2 * 128 * SA_ROW;
constexpr int SA_XDS = SA_XDT + 128 * SA_XROW;
constexpr int SA_FL = SA_XDS + 128 * SA_XROW;

DEV float silu_fast(float v) { return v * __builtin_amdgcn_rcpf(1.f + __builtin_amdgcn_exp2f(-1.4426950408889634f * v)); }

DEV void conv_pair8(const u16* __restrict__ xbc, const float* __restrict__ cw, const float* __restrict__ cbias, size_t tb, int pos0, int ch, float* o0, float* o1) {
  const float2 w0 = *(const float2*)(cw + ch), w1 = *(const float2*)(cw + 1024 + ch), w2 = *(const float2*)(cw + 2048 + ch), w3 = *(const float2*)(cw + 3072 + ch);
  const float2 bs = *(const float2*)(cbias + ch);
  unsigned xr[11];
#pragma unroll
  for (int j = 0; j < 11; j++) { const int sp = pos0 - 3 + j; xr[j] = (sp >= 0) ? *(const unsigned*)(xbc + (tb + sp) * 1024 + ch) : 0u; }
#pragma unroll
  for (int j = 0; j < 8; j++) {
    float a = bs.x, c = bs.y;
    a = fmaf(w0.x, bflo(xr[j]), a); c = fmaf(w0.y, bfhi(xr[j]), c);
    a = fmaf(w1.x, bflo(xr[j + 1]), a); c = fmaf(w1.y, bfhi(xr[j + 1]), c);
    a = fmaf(w2.x, bflo(xr[j + 2]), a); c = fmaf(w2.y, bfhi(xr[j + 2]), c);
    a = fmaf(w3.x, bflo(xr[j + 3]), a); c = fmaf(w3.y, bfhi(xr[j + 3]), c);
    o0[j] = silu_fast(a); o1[j] = silu_fast(c);
  }
}

DEV bf16x8 gather8(const char* base, int stride, bool perm) {
  unsigned v[8];
#pragma unroll
  for (int j = 0; j < 8; j++) { const int row = perm ? ((j & 3) + 8 * (j >> 2)) : j; v[j] = *(const u16*)(base + row * stride); }
  union { uint4 u; bf16x8 f; } t;
  t.u = make_uint4(v[0] | (v[1] << 16), v[2] | (v[3] << 16), v[4] | (v[5] << 16), v[6] | (v[7] << 16));
  return t.f;
}

DEV void ssdA_item(const Params& p, int b, int c, int g, char* smem) {
  const int tid = opaque_tid(), lane = tid & 63, w = __builtin_amdgcn_readfirstlane(tid >> 6), r = lane & 31, hh = lane >> 5;
  const size_t tb = (size_t)b * 2048;
  const u16* xbc = (const u16*)(p.ws + OFF_XBC);
  const float* dtraw = (const float*)(p.ws + OFF_DT);
  __syncthreads();
  {
    u16* ccg = (u16*)(p.ws + OFF_CC);
#pragma unroll 1
    for (int k = 0; k < 4; k++) {
      const int e = tid + k * 512;
      const int pr = e & 63, lb = (e >> 6) & 15, which = e >> 10;
      const int n = 2 * pr, l0 = lb * 8;
      float o0[8], o1[8];
      conv_pair8(xbc, p.conv_w, p.conv_b, tb, c * 128 + l0, 512 + which * 256 + g * 128 + n, o0, o1);
      char* dst = smem + (which ? SA_C : SA_B) + l0 * SA_ROW + n * 2;
#pragma unroll
      for (int j = 0; j < 8; j++) {
        const unsigned pk = pack2(o0[j], o1[j]);
        *(unsigned*)(dst + j * SA_ROW) = pk;
        if (which) *(unsigned*)(ccg + (tb + c * 128 + l0 + j) * 256 + g * 128 + n) = pk;
      }
    }
  }
  if (w < 4) {
    const int h = g * 4 + w;
    float* dtv_ = (float*)(smem + SA_FL) + w * 384; float* acum_ = dtv_ + 128; float* decs_ = dtv_ + 256;
    {
      const float A = -expf(p.a_log[h]);
      const float bias = p.dt_bias[h];
      float x0 = dtraw[(tb + c * 128 + lane) * 8 + h] + bias;
      float x1 = dtraw[(tb + c * 128 + 64 + lane) * 8 + h] + bias;
      float d0 = (x0 > 20.f) ? x0 : log1pf(expf(x0));
      float d1 = (x1 > 20.f) ? x1 : log1pf(expf(x1));
      dtv_[lane] = d0; dtv_[64 + lane] = d1;
      float v0 = d0 * A, v1 = d1 * A;
#pragma unroll
      for (int o = 1; o < 64; o <<= 1) { float n0 = __shfl_up(v0, o), n1 = __shfl_up(v1, o); if (lane >= o) { v0 += n0; v1 += n1; } }
      const float tot0 = __shfl(v0, 63);
      v1 += tot0;
      acum_[lane] = v0; acum_[64 + lane] = v1;
      const float atot = __shfl(v1, 63);
      decs_[lane] = expf(atot - v0); decs_[64 + lane] = expf(atot - v1);
    }
  }
#pragma unroll 1
  for (int h4 = 0; h4 < 4; h4++) {
    const int h = g * 4 + h4;
    float* dtv = (float*)(smem + SA_FL) + h4 * 384; float* acum = dtv + 128; float* decs = dtv + 256;
    __syncthreads();
    {
      const int pr = tid & 31, lb = tid >> 5;
      const int pp = 2 * pr, l0 = lb * 8;
      float o0[8], o1[8];
      conv_pair8(xbc, p.conv_w, p.conv_b, tb, c * 128 + l0, h * 64 + pp, o0, o1);
#pragma unroll
      for (int j = 0; j < 8; j++) {
        const float d = dtv[l0 + j], ds = decs[l0 + j];
        const float a0 = o0[j] * d, a1 = o1[j] * d;
        *(unsigned*)(smem + SA_XDT + (l0 + j) * SA_XROW + pp * 2) = pack2(a0, a1);
        *(unsigned*)(smem + SA_XDS + (l0 + j) * SA_XROW + pp * 2) = pack2(a0 * ds, a1 * ds);
      }
    }
    __syncthreads();
    {
      const int pt = w & 1, lt = w >> 1;
      const int lidx = lt * 32 + r;
      const float acl = acum[lidx];
      f32x16 yT = zero16();
      for (int st = 0; st <= lt; ++st) {
        f32x16 cb = zero16();
#pragma unroll
        for (int ks = 0; ks < 8; ks++) {
          const bf16x8 a = *(const bf16x8*)(smem + SA_B + (st * 32 + r) * SA_ROW + ks * 32 + hh * 16);
          const bf16x8 bq = *(const bf16x8*)(smem + SA_C + (lt * 32 + r) * SA_ROW + ks * 32 + hh * 16);
          cb = mfma32(a, bq, cb);
        }
#pragma unroll
        for (int reg = 0; reg < 16; reg++) {
          const int sidx = st * 32 + rowmap(reg, hh);
          const float as = acum[sidx];
          cb[reg] = (sidx <= lidx) ? cb[reg] * __builtin_amdgcn_exp2f((acl - as) * 1.4426950408889634f) : 0.f;
        }
        const bf16x8 mf0 = pack_frag(cb, 0), mf1 = pack_frag(cb, 8);
        const char* xb = smem + SA_XDT + (st * 32 + 4 * hh) * SA_XROW + (pt * 32 + r) * 2;
        const bf16x8 x0 = gather8(xb, SA_XROW, true);
        const bf16x8 x1 = gather8(xb + 16 * SA_XROW, SA_XROW, true);
        yT = mfma32(x0, mf0, yT); yT = mfma32(x1, mf1, yT);
      }
      const float dsk = p.d_skip[h] / dtv[lidx];
      float* yp = (float*)(p.ws + OFF_YP) + (tb + c * 128 + lidx) * 512 + h * 64 + pt * 32 + 4 * hh;
#pragma unroll
      for (int gq = 0; gq < 4; gq++) {
        const uint2 xv = *(const uint2*)(smem + SA_XDT + lidx * SA_XROW + (pt * 32 + 8 * gq + 4 * hh) * 2);
        *(float4*)(yp + 8 * gq) = make_float4(yT[4 * gq] + dsk * bflo(xv.x), yT[4 * gq + 1] + dsk * bfhi(xv.x), yT[4 * gq + 2] + dsk * bflo(xv.y), yT[4 * gq + 3] + dsk * bfhi(xv.y));
      }
      const int nt = w >> 1;
      f32x16 sacc = zero16();
#pragma unroll
      for (int ks = 0; ks < 8; ks++) {
        const bf16x8 a = gather8(smem + SA_XDS + (ks * 16 + hh * 8) * SA_XROW + (pt * 32 + r) * 2, SA_XROW, false);
        const bf16x8 bq = gather8(smem + SA_B + (ks * 16 + hh * 8) * SA_ROW + (nt * 32 + r) * 2, SA_ROW, false);
        sacc = mfma32(a, bq, sacc);
      }
      float* stp = (float*)(p.ws + OFF_ST) + ((size_t)((b * 16 + c) * 8 + h) * 64) * 128;
#pragma unroll
      for (int reg = 0; reg < 16; reg++) stp[(pt * 32 + rowmap(reg, hh)) * 128 + nt * 32 + r] = sacc[reg];
      if (tid < 128) ((float*)(p.ws + OFF_ACUM))[((b * 16 + c) * 8 + h) * 128 + tid] = acum[tid];
    }
  }
}

DEV void ssdS_item(const Params& p, int b, int h, int q) {
  const int tid = opaque_tid();
  const float* stb = (const float*)(p.ws + OFF_ST);
  const float* acg = (const float*)(p.ws + OFF_ACUM);
  u16* sin = (u16*)(p.ws + OFF_SIN_ST);
  const int off = q * 2048 + tid * 4;
  float4 S = make_float4(0.f, 0.f, 0.f, 0.f);
  float4 ld[4];
#pragma unroll
  for (int j = 0; j < 4; j++) ld[j] = *(const float4*)(stb + (size_t)((b * 16 + j) * 8 + h) * 8192 + off);
#pragma unroll
  for (int c4 = 0; c4 < 16; c4 += 4) {
    float4 nx[4];
    if (c4 + 4 < 16) {
#pragma unroll
      for (int j = 0; j < 4; j++) nx[j] = *(const float4*)(stb + (size_t)((b * 16 + c4 + 4 + j) * 8 + h) * 8192 + off);
    }
#pragma unroll
    for (int j = 0; j < 4; j++) {
      const int c = c4 + j;
      *(uint2*)(sin + (size_t)((b * 16 + c) * 8 + h) * 8192 + off) = make_uint2(pack2(S.x, S.y), pack2(S.z, S.w));
      const float dec = expf(acg[((b * 16 + c) * 8 + h) * 128 + 127]);
      S.x = fmaf(S.x, dec, ld[j].x); S.y = fmaf(S.y, dec, ld[j].y); S.z = fmaf(S.z, dec, ld[j].z); S.w = fmaf(S.w, dec, ld[j].w);
    }
    if (c4 + 4 < 16) {
#pragma unroll
      for (int j = 0; j < 4; j++) ld[j] = nx[j];
    }
  }
}

DEV void ssdB_item(const Params& p, int b, int c, char* smem) {
  const int tid = opaque_tid(), lane = tid & 63, h = __builtin_amdgcn_readfirstlane(tid >> 6), r = lane & 31, hh = lane >> 5;
  const size_t tb = (size_t)b * 2048;
  const int g = h >> 2;
  float* ssq = (float*)smem;
  const float* acg = (const float*)(p.ws + OFF_ACUM);
  __syncthreads();
  bf16x8 sf[2][8];
  if (c > 0) {
    const u16* sin = (const u16*)(p.ws + OFF_SIN_ST) + (size_t)((b * 16 + c) * 8 + h) * 8192;
#pragma unroll
    for (int pt = 0; pt < 2; pt++)
#pragma unroll
      for (int ks = 0; ks < 8; ks++) sf[pt][ks] = *(const bf16x8*)(sin + (pt * 32 + r) * 128 + ks * 16 + hh * 8);
  }
  const u16* ccg = (const u16*)(p.ws + OFF_CC);
  const u16* zb = (const u16*)(p.ws + OFF_Z);
  const float* ypb = (const float*)(p.ws + OFF_YP);
  u16* cat = (u16*)(p.ws + OFF_HBUF);
#pragma unroll 1
  for (int lt = 0; lt < 4; ++lt) {
    const int lidx = lt * 32 + r;
    const size_t t = tb + c * 128 + lidx;
    f32x16 y0 = zero16(), y1 = zero16();
    if (c > 0) {
#pragma unroll
      for (int ks = 0; ks < 8; ks++) {
        const bf16x8 cf = *(const bf16x8*)(ccg + t * 256 + g * 128 + ks * 16 + hh * 8);
        y0 = mfma32(sf[0][ks], cf, y0); y1 = mfma32(sf[1][ks], cf, y1);
      }
      const float e = expf(acg[((b * 16 + c) * 8 + h) * 128 + lidx]);
#pragma unroll
      for (int reg = 0; reg < 16; reg++) { y0[reg] *= e; y1[reg] *= e; }
    }
    float ss = 0.f;
#pragma unroll
    for (int gq = 0; gq < 4; gq++) {
      const int pb = 8 * gq + 4 * hh;
      const float4 a0 = *(const float4*)(ypb + t * 512 + h * 64 + pb);
      const float4 a1 = *(const float4*)(ypb + t * 512 + h * 64 + 32 + pb);
      const uint2 z0 = *(const uint2*)(zb + t * 512 + h * 64 + pb);
      const uint2 z1 = *(const uint2*)(zb + t * 512 + h * 64 + 32 + pb);
      y0[4 * gq + 0] = (y0[4 * gq + 0] + a0.x) * silu_f(bflo(z0.x)); y0[4 * gq + 1] = (y0[4 * gq + 1] + a0.y) * silu_f(bfhi(z0.x));
      y0[4 * gq + 2] = (y0[4 * gq + 2] + a0.z) * silu_f(bflo(z0.y)); y0[4 * gq + 3] = (y0[4 * gq + 3] + a0.w) * silu_f(bfhi(z0.y));
      y1[4 * gq + 0] = (y1[4 * gq + 0] + a1.x) * silu_f(bflo(z1.x)); y1[4 * gq + 1] = (y1[4 * gq + 1] + a1.y) * silu_f(bfhi(z1.x));
      y1[4 * gq + 2] = (y1[4 * gq + 2] + a1.z) * silu_f(bflo(z1.y)); y1[4 * gq + 3] = (y1[4 * gq + 3] + a1.w) * silu_f(bfhi(z1.y));
#pragma unroll
      for (int j = 0; j < 4; j++) ss += y0[4 * gq + j] * y0[4 * gq + j] + y1[4 * gq + j] * y1[4 * gq + j];
    }
    ss += __shfl_xor(ss, 32);
    if (hh == 0) ssq[(lt * 32 + r) * 8 + h] = ss;
    __syncthreads();
    float tot = 0.f;
#pragma unroll
    for (int k = 0; k < 8; k++) tot += ssq[(lt * 32 + r) * 8 + k];
    const float rstd = rsqrtf(tot * (1.f / 512.f) + 1e-6f);
#pragma unroll
    for (int gq = 0; gq < 4; gq++) {
      const int pb = 8 * gq + 4 * hh;
      const float4 g0 = *(const float4*)(p.ssd_norm_g + h * 64 + pb);
      const float4 g1 = *(const float4*)(p.ssd_norm_g + h * 64 + 32 + pb);
      *(uint2*)(cat + t * 1024 + 512 + h * 64 + pb) = make_uint2(pack2(y0[4 * gq] * rstd * g0.x, y0[4 * gq + 1] * rstd * g0.y), pack2(y0[4 * gq + 2] * rstd * g0.z, y0[4 * gq + 3] * rstd * g0.w));
      *(uint2*)(cat + t * 1024 + 512 + h * 64 + 32 + pb) = make_uint2(pack2(y1[4 * gq] * rstd * g1.x, y1[4 * gq + 1] * rstd * g1.y), pack2(y1[4 * gq + 2] * rstd * g1.z, y1[4 * gq + 3] * rstd * g1.w));
    }
  }
}


DEV void p3_rows1(const Params& p, int m0) {
  const int tid_ = opaque_tid(); const int lane = tid_ & 63, w = __builtin_amdgcn_readfirstlane(tid_ >> 6);
  const u16* mix = (const u16*)(p.ws + OFF_MIX);
  const float* mod = (const float*)(p.ws + OFF_MOD);
  u16* h2 = (u16*)(p.ws + OFF_HBUF);
  const int b = m0 >> 11;
  float4 pg1[4], fgm[4], sh2[4];
#pragma unroll
  for (int k = 0; k < 4; k++) {
    const int col = (k * 64 + lane) * 4;
    const float4 pg = *(const float4*)(p.post_mix_g + col);
    const float4 g1 = ldmod(mod, b * 6144 + 2048 + col);
    pg1[k] = make_float4(pg.x * g1.x, pg.y * g1.y, pg.z * g1.z, pg.w * g1.w);
    const float4 fg = *(const float4*)(p.pre_ffn_g + col);
    const float4 sc = ldmod(mod, b * 6144 + 4096 + col);
    fgm[k] = make_float4(fg.x * (1.f + sc.x), fg.y * (1.f + sc.y), fg.z * (1.f + sc.z), fg.w * (1.f + sc.w));
    sh2[k] = ldmod(mod, b * 6144 + 3072 + col);
  }
#pragma unroll 2
  for (int i = 0; i < 16; i++) {
    const int t = m0 + w * 16 + i;
    float4 mv[4], xv[4]; float ss = 0.f;
#pragma unroll
    for (int k = 0; k < 4; k++) {
      { const uint2 mq = *(const uint2*)(mix + (size_t)t * 1024 + (k * 64 + lane) * 4); mv[k] = make_float4(bflo(mq.x), bfhi(mq.x), bflo(mq.y), bfhi(mq.y)); }
      xv[k] = *(const float4*)(p.x + (size_t)t * 1024 + (k * 64 + lane) * 4);
      ss += mv[k].x * mv[k].x + mv[k].y * mv[k].y + mv[k].z * mv[k].z + mv[k].w * mv[k].w;
    }
    ss = wave_sum(ss);
    const float rstd = rsqrtf(ss * (1.f / 1024.f) + 1e-6f);
    float s2 = 0.f;
#pragma unroll
    for (int k = 0; k < 4; k++) {
      const int col = (k * 64 + lane) * 4;
      xv[k].x += (mv[k].x * rstd) * pg1[k].x; xv[k].y += (mv[k].y * rstd) * pg1[k].y;
      xv[k].z += (mv[k].z * rstd) * pg1[k].z; xv[k].w += (mv[k].w * rstd) * pg1[k].w;
      s2 += xv[k].x * xv[k].x + xv[k].y * xv[k].y + xv[k].z * xv[k].z + xv[k].w * xv[k].w;
      *(uint2*)((u16*)(p.ws + OFF_X1) + (size_t)t * 1024 + col) = make_uint2(pack2(xv[k].x, xv[k].y), pack2(xv[k].z, xv[k].w));
    }
    s2 = wave_sum(s2);
    const float rstd2 = rsqrtf(s2 * (1.f / 1024.f) + 1e-6f);
#pragma unroll
    for (int k = 0; k < 4; k++) {
      const int col = (k * 64 + lane) * 4;
      const float y0 = (xv[k].x * rstd2) * fgm[k].x + sh2[k].x;
      const float y1 = (xv[k].y * rstd2) * fgm[k].y + sh2[k].y;
      const float y2 = (xv[k].z * rstd2) * fgm[k].z + sh2[k].z;
      const float y3 = (xv[k].w * rstd2) * fgm[k].w + sh2[k].w;
      *(uint2*)(h2 + (size_t)t * 1024 + col) = make_uint2(pack2(y0, y1), pack2(y2, y3));
      xv[k] = make_float4(y0, y1, y2, y3);
    }
    {
      float mx = 0.f;
#pragma unroll
      for (int k = 0; k < 4; k++) mx = fmaxf(mx, fmaxf(fmaxf(fabsf(xv[k].x), fabsf(xv[k].y)), fmaxf(fabsf(xv[k].z), fabsf(xv[k].w))));
#pragma unroll
      for (int o = 32; o > 0; o >>= 1) mx = fmaxf(mx, __shfl_xor(mx, o));
      const float inv = (mx > 0.f) ? 127.f / mx : 0.f;
      unsigned wd[4];
#pragma unroll
      for (int k = 0; k < 4; k++) wd[k] = pack_i8x4(xv[k].x * inv, xv[k].y * inv, xv[k].z * inv, xv[k].w * inv);
      *(uint4*)(p.ws + OFF_H2Q + (size_t)t * 1024 + lane * 16) = make_uint4(wd[0], wd[1], wd[2], wd[3]);
      if (lane == 0) ((float*)(p.ws + OFF_SH))[t] = mx * (1.f / 127.f);
    }
  }
}

#define INS16(L, x) { _Pragma("unroll") for (int j_ = 0; j_ < 16; j_++) { const unsigned hi_ = max(L[j_], x); x = min(L[j_], x); L[j_] = hi_; } }
#define CEX(L, a_, b_) { const unsigned hi_ = max(L[a_], L[b_]); const unsigned lo_ = min(L[a_], L[b_]); L[a_] = hi_; L[b_] = lo_; }
DEV float unordkey(unsigned u) { const unsigned b = (u & 0x80000000u) ? (u ^ 0x80000000u) : ~u; return __uint_as_float(b); }

#define SORT16(L) { \
  _Pragma("unroll") for (int k_ = 2; k_ <= 16; k_ <<= 1) { \
    _Pragma("unroll") for (int j_ = k_ >> 1; j_ > 0; j_ >>= 1) { \
      _Pragma("unroll") for (int i_ = 0; i_ < 16; i_++) { \
        const int l_ = i_ ^ j_; \
        if (l_ > i_) { \
          const unsigned a_ = L[i_], b_ = L[l_]; \
          const bool desc_ = ((i_ & k_) == 0); \
          L[i_] = desc_ ? max(a_, b_) : min(a_, b_); L[l_] = desc_ ? min(a_, b_) : max(a_, b_); \
        } } } } }
#define MERGE16(A, B) { \
  _Pragma("unroll") for (int j_ = 0; j_ < 16; j_++) A[j_] = max(A[j_], B[15 - j_]); \
  _Pragma("unroll") for (int j_ = 0; j_ < 8; j_++) CEX(A, j_, j_ + 8); \
  _Pragma("unroll") for (int j_ = 0; j_ < 16; j_++) if ((j_ & 4) == 0) CEX(A, j_, j_ + 4); \
  _Pragma("unroll") for (int j_ = 0; j_ < 16; j_++) if ((j_ & 2) == 0) CEX(A, j_, j_ + 2); \
  _Pragma("unroll") for (int j_ = 0; j_ < 16; j_ += 2) CEX(A, j_, j_ + 1); }

constexpr int RT_LROW = 36;

DEV void p3_route(const Params& p, int m0, char* smem) {
  const int tid = opaque_tid(), lane = tid & 63, w = __builtin_amdgcn_readfirstlane(tid >> 6), r = lane & 31, hh = lane >> 5;
  const u16* qp = (const u16*)(p.ws + OFF_QP);
  const u16* sk = (const u16*)(p.ws + OFF_SK);
  unsigned* lists = (unsigned*)smem;
  int* eidx = (int*)(p.ws + OFF_EIDX);
  float* gate = (float*)(p.ws + OFF_GATE);
  __syncthreads();
  {
    const int h = w;
#pragma unroll 1
    for (int i = 0; i < 2; i++) {
      bf16x8 af[4][4];
#pragma unroll
      for (int kt4 = 0; kt4 < 4; kt4++)
#pragma unroll
        for (int ks = 0; ks < 4; ks++) af[kt4][ks] = *(const bf16x8*)(sk + ((size_t)(h * 2 + i) * 128 + kt4 * 32 + r) * 64 + ks * 16 + hh * 8);
#pragma unroll 1
      for (int tt = 0; tt < 4; tt++) {
        bf16x8 bq[4];
#pragma unroll
        for (int ks = 0; ks < 4; ks++) bq[ks] = *(const bf16x8*)(qp + (size_t)(m0 + tt * 32 + r) * 1024 + h * 128 + i * 64 + ks * 16 + hh * 8);
        unsigned L0[16], L1[16], L2[16], L3[16];
#define RT_TILE(LL, kt4) { f32x16 acc = zero16(); \
          _Pragma("unroll") for (int ks = 0; ks < 4; ks++) acc = mfma32(af[kt4][ks], bq[ks], acc); \
          const unsigned kb = (unsigned)(127 - (kt4) * 32 - 4 * hh); \
          _Pragma("unroll") for (int reg = 0; reg < 16; reg++) LL[reg] = (ordkey(acc[reg]) & 0xFFFFFF80u) | (kb - (unsigned)((reg & 3) + 8 * (reg >> 2))); \
          SORT16(LL); }
        RT_TILE(L0, 0); RT_TILE(L1, 1);
        MERGE16(L0, L1);
        RT_TILE(L2, 2); RT_TILE(L3, 3);
        MERGE16(L2, L3);
        MERGE16(L0, L2);
#undef RT_TILE
        unsigned C[16];
#pragma unroll
        for (int j = 0; j < 16; j++) C[j] = (unsigned)__shfl_xor((int)L0[j], 32);
        MERGE16(L0, C);
#pragma unroll
        for (int j = 0; j < 16; j++) C[j] = L0[j];
        if (hh == 0) {
          uint4* dst = (uint4*)(lists + ((size_t)(h * 128 + tt * 32 + r)) * RT_LROW + i * 16);
          dst[0] = make_uint4(C[0], C[1], C[2], C[3]); dst[1] = make_uint4(C[4], C[5], C[6], C[7]);
          dst[2] = make_uint4(C[8], C[9], C[10], C[11]); dst[3] = make_uint4(C[12], C[13], C[14], C[15]);
        }
      }
    }
  }
  __syncthreads();
#pragma unroll 1
  for (int k = 0; k < 2; k++) {
    const int task = tid + k * 512;
    const int h = task >> 7, t = task & 127;
    const uint4* src = (const uint4*)(lists + (size_t)(h * 128 + t) * RT_LROW);
    unsigned K0[16], K1[16];
#pragma unroll
    for (int q = 0; q < 4; q++) {
      const uint4 a = src[q], bb = src[4 + q];
      K0[4 * q] = a.x; K0[4 * q + 1] = a.y; K0[4 * q + 2] = a.z; K0[4 * q + 3] = a.w;
      K1[4 * q] = bb.x; K1[4 * q + 1] = bb.y; K1[4 * q + 2] = bb.z; K1[4 * q + 3] = bb.w;
    }
    float s0[16], s1[16];
#pragma unroll
    for (int j = 0; j < 16; j++) { s0[j] = unordkey(K0[j] & 0xFFFFFF80u); s1[j] = unordkey(K1[j] & 0xFFFFFF80u); }
    unsigned L[16];
#pragma unroll
    for (int j = 0; j < 16; j++) L[j] = 0u;
#pragma unroll
    for (int a = 0; a < 16; a++) {
#pragma unroll
      for (int bb = 0; bb < 16; bb++) {
        if ((a + 1) * (bb + 1) <= 16) {
          unsigned x = (ordkey(s0[a] + s1[bb]) & 0xFFFFFF00u) | (unsigned)(255 - (a * 16 + bb));
          INS16(L, x);
        }
      }
    }
    float fv[16]; int ei[16]; float mx = NEG_INF;
#pragma unroll
    for (int j = 0; j < 16; j++) {
      const int code = 255 - (int)(L[j] & 255u); const int a = code >> 4, bb = code & 15;
      const unsigned ka = ((const unsigned*)src)[a], kb2 = ((const unsigned*)src)[16 + bb];
      const float va = unordkey(ka & 0xFFFFFF80u), vb = unordkey(kb2 & 0xFFFFFF80u);
      fv[j] = va + vb;
      ei[j] = (127 - (int)(ka & 127u)) * 128 + (127 - (int)(kb2 & 127u));
      mx = fmaxf(mx, fv[j]);
    }
    float sum = 0.f;
#pragma unroll
    for (int j = 0; j < 16; j++) { fv[j] = __expf(fv[j] - mx); sum += fv[j]; }
    const float inv = 1.f / sum;
    int* ep = eidx + (size_t)(m0 + t) * 128 + h * 16;
    float* gp = gate + (size_t)(m0 + t) * 128 + h * 16;
#pragma unroll
    for (int q = 0; q < 4; q++) {
      *(int4*)(ep + 4 * q) = make_int4(ei[4 * q], ei[4 * q + 1], ei[4 * q + 2], ei[4 * q + 3]);
      *(float4*)(gp + 4 * q) = make_float4(fv[4 * q] * inv, fv[4 * q + 1] * inv, fv[4 * q + 2] * inv, fv[4 * q + 3] * inv);
    }
  }
}

typedef __attribute__((ext_vector_type(2))) float f32x2;
DEV void dec16(const uint4& q, float* f) {
  f32x2 t;
  t = __builtin_amdgcn_cvt_pk_f32_fp8((int)q.x, false); f[0] = t[0]; f[1] = t[1];
  t = __builtin_amdgcn_cvt_pk_f32_fp8((int)q.x, true);  f[2] = t[0]; f[3] = t[1];
  t = __builtin_amdgcn_cvt_pk_f32_fp8((int)q.y, false); f[4] = t[0]; f[5] = t[1];
  t = __builtin_amdgcn_cvt_pk_f32_fp8((int)q.y, true);  f[6] = t[0]; f[7] = t[1];
  t = __builtin_amdgcn_cvt_pk_f32_fp8((int)q.z, false); f[8] = t[0]; f[9] = t[1];
  t = __builtin_amdgcn_cvt_pk_f32_fp8((int)q.z, true);  f[10] = t[0]; f[11] = t[1];
  t = __builtin_amdgcn_cvt_pk_f32_fp8((int)q.w, false); f[12] = t[0]; f[13] = t[1];
  t = __builtin_amdgcn_cvt_pk_f32_fp8((int)q.w, true);  f[14] = t[0]; f[15] = t[1];
}

constexpr int PX_ROW = 132;
constexpr int PX_Z = 0;
constexpr int PX_E = 8 * 16 * PX_ROW * 4;
constexpr int PX_SS = 2 * PX_E;
constexpr int PX_CL = PX_SS + 512;

DEV void p3_ustage(const Params& p, int m0, char* smem) {
  const int tid_ = opaque_tid(); const int lane = tid_ & 63, w = __builtin_amdgcn_readfirstlane(tid_ >> 6);
  const int sl = lane >> 3, ch = lane & 7;
  const unsigned char* h2q = p.ws + OFF_H2Q;
  const unsigned char* U = p.ws + OFF_U;
  const int* eidx = (const int*)(p.ws + OFF_EIDX);
  float* zb = (float*)(smem + PX_Z) + w * 16 * PX_ROW;
  int* eb = (int*)(smem + PX_E) + w * 16 * PX_ROW;
  int* cl = (int*)(smem + PX_CL) + w * 128;
#pragma unroll 1
  for (int i = 0; i < 16; i++) {
    const int t = m0 + w * 16 + i;
    eb[i * PX_ROW + lane] = eidx[(size_t)t * 128 + lane]; eb[i * PX_ROW + 64 + lane] = eidx[(size_t)t * 128 + 64 + lane];
  }
  if (lane < 16) ((float*)(smem + PX_SS))[w * 16 + lane] = 0.f;
#define U_LOAD8(Q, E) { const unsigned char* up_ = U + (size_t)(E) * 1024 + ch * 16; _Pragma("unroll") for (int k_ = 0; k_ < 8; k_++) Q[k_] = *(const uint4*)(up_ + k_ * 128); }
#pragma unroll 1
  for (int rep = 0; rep < PROBE_U; rep++)
#pragma unroll 1
  for (int x = 0; x < 8; x++) {
    float* zbase = zb;
    uint4 hqn[8];
#pragma unroll
    for (int k = 0; k < 8; k++) hqn[k] = *(const uint4*)(h2q + (size_t)(m0 + w * 16) * 1024 + k * 128 + ch * 16);
#pragma unroll 1
    for (int i = 0; i < 16; i++) {
      uint4 hq[8];
#pragma unroll
      for (int k = 0; k < 8; k++) hq[k] = hqn[k];
      const int ev0 = eb[i * PX_ROW + lane], ev1 = eb[i * PX_ROW + 64 + lane];
      const bool f0 = (ev0 >> 11) == x, f1 = (ev1 >> 11) == x;
      const unsigned long long mk0 = __ballot(f0), mk1 = __ballot(f1);
      const int n0 = __builtin_popcountll(mk0), n = n0 + __builtin_popcountll(mk1);
      const int r0 = __builtin_amdgcn_mbcnt_hi((unsigned)(mk0 >> 32), __builtin_amdgcn_mbcnt_lo((unsigned)mk0, 0));
      const int r1 = n0 + __builtin_amdgcn_mbcnt_hi((unsigned)(mk1 >> 32), __builtin_amdgcn_mbcnt_lo((unsigned)mk1, 0));
      if (f0) cl[r0] = ev0 | (lane << 16);
      if (f1) cl[r1] = ev1 | ((64 + lane) << 16);
      float* zrow = zbase + i * PX_ROW;
      uint4 qA[8]; int ceA = 0;
      if (n > 0) { ceA = cl[(sl < n) ? sl : 0]; U_LOAD8(qA, ceA & 0xFFFF); }
      {
        const unsigned char* hp = h2q + (size_t)(m0 + w * 16 + ((i < 15) ? i + 1 : i)) * 1024 + ch * 16;
#pragma unroll
        for (int k = 0; k < 8; k++) hqn[k] = *(const uint4*)(hp + k * 128);
      }
#pragma unroll 1
      for (int bb = 0; bb < n; bb += 8) {
        uint4 qB[8]; int ceB = 0;
        const bool more = (bb + 8 < n);
        if (more) { const int ix = bb + 8 + sl; ceB = cl[(ix < n) ? ix : bb + 8]; U_LOAD8(qB, ceB & 0xFFFF); }
        int d = 0;
#pragma unroll
        for (int k = 0; k < 8; k++) {
          d = __builtin_amdgcn_sdot4((int)qA[k].x, (int)hq[k].x, d, false);
          d = __builtin_amdgcn_sdot4((int)qA[k].y, (int)hq[k].y, d, false);
          d = __builtin_amdgcn_sdot4((int)qA[k].z, (int)hq[k].z, d, false);
          d = __builtin_amdgcn_sdot4((int)qA[k].w, (int)hq[k].w, d, false);
        }
        d += __builtin_amdgcn_update_dpp(0, d, 0xB1, 0xF, 0xF, false);
        d += __builtin_amdgcn_update_dpp(0, d, 0x4E, 0xF, 0xF, false);
        d += __builtin_amdgcn_update_dpp(0, d, 0x141, 0xF, 0xF, false);
        if (ch == 0 && bb + sl < n) zrow[ceA >> 16] = (float)d;
        if (more) {
#pragma unroll
          for (int k = 0; k < 8; k++) qA[k] = qB[k];
          ceA = ceB;
        }
      }
    }
  }
#undef U_LOAD8
  {
    const float* su = (const float*)(p.ws + OFF_SU);
    const float* sv = (const float*)(p.ws + OFF_SV);
    const float* shs = (const float*)(p.ws + OFF_SH);
    const float* gate = (const float*)(p.ws + OFF_GATE);
#pragma unroll 1
    for (int i = 0; i < 16; i++) {
      const int t = m0 + w * 16 + i;
      const float st = shs[t];
#pragma unroll
      for (int half = 0; half < 2; half++) {
        const int e = eb[i * PX_ROW + half * 64 + lane];
        const float z = zb[i * PX_ROW + half * 64 + lane] * (su[e] * st);
        zb[i * PX_ROW + half * 64 + lane] = 0.5f * z * (1.f + erff(z * 0.70710678118654752f)) * gate[(size_t)t * 128 + half * 64 + lane] * sv[e];
      }
    }
  }
}

DEV void p3_vstage(const Params& p, int m0, char* smem) {
  const int tid_ = opaque_tid(); const int lane = tid_ & 63, w = __builtin_amdgcn_readfirstlane(tid_ >> 6);
  const unsigned char* V = p.ws + OFF_V;
  const float* ab = (const float*)(smem + PX_Z) + w * 16 * PX_ROW;
  const int* eb = (const int*)(smem + PX_E) + w * 16 * PX_ROW;
  float* ssq = (float*)(smem + PX_SS) + w * 16;
  u16* F = (u16*)(p.ws + OFF_MIX + (size_t)T_ * 1024 * 2);
  const int ts = lane >> 3, ch = lane & 7;
#define V_LOAD4(Q, E4) { Q[0] = *(const uint4*)(vb + (size_t)(E4).x * 1024); Q[1] = *(const uint4*)(vb + (size_t)(E4).y * 1024); \
    Q[2] = *(const uint4*)(vb + (size_t)(E4).z * 1024); Q[3] = *(const uint4*)(vb + (size_t)(E4).w * 1024); }
#pragma unroll 1
  for (int rep = 0; rep < PROBE_V; rep++)
#pragma unroll 1
  for (int x = 0; x < 8; x++) {
    const unsigned char* vb = V + x * 128 + ch * 16;
#pragma unroll 1
    for (int grp = 0; grp < 2; grp++) {
      const int i = grp * 8 + ts;
      const int t = m0 + w * 16 + i;
      const int4* ep = (const int4*)(eb + i * PX_ROW);
      const float4* ap = (const float4*)(ab + i * PX_ROW);
      f32x2 acc[8];
#pragma unroll
      for (int k = 0; k < 8; k++) acc[k] = (f32x2){0.f, 0.f};
      uint4 qA[4], qB[4];
      int4 e4 = ep[0];
      V_LOAD4(qA, e4);
      e4 = ep[1];
      V_LOAD4(qB, e4);
#pragma unroll 1
      for (int pb = 0; pb < 32; pb += 2) {
#pragma unroll
        for (int half = 0; half < 2; half++) {
          const float4 a4 = ap[pb + half];
          const float av[4] = {a4.x, a4.y, a4.z, a4.w};
#pragma unroll
          for (int u = 0; u < 4; u++) {
            const uint4 qq = half ? qB[u] : qA[u];
            const f32x2 a2 = {av[u], av[u]};
            const unsigned wds[4] = {qq.x, qq.y, qq.z, qq.w};
#pragma unroll
            for (int k2 = 0; k2 < 4; k2++) {
              acc[2 * k2] = __builtin_elementwise_fma(a2, __builtin_amdgcn_cvt_pk_f32_fp8((int)wds[k2], false), acc[2 * k2]);
              acc[2 * k2 + 1] = __builtin_elementwise_fma(a2, __builtin_amdgcn_cvt_pk_f32_fp8((int)wds[k2], true), acc[2 * k2 + 1]);
            }
          }
          const int nx = pb + 2 + half;
          if (nx < 32) { const int4 en = ep[nx]; if (half) { V_LOAD4(qB, en); } else { V_LOAD4(qA, en); } }
        }
      }
      float ss = 0.f;
#pragma unroll
      for (int k = 0; k < 8; k++) ss = fmaf(acc[k][0], acc[k][0], fmaf(acc[k][1], acc[k][1], ss));
      ss += __int_as_float(__builtin_amdgcn_update_dpp(0, __float_as_int(ss), 0xB1, 0xF, 0xF, false));
      ss += __int_as_float(__builtin_amdgcn_update_dpp(0, __float_as_int(ss), 0x4E, 0xF, 0xF, false));
      ss += __int_as_float(__builtin_amdgcn_update_dpp(0, __float_as_int(ss), 0x141, 0xF, 0xF, false));
      if (rep < PROBE_V) {
        u16* fp = F + (size_t)t * 1024 + x * 128 + ch * 16;
        *(uint4*)(fp) = make_uint4(pack2(acc[0][0], acc[0][1]), pack2(acc[1][0], acc[1][1]), pack2(acc[2][0], acc[2][1]), pack2(acc[3][0], acc[3][1]));
        *(uint4*)(fp + 8) = make_uint4(pack2(acc[4][0], acc[4][1]), pack2(acc[5][0], acc[5][1]), pack2(acc[6][0], acc[6][1]), pack2(acc[7][0], acc[7][1]));
        if (ch == 0 && rep == 0) ssq[i] += ss;
      }
    }
  }
#undef V_LOAD4
  {
    const float* mod = (const float*)(p.ws + OFF_MOD);
    const int b = m0 >> 11;
    float4 fg2[4];
#pragma unroll
    for (int j = 0; j < 4; j++) {
      const int col = j * 256 + lane * 4;
      const float4 fg = *(const float4*)(p.post_ffn_g + col);
      const float4 g2 = ldmod(mod, b * 6144 + 5120 + col);
      fg2[j] = make_float4(fg.x * g2.x, fg.y * g2.y, fg.z * g2.z, fg.w * g2.w);
    }
#pragma unroll 2
    for (int i = 0; i < 16; i++) {
      const int t = m0 + w * 16 + i;
      const float rstd = rsqrtf(ssq[i] * (1.f / 1024.f) + 1e-6f);
#pragma unroll
      for (int j = 0; j < 4; j++) {
        const uint2 fq = *(const uint2*)(F + (size_t)t * 1024 + lane * 16 + j * 4);
        const float4 f = make_float4(bflo(fq.x), bfhi(fq.x), bflo(fq.y), bfhi(fq.y));
        const int col = j * 256 + lane * 4;
        const uint2 xq = *(const uint2*)((const u16*)(p.ws + OFF_X1) + (size_t)t * 1024 + col);
        const float4 x1 = make_float4(bflo(xq.x), bfhi(xq.x), bflo(xq.y), bfhi(xq.y));
        float4 o;
        o.x = x1.x + (f.x * rstd) * fg2[j].x; o.y = x1.y + (f.y * rstd) * fg2[j].y;
        o.z = x1.z + (f.z * rstd) * fg2[j].z; o.w = x1.w + (f.w * rstd) * fg2[j].w;
        *(float4*)(p.out + (size_t)t * 1024 + col) = o;
      }
    }
  }
}

DEV void phase3_tile(const Params& p, int mt, char* smem) {
  const int m0 = mt * 128;
  const u16* cat = (const u16*)(p.ws + OFF_HBUF) + (size_t)m0 * 1024;
  {
    const u16* wt = (const u16*)(p.ws + OFF_WTOUT);
    for (int rep = 0; rep < PROBE_G3; rep++)
    for (int nc = 0; nc < 4; nc++) {
      EpiStoreBf16 epi{(u16*)(p.ws + OFF_MIX) + (size_t)m0 * 1024, nc * 256};
      gemm_tile(cat, 1024, wt + (size_t)nc * 256 * 1024, 1024, 1024, smem, epi);
    }
  }
  __syncthreads();
  p3_rows1(p, m0);
#if STAGE >= 6
  __syncthreads();
  {
    const u16* wt = (const u16*)(p.ws + OFF_WTQ);
    for (int rep = 0; rep < PROBE_G3; rep++)
    for (int nc = 0; nc < 4; nc++) {
      EpiStoreBf16 epi{(u16*)(p.ws + OFF_QP) + (size_t)m0 * 1024, nc * 256};
      gemm_tile(cat, 1024, wt + (size_t)nc * 256 * 1024, 1024, 1024, smem, epi);
    }
  }
  __syncthreads();
  for (int rep = 0; rep < PROBE_ROUTE; rep++) p3_route(p, m0, smem);
  __syncthreads();
#endif
}

DEV void grid_barrier(unsigned* counter, unsigned& target) {
  asm volatile("s_waitcnt vmcnt(0)" ::: "memory");
  __syncthreads();
  if (threadIdx.x == 0) {
    __builtin_amdgcn_fence(__ATOMIC_RELEASE, "agent");
    asm volatile("s_waitcnt vmcnt(0)" ::: "memory");
    target += gridDim.x;
    __hip_atomic_fetch_add(counter, 1u, __ATOMIC_RELAXED, __HIP_MEMORY_SCOPE_AGENT);
    while (__hip_atomic_load(counter, __ATOMIC_RELAXED, __HIP_MEMORY_SCOPE_AGENT) < target) __builtin_amdgcn_s_sleep(1);
    __builtin_amdgcn_fence(__ATOMIC_ACQUIRE, "agent");
    asm volatile("s_waitcnt vmcnt(0)" ::: "memory");
  }
  __syncthreads();
}

#define XB_TMO      128
#define XB_XCNT(j)  (256  + 64 * (j))
#define XB_XSUB(j)  (1280 + 64 * (j))
#define XB_XGEN(j)  (2304 + 64 * (j))
#define XB_TOP      3328
#define XB_TOPGEN   3392
#define XB_SPIN_CAP (1u << 22)
DEV unsigned xb_ld(unsigned* p) { return __hip_atomic_load(p, __ATOMIC_RELAXED, __HIP_MEMORY_SCOPE_AGENT); }
DEV unsigned xb_add(unsigned* p, unsigned v) { return __hip_atomic_fetch_add(p, v, __ATOMIC_RELAXED, __HIP_MEMORY_SCOPE_AGENT); }
DEV unsigned xb_xcc_id() { return (unsigned)__builtin_amdgcn_s_getreg((3 << 11) | 20) & 0xFu; }
#define XB_SPIN(cond, bar) do { unsigned _sp = 0; while (cond) { __builtin_amdgcn_s_sleep(1); \
    if ((++_sp & 255u) == 0u) { if (xb_ld(&(bar)[XB_TMO])) break; if (_sp > XB_SPIN_CAP) { atomicAdd(&(bar)[XB_TMO], 1u); break; } } } } while (0)
struct XcdBarrier { unsigned* bar; unsigned x; unsigned* st; };
DEV void xcd_barrier_complete(unsigned* bar, unsigned x, unsigned& nloc, unsigned& nx) {
  const unsigned G = gridDim.x;
  unsigned sum, cnt, mine, sp = 0u;
  for (;;) {
    sum = 0u; cnt = 0u; mine = 0u;
#pragma unroll
    for (unsigned j = 0; j < 16; ++j) { const unsigned c = xb_ld(&bar[XB_XCNT(j)]); sum += c; cnt += (c > 0u) ? 1u : 0u; mine = (j == x) ? c : mine; }
    if (sum == G) break;
    __builtin_amdgcn_s_sleep(1);
    if ((++sp & 255u) == 0u) { if (xb_ld(&bar[XB_TMO])) break; if (sp > XB_SPIN_CAP) { atomicAdd(&bar[XB_TMO], 1u); break; } }
  }
  nloc = mine > 0u ? mine : 1u; nx = cnt > 0u ? cnt : 1u;
}
DEV void xcd_barrier(const XcdBarrier& b) {
  asm volatile("s_waitcnt vmcnt(0)" ::: "memory");
  __syncthreads();
  if (threadIdx.x == 0) {
    unsigned* bar = b.bar;
    __builtin_amdgcn_s_waitcnt(0);
    unsigned nloc = b.st[0], nx = b.st[1];
    if (nloc == 0u) { xcd_barrier_complete(bar, b.x, nloc, nx); b.st[0] = nloc; b.st[1] = nx; }
    const unsigned old = xb_add(&bar[XB_XSUB(b.x)], 1u);
    const unsigned gen = old / nloc;
    if (old + 1u == (gen + 1u) * nloc) {
      __builtin_amdgcn_fence(__ATOMIC_RELEASE, "agent");
      asm volatile("s_waitcnt vmcnt(0)" ::: "memory");
      const unsigned og = xb_add(&bar[XB_TOP], 1u);
      const unsigned tg = og / nx;
      if (og + 1u == (tg + 1u) * nx) xb_add(&bar[XB_TOPGEN], 1u);
      else XB_SPIN(xb_ld(&bar[XB_TOPGEN]) == tg, bar);
      __builtin_amdgcn_fence(__ATOMIC_ACQUIRE, "agent");
      xb_add(&bar[XB_XGEN(b.x)], 1u);
      asm volatile("s_waitcnt vmcnt(0)" ::: "memory");
    } else {
      XB_SPIN(xb_ld(&bar[XB_XGEN(b.x)]) == gen, bar);
      __builtin_amdgcn_fence(__ATOMIC_ACQUIRE, "agent");
      asm volatile("s_waitcnt vmcnt(0)" ::: "memory");
    }
  }
  __syncthreads();
}

__global__ void __launch_bounds__(NT) mega(Params p) {
  __shared__ __attribute__((aligned(16))) char smem[LDS_BYTES + 16];
  cg::grid_group grid = cg::this_grid();
  XcdBarrier xb; xb.bar = (unsigned*)(p.ws + OFF_XB); xb.x = xb_xcc_id(); xb.st = (unsigned*)(smem + LDS_BYTES);
  if (threadIdx.x == 0) { xb.st[0] = 0u; xb.st[1] = 0u; (void)xb_add(&xb.bar[XB_XCNT(xb.x)], 1u); }
  __syncthreads();
#if STAGE == 0
  {
    const size_t n4 = (size_t)T_ * 1024 / 4;
    for (size_t i = (size_t)blockIdx.x * NT + threadIdx.x; i < n4; i += (size_t)gridDim.x * NT) ((float4*)p.out)[i] = ((const float4*)p.x)[i];
  }
#endif
  phase_mod(p, smem);
  if (gridDim.x == 0x7fffffffu) grid.sync();
  xcd_barrier(xb);
#if PH(1)
  for (int rep = 0; rep < PROBE_HN; rep++) phase_hnorm(p);
#endif
#if PH(0)
  for (int rep = 0; rep < PROBE_P0; rep++) phase0(p, smem);
#endif
  xcd_barrier(xb);
#if STAGE >= 1 && PH(2)
  for (int rep = 0; rep < PROBE_P1; rep++) phase1(p, smem);
#endif
  xcd_barrier(xb);
#if STAGE >= 2 && PH(3)
  for (int rep = 0; rep < PROBE_SSDA; rep++)
  for (int it = blockIdx.x; it < 512; it += gridDim.x) { ssdA_item(p, it >> 5, (it >> 1) & 15, it & 1, smem); }
#endif
#if STAGE >= 4 && PH(4)
  for (int rep = 0; rep < PROBE_DSA; rep++)
  for (int k = 0; k < 4; k++) {
    const int i = blockIdx.x + k * gridDim.x;
    if (gridDim.x == 256) {
      const int rr = i & 255; const int b = rr & 15, a = rr >> 4;
      const int qt = (k == 0) ? a : (k == 1) ? 31 - a : (k == 2) ? 32 + a : 63 - a;
      dsa_item(p, b, qt, smem);
    }
  }
  if (gridDim.x != 256) { for (int i = blockIdx.x; i < 1024; i += gridDim.x) dsa_item(p, i & 15, 63 - (i >> 4), smem); }
#if STAGE >= 2
  xcd_barrier(xb);
#endif
  for (int it = blockIdx.x; it < 512; it += gridDim.x) ssdS_item(p, it >> 5, (it >> 2) & 7, it & 3);
#elif STAGE >= 2 && STAGE < 4
  {
    u16* cat = (u16*)(p.ws + OFF_HBUF);
    for (size_t i = (size_t)blockIdx.x * NT + threadIdx.x; i < (size_t)T_ * 64; i += (size_t)gridDim.x * NT) {
      const size_t t = i >> 6, cc = i & 63;
      *(uint4*)(cat + t * 1024 + cc * 8) = make_uint4(0, 0, 0, 0);
    }
  }
#endif
  xcd_barrier(xb);
#if STAGE >= 2 && PH(5)
  for (int rep = 0; rep < PROBE_SSDB; rep++)
  for (int it = blockIdx.x; it < 256; it += gridDim.x) ssdB_item(p, it >> 4, it & 15, smem);
#endif
  xcd_barrier(xb);
#if STAGE >= 3 && PH(6)
  if (gridDim.x == 256) {
    if (blockIdx.x & 1) convert_fp8_rows(p.peer_v, p.ws + OFF_V, (float*)(p.ws + OFF_SV));
    phase3_tile(p, blockIdx.x, smem);
    if (!(blockIdx.x & 1)) convert_fp8_rows(p.peer_v, p.ws + OFF_V, (float*)(p.ws + OFF_SV));
    xcd_barrier(xb);
    p3_ustage(p, blockIdx.x * 128, smem);
    xcd_barrier(xb);
    p3_vstage(p, blockIdx.x * 128, smem);
  } else {
    convert_fp8_rows(p.peer_v, p.ws + OFF_V, (float*)(p.ws + OFF_SV));
    xcd_barrier(xb);
    for (int mt = blockIdx.x; mt < 256; mt += gridDim.x) { phase3_tile(p, mt, smem); p3_ustage(p, mt * 128, smem); p3_vstage(p, mt * 128, smem); __syncthreads(); }
  }
#endif
}

extern "C" void kernel_launch(void* const* d_in, const int* in_sizes, int n_in, void* d_out, int out_size, void* d_ws, size_t ws_size, hipStream_t stream) {
  static int grid_blocks = 0;
  if (!grid_blocks) {
    int dev = 0, cus = 0, per_cu = 0;
    hipGetDevice(&dev);
    hipDeviceGetAttribute(&cus, hipDeviceAttributeMultiprocessorCount, dev);
    hipOccupancyMaxActiveBlocksPerMultiprocessor(&per_cu, mega, NT, 0);
    if (per_cu < 1) { fprintf(stderr, "occupancy query says %d blocks/CU\n", per_cu); per_cu = 1; }
    grid_blocks = cus;
    if (ws_size < WS_END) fprintf(stderr, "workspace too small: %zu < %zu\n", ws_size, (size_t)WS_END);
  }
  Params p{};
  p.x = (const float*)d_in[0]; p.c = (const float*)d_in[1]; p.pos = (const int*)d_in[2]; p.w_ada = (const float*)d_in[3]; p.b_ada = (const float*)d_in[4];
  p.pre_mix_g = (const float*)d_in[5]; p.post_mix_g = (const float*)d_in[6]; p.w_in = (const float*)d_in[7]; p.conv_w = (const float*)d_in[8]; p.conv_b = (const float*)d_in[9];
  p.dt_bias = (const float*)d_in[10]; p.a_log = (const float*)d_in[11]; p.d_skip = (const float*)d_in[12]; p.ssd_norm_g = (const float*)d_in[13]; p.w_out = (const float*)d_in[14];
  p.pre_ffn_g = (const float*)d_in[15]; p.post_ffn_g = (const float*)d_in[16]; p.w_q = (const float*)d_in[17]; p.sub_keys = (const float*)d_in[18]; p.peer_u = (const float*)d_in[19];
  p.peer_v = (const float*)d_in[20]; p.out = (float*)d_out; p.ws = (unsigned char*)d_ws;
  if (hipMemsetAsync((unsigned char*)d_ws + OFF_XB, 0, 16384, stream) != hipSuccess) fprintf(stderr, "memset of the barrier words failed\n");
  void* args[] = {&p};
  hipError_t e = hipLaunchCooperativeKernel((void*)mega, dim3(grid_blocks), dim3(NT), args, 0, stream);
  if (e != hipSuccess) fprintf(stderr, "cooperative launch failed: %s (grid %d)\n", hipGetErrorString(e), grid_blocks);
}
```

```cpp
#include <hip/hip_runtime.h>
#include <hip/hip_cooperative_groups.h>
#include <stdint.h>
#include <stdio.h>
namespace cg = cooperative_groups;

#ifndef STAGE
#define STAGE 99
#endif
#ifndef ONLY
#define ONLY -1
#endif
#define PH(n) (ONLY < 0 || ONLY == (n))
#ifndef PROBE_P0
#define PROBE_P0 1
#endif
#ifndef PROBE_HN
#define PROBE_HN 1
#endif
#ifndef PROBE_P1
#define PROBE_P1 1
#endif
#ifndef PROBE_SSDA
#define PROBE_SSDA 1
#endif
#ifndef PROBE_DSA
#define PROBE_DSA 1
#endif
#ifndef PROBE_SSDB
#define PROBE_SSDB 1
#endif
#ifndef PROBE_UHOT
#define PROBE_UHOT 0
#endif
#ifndef PROBE_VHOT
#define PROBE_VHOT 0
#endif
#ifndef PROBE_DSA_SC
#define PROBE_DSA_SC 1
#endif
#ifndef PROBE_DSA_BIS
#define PROBE_DSA_BIS 1
#endif
#ifndef PROBE_DSA_ATT
#define PROBE_DSA_ATT 1
#endif
#ifndef PROBE_U
#define PROBE_U 1
#endif
#ifndef PROBE_V
#define PROBE_V 1
#endif
#ifndef PROBE_ROUTE
#define PROBE_ROUTE 1
#endif
#ifndef PROBE_G3
#define PROBE_G3 1
#endif

#define NT 512
typedef unsigned short u16;
typedef __attribute__((ext_vector_type(8))) short bf16x8;
typedef __attribute__((ext_vector_type(16))) float f32x16;
typedef __attribute__((ext_vector_type(16))) unsigned u32x16;

#define DEV __device__ __forceinline__

constexpr int B_ = 16, S_ = 2048, D_ = 1024, T_ = B_ * S_;
constexpr int NPROJ = 2896, NPAD = 3072;
constexpr int SV_ = 2048 + 64;
constexpr float NEG_INF = -__builtin_huge_valf();

constexpr size_t OFF_MOD = 0;
constexpr size_t OFF_COS = OFF_MOD + 786432;
constexpr size_t OFF_SIN = OFF_COS + (size_t)T_ * 32 * 4;
constexpr size_t OFF_HBUF = OFF_SIN + (size_t)T_ * 32 * 4;
constexpr size_t OFF_WTIN = OFF_HBUF + (size_t)T_ * 1024 * 2;
constexpr size_t OFF_WTOUT = OFF_WTIN + (size_t)NPAD * 1024 * 2;
constexpr size_t OFF_WTQ = OFF_WTOUT + (size_t)1024 * 1024 * 2;
constexpr size_t OFF_SK = OFF_WTQ + (size_t)1024 * 1024 * 2;
constexpr size_t OFF_U = OFF_SK + (size_t)16 * 128 * 64 * 2;
constexpr size_t OFF_V = OFF_U + (size_t)16384 * 1024;
constexpr size_t OFF_SU = OFF_V + (size_t)16384 * 1024;
constexpr size_t OFF_SV = OFF_SU + (size_t)16384 * 4;
constexpr size_t OFF_Q = OFF_SV + (size_t)16384 * 4;
constexpr size_t OFF_QI = OFF_Q + (size_t)T_ * 512 * 2;
constexpr size_t OFF_XBC = OFF_QI + (size_t)T_ * 512 * 2;
constexpr size_t OFF_SIN_ST = OFF_XBC;
constexpr size_t OFF_MIX = OFF_Q;
constexpr size_t OFF_K = OFF_XBC + (size_t)T_ * 1024 * 2;
constexpr size_t OFF_VT = OFF_K + (size_t)T_ * 128 * 2;
constexpr size_t OFF_KI = OFF_VT + (size_t)16 * 2 * 64 * SV_ * 2;
constexpr size_t OFF_WI = OFF_KI + (size_t)T_ * 64 * 2;
constexpr size_t OFF_DT = OFF_WI + (size_t)T_ * 8 * 4;
constexpr size_t OFF_Z = OFF_DT + (size_t)T_ * 8 * 4;
constexpr size_t OFF_EIDX = OFF_Z;
constexpr size_t OFF_GATE = OFF_Z + (size_t)T_ * 128 * 4;
constexpr size_t OFF_ST = OFF_Z + (size_t)T_ * 512 * 2;
constexpr size_t OFF_YP_ = OFF_ST + (size_t)16 * 16 * 8 * 64 * 128 * 4 + (size_t)16 * 16 * 8 * 128 * 4;
constexpr size_t OFF_X1 = OFF_ST;
constexpr size_t OFF_QP = OFF_YP_;
constexpr size_t OFF_ACUM = OFF_ST + (size_t)16 * 16 * 8 * 64 * 128 * 4;
constexpr size_t OFF_YP = OFF_ACUM + (size_t)16 * 16 * 8 * 128 * 4;
static_assert(OFF_YP_ == OFF_YP, "alias");
constexpr size_t OFF_CC = OFF_YP + (size_t)T_ * 512 * 4;
constexpr size_t OFF_BAR = OFF_CC + (size_t)T_ * 256 * 2;
constexpr size_t OFF_XB = OFF_BAR + 256;
constexpr size_t OFF_H2Q = OFF_XB + 16384;
constexpr size_t OFF_SH = OFF_H2Q + (size_t)T_ * 1024;
constexpr size_t WS_END = OFF_SH + (size_t)T_ * 4;

constexpr int LDS_BYTES = 156672;

struct Params {
  const float* x; const float* c; const int* pos; const float* w_ada; const float* b_ada;
  const float* pre_mix_g; const float* post_mix_g; const float* w_in; const float* conv_w; const float* conv_b;
  const float* dt_bias; const float* a_log; const float* d_skip; const float* ssd_norm_g; const float* w_out;
  const float* pre_ffn_g; const float* post_ffn_g; const float* w_q; const float* sub_keys; const float* peer_u;
  const float* peer_v; float* out; unsigned char* ws;
};

__constant__ float c_inv_freq[32] = {
  1.000000000e+00f, 7.498942614e-01f, 5.623413324e-01f, 4.216965139e-01f, 3.162277639e-01f, 2.371373773e-01f, 1.778279394e-01f, 1.333521307e-01f,
  1.000000015e-01f, 7.498941571e-02f, 5.623413250e-02f, 4.216965288e-02f, 3.162277490e-02f, 2.371373773e-02f, 1.778279431e-02f, 1.333521493e-02f,
  9.999999776e-03f, 7.498941850e-03f, 5.623413250e-03f, 4.216964822e-03f, 3.162277630e-03f, 2.371373586e-03f, 1.778279431e-03f, 1.333521446e-03f,
  1.000000047e-03f, 7.498942432e-04f, 5.623413017e-04f, 4.216965172e-04f, 3.162277571e-04f, 2.371373703e-04f, 1.778279402e-04f, 1.333521504e-04f};

DEV int opaque_tid() { int t = threadIdx.x; asm volatile("" : "+v"(t)); return t; }
DEV u16 f2bf(float f) { unsigned u = __float_as_uint(f); u += 0x7FFFu + ((u >> 16) & 1u); return (u16)(u >> 16); }
DEV float bf2f(u16 h) { return __uint_as_float(((unsigned)h) << 16); }
DEV unsigned pack2(float a, float b) { unsigned r; asm("v_cvt_pk_bf16_f32 %0, %1, %2" : "=v"(r) : "v"(a), "v"(b)); return r; }
DEV float bflo(unsigned u) { return __uint_as_float(u << 16); }
DEV float bfhi(unsigned u) { return __uint_as_float(u & 0xFFFF0000u); }
DEV float wave_sum(float v) {
#pragma unroll
  for (int o = 32; o > 0; o >>= 1) v += __shfl_xor(v, o);
  return v;
}
#define DPP_ADD(v, ctrl, rmask) v += __int_as_float(__builtin_amdgcn_update_dpp(0, __float_as_int(v), ctrl, rmask, 0xF, false))
DEV float wave_sum63(float v) {
  DPP_ADD(v, 0xB1, 0xF);
  DPP_ADD(v, 0x4E, 0xF);
  DPP_ADD(v, 0x141, 0xF);
  DPP_ADD(v, 0x140, 0xF);
  DPP_ADD(v, 0x142, 0xA);
  DPP_ADD(v, 0x143, 0xC);
  return v;
}
DEV f32x16 mfma32(bf16x8 a, bf16x8 b, f32x16 c) { return __builtin_amdgcn_mfma_f32_32x32x16_bf16(a, b, c, 0, 0, 0); }
DEV f32x16 zero16() { f32x16 z;
#pragma unroll
  for (int i = 0; i < 16; i++) z[i] = 0.f;
  return z; }
DEV int rowmap(int reg, int hh) { return (reg & 3) + 8 * (reg >> 2) + 4 * hh; }
DEV float silu_f(float v) { return v / (1.f + expf(-v)); }
DEV unsigned ordkey(float f) { unsigned b = __float_as_uint(f); unsigned m = (unsigned)((int)b >> 31) | 0x80000000u; return b ^ m; }
DEV bf16x8 mk_frag(uint2 lo, uint2 hi) { union { uint4 u; bf16x8 v; } t; t.u = make_uint4(lo.x, lo.y, hi.x, hi.y); return t.v; }
DEV bf16x8 pack_frag(const f32x16& v, int base) {
  union { uint4 u; bf16x8 f; } t;
  t.u = make_uint4(pack2(v[base + 0], v[base + 1]), pack2(v[base + 2], v[base + 3]), pack2(v[base + 4], v[base + 5]), pack2(v[base + 6], v[base + 7]));
  return t.f;
}

DEV float4 ldmod(const float* mod, int off) {
  const float4 a = *(const float4*)(mod + off), b = *(const float4*)(mod + 98304 + off);
  return make_float4(a.x + b.x, a.y + b.y, a.z + b.z, a.w + b.w);
}
DEV void phase_mod(const Params& p, char* smem) {
  float* s_silu = (float*)smem;
  float* s_red = (float*)(smem + 32768);
  float* mod = (float*)(p.ws + OFF_MOD);
  const int tid = threadIdx.x;
  for (int item = blockIdx.x; item < 192; item += gridDim.x) {
    const int cgp = item >> 1, ks = item & 1;
    __syncthreads();
    for (int e = tid; e < 8192; e += NT) { int b = e >> 9, i = e & 511; s_silu[i * 16 + b] = silu_f(p.c[b * 1024 + ks * 512 + i]); }
    __syncthreads();
    const int kg = tid >> 6, col = tid & 63;
    float acc[16];
#pragma unroll
    for (int b = 0; b < 16; b++) acc[b] = 0.f;
    const float* w = p.w_ada + (size_t)(ks * 512 + kg * 64) * 6144 + cgp * 64 + col;
#pragma unroll 1
    for (int i0 = 0; i0 < 64; i0 += 16) {
      float wreg[16];
#pragma unroll
      for (int u = 0; u < 16; u++) wreg[u] = w[(size_t)(i0 + u) * 6144];
#pragma unroll
      for (int u = 0; u < 16; u++) {
        const float wv = wreg[u];
        const float4* sp = (const float4*)(s_silu + (kg * 64 + i0 + u) * 16);
        float4 s0 = sp[0], s1 = sp[1], s2 = sp[2], s3 = sp[3];
        acc[0] += s0.x * wv; acc[1] += s0.y * wv; acc[2] += s0.z * wv; acc[3] += s0.w * wv;
        acc[4] += s1.x * wv; acc[5] += s1.y * wv; acc[6] += s1.z * wv; acc[7] += s1.w * wv;
        acc[8] += s2.x * wv; acc[9] += s2.y * wv; acc[10] += s2.z * wv; acc[11] += s2.w * wv;
        acc[12] += s3.x * wv; acc[13] += s3.y * wv; acc[14] += s3.z * wv; acc[15] += s3.w * wv;
      }
    }
#pragma unroll
    for (int b = 0; b < 16; b++) s_red[(kg * 64 + col) * 16 + b] = acc[b];
    __syncthreads();
    for (int e = tid; e < 1024; e += NT) {
      int cc = e >> 4, b = e & 15; float sum = 0.f;
#pragma unroll
      for (int k = 0; k < 8; k++) sum += s_red[(k * 64 + cc) * 16 + b];
      int j = cgp * 64 + cc;
      mod[ks * 98304 + b * 6144 + j] = sum + (ks == 0 ? p.b_ada[j] : 0.f);
    }
  }
}

DEV int remap_col(int n) {
  if (n < 1344) return n;
  if (n < 1352) return 2880 + (n - 1344);
  if (n < 2888) return n - 8;
  return n;
}

DEV void transpose_convert(const float* __restrict__ src, int N, u16* __restrict__ dst, bool remap, char* smem) {
  float* tile = (float*)smem;
  const int tid = threadIdx.x;
  const int ntn = (N + 63) >> 6;
  const int nitems = 16 * ntn;
  for (int item = blockIdx.x; item < nitems; item += gridDim.x) {
    const int kt = item / ntn, nt = item - kt * ntn;
    const int k0 = kt * 64, n0 = nt * 64;
    __syncthreads();
    for (int e = tid; e < 4096; e += NT) {
      int r = e >> 6, ci = e & 63, n = n0 + ci;
      tile[r * 65 + ci] = (n < N) ? src[(size_t)(k0 + r) * N + n] : 0.f;
    }
    __syncthreads();
    for (int e = tid; e < 4096; e += NT) {
      int nn = e >> 6, kk = e & 63, n = n0 + nn;
      if (n < N) { int n2 = remap ? remap_col(n) : n; dst[(size_t)n2 * 1024 + k0 + kk] = f2bf(tile[kk * 65 + nn]); }
    }
  }
}

DEV void convert_bf16(const float* __restrict__ src, u16* __restrict__ dst, size_t n8) {
  const size_t g = (size_t)blockIdx.x * NT + threadIdx.x, gs = (size_t)gridDim.x * NT;
  for (size_t i = g; i < n8; i += gs) {
    const float4 a = ((const float4*)src)[2 * i], b = ((const float4*)src)[2 * i + 1];
    ((uint4*)dst)[i] = make_uint4(pack2(a.x, a.y), pack2(a.z, a.w), pack2(b.x, b.y), pack2(b.z, b.w));
  }
}

DEV void convert_fp8_rows(const float* __restrict__ src, unsigned char* __restrict__ dst, float* __restrict__ scl) {
  const int tid_ = opaque_tid(); const int lane = tid_ & 63, wave = __builtin_amdgcn_readfirstlane(tid_ >> 6);
  for (int e0 = ((blockIdx.x >> 1) * 8 + wave) * 4 + (blockIdx.x & 1) * 8192; e0 < 8192 + (blockIdx.x & 1) * 8192; e0 += (gridDim.x >> 1) * 32) {
    float4 v[4][4];
#pragma unroll
    for (int u = 0; u < 4; u++)
#pragma unroll
      for (int j = 0; j < 4; j++) v[u][j] = *(const float4*)(src + (size_t)(e0 + u) * 1024 + j * 256 + lane * 4);
#pragma unroll
    for (int u = 0; u < 4; u++) {
      float mx = 0.f;
#pragma unroll
      for (int j = 0; j < 4; j++) mx = fmaxf(mx, fmaxf(fmaxf(fabsf(v[u][j].x), fabsf(v[u][j].y)), fmaxf(fabsf(v[u][j].z), fabsf(v[u][j].w))));
#pragma unroll
      for (int o = 32; o > 0; o >>= 1) mx = fmaxf(mx, __shfl_xor(mx, o));
      const float inv = (mx > 0.f) ? 384.f / mx : 0.f;
      int wd[4];
#pragma unroll
      for (int j = 0; j < 4; j++) {
        int t = 0;
        t = __builtin_amdgcn_cvt_pk_fp8_f32(v[u][j].x * inv, v[u][j].y * inv, t, false);
        t = __builtin_amdgcn_cvt_pk_fp8_f32(v[u][j].z * inv, v[u][j].w * inv, t, true);
        wd[j] = t;
      }
      *(uint4*)(dst + (size_t)(e0 + u) * 1024 + lane * 16) = make_uint4((unsigned)wd[0], (unsigned)wd[1], (unsigned)wd[2], (unsigned)wd[3]);
      if (lane == 0) scl[e0 + u] = mx * (1.f / 384.f);
    }
  }
}

DEV unsigned pack_i8x4(float a, float b, float c, float d) {
  const int ia = (int)rintf(a), ib = (int)rintf(b), ic = (int)rintf(c), id = (int)rintf(d);
  return (unsigned)(ia & 255) | ((unsigned)(ib & 255) << 8) | ((unsigned)(ic & 255) << 16) | ((unsigned)id << 24);
}
DEV void convert_i8_rows(const float* __restrict__ src, unsigned char* __restrict__ dst, float* __restrict__ scl) {
  const int tid_ = opaque_tid(); const int lane = tid_ & 63, wave = __builtin_amdgcn_readfirstlane(tid_ >> 6);
  for (int e0 = ((blockIdx.x >> 1) * 8 + wave) * 4 + (blockIdx.x & 1) * 8192; e0 < 8192 + (blockIdx.x & 1) * 8192; e0 += (gridDim.x >> 1) * 32) {
    float4 v[4][4];
#pragma unroll
    for (int u = 0; u < 4; u++)
#pragma unroll
      for (int j = 0; j < 4; j++) v[u][j] = *(const float4*)(src + (size_t)(e0 + u) * 1024 + j * 256 + lane * 4);
#pragma unroll
    for (int u = 0; u < 4; u++) {
      float mx = 0.f;
#pragma unroll
      for (int j = 0; j < 4; j++) mx = fmaxf(mx, fmaxf(fmaxf(fabsf(v[u][j].x), fabsf(v[u][j].y)), fmaxf(fabsf(v[u][j].z), fabsf(v[u][j].w))));
#pragma unroll
      for (int o = 32; o > 0; o >>= 1) mx = fmaxf(mx, __shfl_xor(mx, o));
      const float inv = (mx > 0.f) ? 127.f / mx : 0.f;
      unsigned wd[4];
#pragma unroll
      for (int j = 0; j < 4; j++) wd[j] = pack_i8x4(v[u][j].x * inv, v[u][j].y * inv, v[u][j].z * inv, v[u][j].w * inv);
      *(uint4*)(dst + (size_t)(e0 + u) * 1024 + lane * 16) = make_uint4(wd[0], wd[1], wd[2], wd[3]);
      if (lane == 0) scl[e0 + u] = mx * (1.f / 127.f);
    }
  }
}

DEV void phase0(const Params& p, char* smem) {
  {
    float* cosT = (float*)(p.ws + OFF_COS); float* sinT = (float*)(p.ws + OFF_SIN);
    const int g = blockIdx.x * NT + threadIdx.x, gs = gridDim.x * NT;
    for (int e = g; e < T_ * 32; e += gs) {
      int t = e >> 5, j = e & 31;
      float ang = (float)p.pos[t] * c_inv_freq[j];
      double rev = (double)ang * 0.15915494309189533577;
      rev -= rint(rev);
      float fr = (float)rev;
      cosT[e] = __builtin_amdgcn_cosf(fr);
      sinT[e] = __builtin_amdgcn_sinf(fr);
    }
  }
  transpose_convert(p.w_in, NPROJ, (u16*)(p.ws + OFF_WTIN), true, smem);
  {
    uint4* z = (uint4*)(p.ws + OFF_WTIN + (size_t)NPROJ * 1024 * 2);
    const int n = (NPAD - NPROJ) * 1024 * 2 / 16;
    for (int i = blockIdx.x * NT + threadIdx.x; i < n; i += gridDim.x * NT) z[i] = make_uint4(0, 0, 0, 0);
  }
  transpose_convert(p.w_out, 1024, (u16*)(p.ws + OFF_WTOUT), false, smem);
  transpose_convert(p.w_q, 1024, (u16*)(p.ws + OFF_WTQ), false, smem);
  convert_bf16(p.sub_keys, (u16*)(p.ws + OFF_SK), (size_t)16 * 128 * 64 / 8);
}

DEV void phase_hnorm(const Params& p) {
  const int tid_ = opaque_tid(); const int lane = tid_ & 63, wave = __builtin_amdgcn_readfirstlane(tid_ >> 6);
  const float* mod = (const float*)(p.ws + OFF_MOD);
  u16* h = (u16*)(p.ws + OFF_HBUF);
  for (int t0 = (blockIdx.x * 8 + wave) * 16; t0 < T_; t0 += gridDim.x * 128) {
    const int b = t0 >> 11;
    float4 gm[4], sh[4];
#pragma unroll
    for (int i = 0; i < 4; i++) {
      const int col = (i * 64 + lane) * 4;
      const float4 g = *(const float4*)(p.pre_mix_g + col);
      const float4 sc = ldmod(mod, b * 6144 + 1024 + col);
      sh[i] = ldmod(mod, b * 6144 + col);
      gm[i] = make_float4(g.x * (1.f + sc.x), g.y * (1.f + sc.y), g.z * (1.f + sc.z), g.w * (1.f + sc.w));
    }
#pragma unroll 2
    for (int r_ = 0; r_ < 16; r_++) {
      const int t = t0 + r_;
      const float4* xr = (const float4*)(p.x + (size_t)t * 1024);
      float4 v[4]; float ss = 0.f;
#pragma unroll
      for (int i = 0; i < 4; i++) { v[i] = xr[i * 64 + lane]; ss += v[i].x * v[i].x + v[i].y * v[i].y + v[i].z * v[i].z + v[i].w * v[i].w; }
      ss = wave_sum(ss);
      const float rstd = rsqrtf(ss * (1.f / 1024.f) + 1e-6f);
#pragma unroll
      for (int i = 0; i < 4; i++) {
        const int col = (i * 64 + lane) * 4;
        const float y0 = (v[i].x * rstd) * gm[i].x + sh[i].x, y1 = (v[i].y * rstd) * gm[i].y + sh[i].y;
        const float y2 = (v[i].z * rstd) * gm[i].z + sh[i].z, y3 = (v[i].w * rstd) * gm[i].w + sh[i].w;
        *(uint2*)(h + (size_t)t * 1024 + col) = make_uint2(pack2(y0, y1), pack2(y2, y3));
      }
    }
  }
}

constexpr int G_ROWB = 144;
constexpr int G_ABYTES = 128 * G_ROWB;
constexpr int G_STAGE = (128 + 256) * G_ROWB;
constexpr int G_SROW = 68;

template <class Epi>
DEV void gemm_tile(const u16* __restrict__ A, int lda, const u16* __restrict__ Bt, int ldb, int K, char* smem, Epi& epi) {
  const int tid = opaque_tid(), lane = tid & 63, wave = __builtin_amdgcn_readfirstlane(tid >> 6), wm = wave >> 2, wn = wave & 3;
  const int r = lane & 31, hh = lane >> 5;
  f32x16 acc00 = zero16(), acc01 = zero16(), acc10 = zero16(), acc11 = zero16();
  uint4 pa0, pa1, pb0, pb1, pb2, pb3;
  uint4 qa0, qa1, qb0, qb1, qb2, qb3;
  const int crow = tid >> 3, ckc = tid & 7;
  const u16* Ap = A + (size_t)crow * lda + ckc * 8;
  const u16* Bp = Bt + (size_t)crow * ldb + ckc * 8;
  const size_t a64 = (size_t)64 * lda, b64 = (size_t)64 * ldb;
  const int loff = crow * G_ROWB + ckc * 16;
#define G_LOAD(S, k0) { S##a0 = *(const uint4*)(Ap + (k0)); S##a1 = *(const uint4*)(Ap + a64 + (k0)); \
    S##b0 = *(const uint4*)(Bp + (k0)); S##b1 = *(const uint4*)(Bp + b64 + (k0)); S##b2 = *(const uint4*)(Bp + 2 * b64 + (k0)); S##b3 = *(const uint4*)(Bp + 3 * b64 + (k0)); }
#define G_STORE(S, buf) { char* sb_ = smem + (buf) * G_STAGE + loff; *(uint4*)(sb_) = S##a0; *(uint4*)(sb_ + 64 * G_ROWB) = S##a1; \
    char* sc_ = sb_ + G_ABYTES; *(uint4*)(sc_) = S##b0; *(uint4*)(sc_ + 64 * G_ROWB) = S##b1; *(uint4*)(sc_ + 128 * G_ROWB) = S##b2; *(uint4*)(sc_ + 192 * G_ROWB) = S##b3; }
#define G_COMPUTE(buf) { const char* sb = smem + (buf) * G_STAGE; _Pragma("unroll") for (int s = 0; s < 4; s++) { \
      const bf16x8 a0 = *(const bf16x8*)(sb + aoff + s * 32); const bf16x8 a1 = *(const bf16x8*)(sb + aoff + 32 * G_ROWB + s * 32); \
      const bf16x8 b0 = *(const bf16x8*)(sb + boff + s * 32); const bf16x8 b1 = *(const bf16x8*)(sb + boff + 32 * G_ROWB + s * 32); \
      acc00 = mfma32(a0, b0, acc00); acc01 = mfma32(a0, b1, acc01); acc10 = mfma32(a1, b0, acc10); acc11 = mfma32(a1, b1, acc11); } }
  const int nk = K >> 6;
  const int aoff = (wm * 64 + r) * G_ROWB + hh * 16;
  const int boff = G_ABYTES + (wn * 64 + r) * G_ROWB + hh * 16;
  G_LOAD(p, 0); G_LOAD(q, 64);
  __syncthreads();
  G_STORE(p, 0);
  __syncthreads();
  for (int kt = 0; kt < nk; kt += 2) {
    if (kt + 2 < nk) G_LOAD(p, (kt + 2) * 64);
    G_COMPUTE(0);
    G_STORE(q, 1);
    __syncthreads();
    if (kt + 3 < nk) G_LOAD(q, (kt + 3) * 64);
    G_COMPUTE(1);
    if (kt + 2 < nk) G_STORE(p, 0);
    __syncthreads();
  }
#undef G_LOAD
#undef G_STORE
#undef G_COMPUTE
  {
    float* stage = (float*)(smem + wave * (64 * G_SROW * 4));
#pragma unroll
    for (int reg = 0; reg < 16; reg++) {
      const int row = (reg & 3) + 8 * (reg >> 2) + 4 * hh;
      stage[row * G_SROW + r] = acc00[reg];
      stage[row * G_SROW + 32 + r] = acc01[reg];
      stage[(32 + row) * G_SROW + r] = acc10[reg];
      stage[(32 + row) * G_SROW + 32 + r] = acc11[reg];
    }
    epi.apply(stage, wm * 64, wn * 64, lane);
  }
}

DEV void ld16(const float* src, float* x) {
  const float4 a = *(const float4*)src, b = *(const float4*)(src + 4), c = *(const float4*)(src + 8), d = *(const float4*)(src + 12);
  x[0] = a.x; x[1] = a.y; x[2] = a.z; x[3] = a.w; x[4] = b.x; x[5] = b.y; x[6] = b.z; x[7] = b.w;
  x[8] = c.x; x[9] = c.y; x[10] = c.z; x[11] = c.w; x[12] = d.x; x[13] = d.y; x[14] = d.z; x[15] = d.w;
}
DEV void st16_bf(u16* dst, const float* x) {
  *(uint4*)dst = make_uint4(pack2(x[0], x[1]), pack2(x[2], x[3]), pack2(x[4], x[5]), pack2(x[6], x[7]));
  *(uint4*)(dst + 8) = make_uint4(pack2(x[8], x[9]), pack2(x[10], x[11]), pack2(x[12], x[13]), pack2(x[14], x[15]));
}
DEV void st16_f(float* dst, const float* x) {
  *(float4*)dst = make_float4(x[0], x[1], x[2], x[3]); *(float4*)(dst + 4) = make_float4(x[4], x[5], x[6], x[7]);
  *(float4*)(dst + 8) = make_float4(x[8], x[9], x[10], x[11]); *(float4*)(dst + 12) = make_float4(x[12], x[13], x[14], x[15]);
}

struct EpiInProj {
  const Params* p; int m0, n0;
  DEV void apply(const float* stage, int rbase, int cbase, int lane) { apply_s<G_SROW>(stage, rbase, cbase, lane); }
  template <int SROW>
  DEV void apply_s(const float* stage, int rbase, int cbase, int lane) {
    const int nb = n0 + cbase;
    unsigned char* ws = p->ws;
    const int tb = m0 + rbase;
    if (nb < 640 || (nb >= 768 && nb < 1344)) {
      u16* dst; int ld, cb;
      if (nb < 512) { dst = (u16*)(ws + OFF_Q); ld = 512; cb = nb; }
      else if (nb < 640) { dst = (u16*)(ws + OFF_K); ld = 128; cb = nb - 512; }
      else if (nb < 1280) { dst = (u16*)(ws + OFF_QI); ld = 512; cb = nb - 768; }
      else { dst = (u16*)(ws + OFF_KI); ld = 64; cb = 0; }
      const float* cosT = (const float*)(ws + OFF_COS); const float* sinT = (const float*)(ws + OFF_SIN);
      const int cg = lane & 1;
#pragma unroll 1
      for (int i = 0; i < 2; i++) {
        const int row = (lane >> 1) + 32 * i; const int t = tb + row;
        float x1[16], x2[16], cs[16], sn[16], o1[16], o2[16];
        ld16(stage + row * SROW + cg * 16, x1); ld16(stage + row * SROW + 32 + cg * 16, x2);
        ld16(cosT + (size_t)t * 32 + cg * 16, cs); ld16(sinT + (size_t)t * 32 + cg * 16, sn);
#pragma unroll
        for (int k = 0; k < 16; k++) { o1[k] = x1[k] * cs[k] - x2[k] * sn[k]; o2[k] = x2[k] * cs[k] + x1[k] * sn[k]; }
        st16_bf(dst + (size_t)t * ld + cb + cg * 16, o1); st16_bf(dst + (size_t)t * ld + cb + 32 + cg * 16, o2);
      }
    } else if (nb >= 640 && nb < 768) {
      u16* vt = (u16*)(ws + OFF_VT);
      const int kvh = (nb - 640) >> 6;
      const int b = tb >> 11, s0 = tb & 2047;
      u16* dp = vt + ((size_t)(b * 2 + kvh) * 64 + lane) * SV_ + s0;
#pragma unroll 1
      for (int q8 = 0; q8 < 8; q8++) {
        float x[8];
#pragma unroll
        for (int k = 0; k < 8; k++) x[k] = stage[(q8 * 8 + k) * SROW + lane];
        *(uint4*)(dp + q8 * 8) = make_uint4(pack2(x[0], x[1]), pack2(x[2], x[3]), pack2(x[4], x[5]), pack2(x[6], x[7]));
      }
    } else if (nb >= 1344 && nb < 2880) {
      u16* dst; int ld, cb;
      if (nb < 1856) { dst = (u16*)(ws + OFF_Z); ld = 512; cb = nb - 1344; }
      else { dst = (u16*)(ws + OFF_XBC); ld = 1024; cb = nb - 1856; }
      const int cg = lane & 1;
#pragma unroll 1
      for (int i = 0; i < 2; i++) {
        const int row = (lane >> 1) + 32 * i; const int t = tb + row;
        float x1[16], x2[16];
        ld16(stage + row * SROW + cg * 16, x1); ld16(stage + row * SROW + 32 + cg * 16, x2);
        st16_bf(dst + (size_t)t * ld + cb + cg * 16, x1); st16_bf(dst + (size_t)t * ld + cb + 32 + cg * 16, x2);
      }
    } else if (nb == 2880) {
      float* wi = (float*)(ws + OFF_WI); float* dtr = (float*)(ws + OFF_DT);
      const int t = tb + lane;
      float x[16];
      ld16(stage + lane * SROW, x);
      const float sc = 0.044194173824159216f;
      *(float4*)(wi + (size_t)t * 8) = make_float4(x[0] * sc, x[1] * sc, x[2] * sc, x[3] * sc);
      *(float4*)(wi + (size_t)t * 8 + 4) = make_float4(x[4] * sc, x[5] * sc, x[6] * sc, x[7] * sc);
      *(float4*)(dtr + (size_t)t * 8) = make_float4(x[8], x[9], x[10], x[11]);
      *(float4*)(dtr + (size_t)t * 8 + 4) = make_float4(x[12], x[13], x[14], x[15]);
    }
  }
};

struct EpiStoreF32 {
  float* dst; int n0;
  DEV void apply(const float* stage, int rbase, int cbase, int lane) {
    const int cg = lane & 1;
#pragma unroll 1
    for (int i = 0; i < 2; i++) {
      const int row = (lane >> 1) + 32 * i;
      float x1[16], x2[16];
      ld16(stage + row * G_SROW + cg * 16, x1); ld16(stage + row * G_SROW + 32 + cg * 16, x2);
      float* d = dst + (size_t)(rbase + row) * 1024 + n0 + cbase + cg * 16;
      st16_f(d, x1); st16_f(d + 32, x2);
    }
  }
};
struct EpiStoreBf16 {
  u16* dst; int n0;
  DEV void apply(const float* stage, int rbase, int cbase, int lane) {
    const int cg = lane & 1;
#pragma unroll 1
    for (int i = 0; i < 2; i++) {
      const int row = (lane >> 1) + 32 * i;
      float x1[16], x2[16];
      ld16(stage + row * G_SROW + cg * 16, x1); ld16(stage + row * G_SROW + 32 + cg * 16, x2);
      u16* d = dst + (size_t)(rbase + row) * 1024 + n0 + cbase + cg * 16;
      st16_bf(d, x1); st16_bf(d + 32, x2);
    }
  }
};

typedef __attribute__((ext_vector_type(4))) float f32x4v;
constexpr int P8_HT = 128 * 64;
constexpr int P8_SROW = 260;
DEV int p8_lds_byte(int r, int c) {
  const int st = (r >> 4) * 2 + (c >> 5), rr = r & 15, cc = c & 31, ob = rr * 64 + cc * 2;
  return st * 1024 + (ob ^ (((ob >> 9) & 1) << 5));
}
DEV void p8_stage_rc(int b, int& R, int& C) {
  const int st = b / 1024, sb = b % 1024, swz = sb ^ (((sb >> 9) & 1) << 5);
  R = (st >> 1) * 16 + swz / 64; C = (st & 1) * 32 + (swz % 64) / 2;
}
template <class Epi>
DEV void gemm256_8phase(const u16* __restrict__ A, const u16* __restrict__ Bt, int brow, int bcol, char* smem, Epi& epi) {
  constexpr int K = 1024, BK = 64, HALF = 128;
  u16* shm = (u16*)smem;
  const int tid = opaque_tid();
#define SA(b,h) (shm+((b)*2+(h))*P8_HT)
#define SB(b,h) (shm+(4+(b)*2+(h))*P8_HT)
#define P8STAGE(P,BASE,br,kt) do{ const long _g=(long)(br)*K+(long)(kt)*BK; \
    _Pragma("unroll") for(int _i=0;_i<2;++_i){ const int _b=tid*16+_i*8192; int _r,_c; p8_stage_rc(_b,_r,_c); \
      __builtin_amdgcn_global_load_lds((const unsigned*)(BASE+_g+(long)_r*K+_c), (__attribute__((address_space(3))) unsigned*)((char*)(P)+_b),16,0,0);} }while(0)
#define LDA(dst,b,h) _Pragma("unroll") for(int m=0;m<4;++m) _Pragma("unroll") for(int k=0;k<2;++k) \
    dst[m][k]=*reinterpret_cast<const bf16x8*>((char*)SA(b,h)+p8_lds_byte(wr*64+m*16+fr,k*32+fq*8))
#define LDB(dst,b,h) _Pragma("unroll") for(int n=0;n<2;++n) _Pragma("unroll") for(int k=0;k<2;++k) \
    dst[n][k]=*reinterpret_cast<const bf16x8*>((char*)SB(b,h)+p8_lds_byte(wc*32+n*16+fr,k*32+fq*8))
#define MMA(ai,bj,At,Bt_) do{ __builtin_amdgcn_s_setprio(1); \
    _Pragma("unroll") for(int m=0;m<4;++m) _Pragma("unroll") for(int n=0;n<2;++n) _Pragma("unroll") for(int k=0;k<2;++k) \
      acc[ai][bj][m][n]=__builtin_amdgcn_mfma_f32_16x16x32_bf16(At[m][k],Bt_[n][k],acc[ai][bj][m][n],0,0,0); \
    __builtin_amdgcn_s_setprio(0);}while(0)
#define WAIT_V(n) asm volatile("s_waitcnt vmcnt(" #n ")":::"memory")
#define WAIT_L(n) asm volatile("s_waitcnt lgkmcnt(" #n ")":::"memory")
#define BAR __builtin_amdgcn_s_barrier()
#define SCHED __builtin_amdgcn_sched_barrier(0)
  const int wid = __builtin_amdgcn_readfirstlane(tid >> 6), lane = tid & 63, wr = wid >> 2, wc = wid & 3, fr = lane & 15, fq = lane >> 4;
  f32x4v acc[2][2][4][2];
#pragma unroll
  for (int a_ = 0; a_ < 2; a_++)
#pragma unroll
    for (int b_ = 0; b_ < 2; b_++)
#pragma unroll
      for (int m = 0; m < 4; m++)
#pragma unroll
        for (int n = 0; n < 2; n++) acc[a_][b_][m][n] = (f32x4v){0.f, 0.f, 0.f, 0.f};
  bf16x8 At[4][2], B0[2][2], B1[2][2];
  constexpr int nt = K / BK;
  asm volatile("s_waitcnt vmcnt(0) lgkmcnt(0)" ::: "memory");
  __syncthreads();
  P8STAGE(SB(0,0),Bt,bcol,0); P8STAGE(SA(0,0),A,brow,0);
  P8STAGE(SB(0,1),Bt,bcol+HALF,0); P8STAGE(SA(0,1),A,brow+HALF,0);
  if(wr==1)BAR;
  WAIT_V(4); BAR;
  P8STAGE(SB(1,0),Bt,bcol,1); P8STAGE(SA(1,0),A,brow,1); P8STAGE(SB(1,1),Bt,bcol+HALF,1);
  WAIT_V(6); BAR;
#pragma unroll 1
  for(int t=0;t<nt-2;t+=2){
    LDB(B0,0,0); SCHED; LDA(At,0,0); P8STAGE(SA(1,1),A,brow+HALF,t+1);
    WAIT_L(8); BAR; WAIT_L(0); MMA(0,0,At,B0); BAR; SCHED;
    LDB(B1,0,1); P8STAGE(SB(0,0),Bt,bcol,t+2);
    BAR; WAIT_L(0); MMA(0,1,At,B1); BAR;
    LDA(At,0,1); P8STAGE(SA(0,0),A,brow,t+2);
    BAR; WAIT_L(0); MMA(1,0,At,B0); BAR; SCHED;
    P8STAGE(SB(0,1),Bt,bcol+HALF,t+2);
    WAIT_V(6); BAR; MMA(1,1,At,B1); BAR;
    LDB(B0,1,0); SCHED; LDA(At,1,0); P8STAGE(SA(0,1),A,brow+HALF,t+2);
    WAIT_L(8); BAR; WAIT_L(0); MMA(0,0,At,B0); BAR; SCHED;
    LDB(B1,1,1); P8STAGE(SB(1,0),Bt,bcol,t+3);
    BAR; WAIT_L(0); MMA(0,1,At,B1); BAR;
    LDA(At,1,1); P8STAGE(SA(1,0),A,brow,t+3);
    BAR; WAIT_L(0); MMA(1,0,At,B0); BAR; SCHED;
    P8STAGE(SB(1,1),Bt,bcol+HALF,t+3);
    WAIT_V(6); BAR; MMA(1,1,At,B1); BAR;
  }
  { LDB(B0,0,0); LDA(At,0,0); P8STAGE(SA(1,1),A,brow+HALF,nt-1);
    BAR; WAIT_L(0); MMA(0,0,At,B0); BAR;
    LDB(B1,0,1); BAR; WAIT_L(0); MMA(0,1,At,B1); BAR;
    LDA(At,0,1); WAIT_V(4); BAR; WAIT_L(0); MMA(1,0,At,B0); MMA(1,1,At,B1); BAR; }
  { LDB(B0,1,0); LDA(At,1,0); WAIT_V(2); BAR; WAIT_L(0); MMA(0,0,At,B0); BAR;
    LDB(B1,1,1); WAIT_V(0); BAR; WAIT_L(0); MMA(0,1,At,B1); BAR;
    LDA(At,1,1); BAR; WAIT_L(0); MMA(1,0,At,B0); MMA(1,1,At,B1); BAR; }
  if(wr==0)BAR;
  float* img = (float*)smem;
#pragma unroll
  for (int ai = 0; ai < 2; ai++) {
    __syncthreads();
#pragma unroll
    for (int bj = 0; bj < 2; bj++)
#pragma unroll
      for (int m = 0; m < 4; m++)
#pragma unroll
        for (int n = 0; n < 2; n++)
#pragma unroll
          for (int j = 0; j < 4; j++)
            img[(wr * 64 + m * 16 + fq * 4 + j) * P8_SROW + bj * HALF + wc * 32 + n * 16 + fr] = acc[ai][bj][m][n][j];
    __syncthreads();
    epi.template apply_s<P8_SROW>(img + (wid >> 2) * 64 * P8_SROW + (wid & 3) * 64, ai * 128 + (wid >> 2) * 64, (wid & 3) * 64, lane);
  }
  __syncthreads();
#undef SA
#undef SB
#undef P8STAGE
#undef LDA
#undef LDB
#undef MMA
#undef WAIT_V
#undef WAIT_L
#undef BAR
#undef SCHED
}

DEV void phase1(const Params& p, char* smem) {
  const u16* h = (const u16*)(p.ws + OFF_HBUF);
  const u16* wt = (const u16*)(p.ws + OFF_WTIN);
  if (blockIdx.x & 1) convert_i8_rows(p.peer_u, p.ws + OFF_U, (float*)(p.ws + OFF_SU));
  const int ntiles = 128 * 12;
  for (int tile = blockIdx.x; tile < ntiles; tile += gridDim.x) {
    const int mt = tile % 128, nt = tile / 128;
    EpiInProj epi{&p, mt * 256, nt * 256};
    gemm256_8phase(h, wt, mt * 256, nt * 256, smem, epi);
  }
  if (!(blockIdx.x & 1)) convert_i8_rows(p.peer_u, p.ws + OFF_U, (float*)(p.ws + OFF_SU));
}

constexpr int DS_QROW = 1040;
constexpr int DS_CNT = 32 * DS_QROW;
constexpr int DS_MASK = DS_CNT + 2 * 8 * 32 * 4;
constexpr int DS_WQ = DS_MASK + 64 * 64 * 2;
constexpr int DS_KV = DS_WQ + 1024;
constexpr int DS_KVSTAGE = 2 * 32 * 144 + 2 * 64 * 72;
constexpr int DS_VOFF = 2 * 32 * 144;

DEV int dsa_reduce(int c, unsigned* cbuf, int& par, int r, int hh, int w) {
  c += __shfl_xor(c, 32);
  unsigned* bq = cbuf + par * 256;
  if (hh == 0) bq[w * 32 + r] = (unsigned)c;
  __syncthreads();
  int tot = 0;
#pragma unroll
  for (int k = 0; k < 8; k++) tot += (int)bq[k * 32 + r];
  par ^= 1;
  return tot;
}

DEV void dsa_item(const Params& p, int b, int qt, char* smem) {
  const int tid = opaque_tid(), lane = tid & 63, w = __builtin_amdgcn_readfirstlane(tid >> 6), r = lane & 31, hh = lane >> 5;
  const int q0 = qt * 32; const size_t tb = (size_t)b * 2048;
  const u16* qi = (const u16*)(p.ws + OFF_QI);
  const u16* ki = (const u16*)(p.ws + OFF_KI);
  const float* wi = (const float*)(p.ws + OFF_WI);
  unsigned* cbuf = (unsigned*)(smem + DS_CNT);
  u16* maskb = (u16*)(smem + DS_MASK);
  const bool need_sel = (qt >= 8);
  __syncthreads();
  if (need_sel) {
#pragma unroll
    for (int i = 0; i < 4; i++) {
      int c = tid + i * 512; int row = c >> 6, cc = c & 63;
      *(uint4*)(smem + row * DS_QROW + cc * 16) = *(const uint4*)(qi + (tb + q0 + row) * 512 + cc * 8);
    }
    if (tid < 256) ((float*)(smem + DS_WQ))[tid] = wi[(tb + q0) * 8 + tid];
  }
  __syncthreads();
  if (need_sel) {
    const float* wql = (const float*)(smem + DS_WQ) + r * 8;
    u32x16 uk[8];
#pragma unroll
    for (int i = 0; i < 8; i++) {
      const int kt = w + 8 * i;
      if (kt <= qt) {
        const u16* kp = ki + (tb + kt * 32 + r) * 64 + hh * 8;
        bf16x8 ka[4];
#pragma unroll
        for (int s = 0; s < 4; s++) ka[s] = *(const bf16x8*)(kp + s * 16);
        f32x16 scr = zero16();
#pragma unroll 2
        for (int h8 = 0; h8 < 8; h8++) {
          f32x16 a = zero16();
          const char* qrow = smem + r * DS_QROW + h8 * 128 + hh * 16;
#pragma unroll
          for (int s = 0; s < 4; s++) {
            const bf16x8 qb = *(const bf16x8*)(qrow + s * 32);
            a = mfma32(ka[s], qb, a);
          }
          const float wv = wql[h8];
#pragma unroll
          for (int reg = 0; reg < 16; reg++) scr[reg] = fmaf(wv, fmaxf(a[reg], 0.f), scr[reg]);
        }
#pragma unroll
        for (int reg = 0; reg < 16; reg++) {
          float v = scr[reg];
          if (kt == qt && ((reg & 3) + 8 * (reg >> 2)) > r - 4 * hh) v = NEG_INF;
          uk[i][reg] = ordkey(v);
        }
      } else {
#pragma unroll
        for (int reg = 0; reg < 16; reg++) uk[i][reg] = 0u;
      }
    }
    int par = 0;
    unsigned T = 0u;
    unsigned* lst = (unsigned*)(smem + DS_KV);
    unsigned* lcnt = (unsigned*)(smem + DS_KV + 16384);
    unsigned* lhic = lcnt + 32;
    unsigned* ltp = lcnt + 64;
    for (int rep_b = 0; rep_b < PROBE_DSA_BIS; rep_b++) {
    T = 0u;
    if (tid < 32) lcnt[tid] = 0u;
    for (int it = 0; it < 12; ++it) {
      const unsigned cand = T | (0x80000000u >> it);
      int c = 0;
#pragma unroll
      for (int i = 0; i < 8; i++) {
        if (w + 8 * i <= qt) {
#pragma unroll
          for (int reg = 0; reg < 16; reg++) c += (uk[i][reg] >= cand) ? 1 : 0;
        }
      }
      if (dsa_reduce(c, cbuf, par, r, hh, w) >= 256) T = cand;
    }
    int hic;
    {
      const bool ovf = (T >= 0xFFF00000u);
      const unsigned hi = T + 0x00100000u;
      int c = 0;
      if (!ovf) {
#pragma unroll
        for (int i = 0; i < 8; i++) {
          if (w + 8 * i <= qt) {
#pragma unroll
            for (int reg = 0; reg < 16; reg++) c += (uk[i][reg] >= hi) ? 1 : 0;
          }
        }
      }
      hic = dsa_reduce(c, cbuf, par, r, hh, w);
    }
#pragma unroll
    for (int i = 0; i < 8; i++) {
      if (w + 8 * i <= qt) {
#pragma unroll
        for (int reg = 0; reg < 16; reg++) {
          const unsigned d = uk[i][reg] - T;
          if (d < 0x00100000u) { const unsigned pos = atomicAdd(&lcnt[r], 1u); if (pos < 128u) lst[r * 128 + pos] = d; }
        }
      }
    }
    if (w == 0 && hh == 0) { lhic[r] = (unsigned)hic; ltp[r] = T; }
    __syncthreads();
    if (!__syncthreads_or(lcnt[r] > 128u)) {
      const int qsub = lane >> 4, l16 = lane & 15, q = 4 * w + qsub;
      const int n = (int)lcnt[q];
      const int kp = 256 - (int)lhic[q];
      unsigned v[8];
#pragma unroll
      for (int j = 0; j < 8; j++) { const int ix = l16 + 16 * j; v[j] = (ix < n) ? lst[q * 128 + ix] : 0u; }
      unsigned Tl = 0u;
#pragma unroll 1
      for (int bit = 19; bit >= 0; --bit) {
        const unsigned cand = Tl | (1u << bit);
        int c = 0;
#pragma unroll
        for (int j = 0; j < 8; j++) c += (v[j] >= cand) ? 1 : 0;
        c += __builtin_amdgcn_update_dpp(0, c, 0xB1, 0xF, 0xF, false);
        c += __builtin_amdgcn_update_dpp(0, c, 0x4E, 0xF, 0xF, false);
        c += __builtin_amdgcn_update_dpp(0, c, 0x141, 0xF, 0xF, false);
        c += __builtin_amdgcn_update_dpp(0, c, 0x140, 0xF, 0xF, false);
        if (c >= kp) Tl = cand;
      }
      const unsigned tq = ltp[q] | Tl;
      __syncthreads();
      if (l16 == 0) ltp[q] = tq;
      __syncthreads();
      T = ltp[r];
    } else {
      for (int it = 12; it < 32; ++it) {
        const unsigned cand = T | (0x80000000u >> it);
        int c = 0;
#pragma unroll
        for (int i = 0; i < 8; i++) {
          if (w + 8 * i <= qt) {
#pragma unroll
            for (int reg = 0; reg < 16; reg++) c += (uk[i][reg] >= cand) ? 1 : 0;
          }
        }
        if (dsa_reduce(c, cbuf, par, r, hh, w) >= 256) T = cand;
      }
    }
    }
    int cge;
    {
      int c = 0;
      unsigned Tv = T;
      asm volatile("" : "+v"(Tv));
#pragma unroll
      for (int i = 0; i < 8; i++) {
        if (w + 8 * i <= qt) {
#pragma unroll
          for (int reg = 0; reg < 16; reg++) c += (uk[i][reg] >= Tv) ? 1 : 0;
        }
      }
      cge = dsa_reduce(c, cbuf, par, r, hh, w);
    }
    unsigned J = 4095u;
    if (__syncthreads_or(cge != 256)) {
      int need;
      {
        int c = 0;
        unsigned Tv = T;
        asm volatile("" : "+v"(Tv));
#pragma unroll
        for (int i = 0; i < 8; i++) {
          if (w + 8 * i <= qt) {
#pragma unroll
            for (int reg = 0; reg < 16; reg++) c += (uk[i][reg] > Tv) ? 1 : 0;
          }
        }
        need = 256 - dsa_reduce(c, cbuf, par, r, hh, w);
      }
      J = 0u;
      for (int it = 0; it < 12; ++it) {
        const unsigned cj = J | (2048u >> it);
        int c = 0;
        unsigned Tv = T;
        asm volatile("" : "+v"(Tv));
#pragma unroll
        for (int i = 0; i < 8; i++) {
          if (w + 8 * i <= qt) {
            const int lim = (int)cj - ((w + 8 * i) * 32 + 4 * hh);
#pragma unroll
            for (int reg = 0; reg < 16; reg++) c += (uk[i][reg] == Tv && ((reg & 3) + 8 * (reg >> 2)) < lim) ? 1 : 0;
          }
        }
        if (dsa_reduce(c, cbuf, par, r, hh, w) <= need) J = cj;
      }
    }
#pragma unroll
    for (int i = 0; i < 8; i++) {
      const int kt = w + 8 * i;
      if (kt <= qt) {
        const int lim = (int)J - (kt * 32 + 4 * hh);
        unsigned bits = 0u;
#pragma unroll
        for (int reg = 0; reg < 16; reg++) {
          const unsigned u = uk[i][reg];
          const bool sel = (u > T) || (u == T && ((reg & 3) + 8 * (reg >> 2)) < lim);
          bits |= (sel ? 1u : 0u) << reg;
        }
        maskb[kt * 64 + lane] = (u16)bits;
      }
    }
  } else {
#pragma unroll
    for (int i = 0; i < 8; i++) {
      const int kt = w + 8 * i;
      if (kt <= qt) {
        unsigned bits = 0xFFFFu;
        if (kt == qt) {
          bits = 0u;
#pragma unroll
          for (int reg = 0; reg < 16; reg++) bits |= ((((reg & 3) + 8 * (reg >> 2)) <= r - 4 * hh) ? 1u : 0u) << reg;
        }
        maskb[kt * 64 + lane] = (u16)bits;
      }
    }
  }
  for (int rep_a = 0; rep_a < PROBE_DSA_ATT; rep_a++)
  {
    const int head = w, kvh = w >> 2;
    const u16* q = (const u16*)(p.ws + OFF_Q);
    const u16* kk = (const u16*)(p.ws + OFF_K);
    const u16* vt = (const u16*)(p.ws + OFF_VT);
    bf16x8 qf[4];
    {
      const u16* qp = q + (tb + q0 + r) * 512 + head * 64 + hh * 8;
#pragma unroll
      for (int s = 0; s < 4; s++) qf[s] = *(const bf16x8*)(qp + s * 16);
    }
    const int l_kvh = tid >> 8;
    const int k_row = (tid >> 3) & 31, k_ch = tid & 7;
    const int v_d = (tid >> 2) & 63, v_ch = tid & 3;
    const u16* gk = kk + (tb + k_row) * 128 + l_kvh * 64 + k_ch * 8;
    const u16* gv = vt + ((size_t)(b * 2 + l_kvh) * 64 + v_d) * SV_ + v_ch * 8;
    const int lk = DS_KV + l_kvh * (32 * 144) + k_row * 144 + k_ch * 16;
    const int lv = DS_KV + DS_VOFF + l_kvh * (64 * 72) + v_d * 72 + v_ch * 16;
    const int fk = DS_KV + kvh * (32 * 144) + r * 144 + hh * 16;
    const int fv = DS_KV + DS_VOFF + kvh * (64 * 72) + r * 72 + hh * 8;
    const int nsteps = (qt + 2) >> 1;
    uint4 rkA, rvA, rkB, rvB;
#define AT_LOAD(j_) { const int ka_ = 2 * (j_), kb_ = (2 * (j_) + 1 <= qt) ? 2 * (j_) + 1 : qt; \
      rkA = *(const uint4*)(gk + (size_t)ka_ * 32 * 128); rvA = *(const uint4*)(gv + ka_ * 32); \
      rkB = *(const uint4*)(gk + (size_t)kb_ * 32 * 128); rvB = *(const uint4*)(gv + kb_ * 32); }
#define AT_STORE(sb_) { char* d_ = smem + (sb_) * (2 * DS_KVSTAGE); \
      *(uint4*)(d_ + lk) = rkA; *(uint2*)(d_ + lv) = make_uint2(rvA.x, rvA.y); *(uint2*)(d_ + lv + 8) = make_uint2(rvA.z, rvA.w); \
      *(uint4*)(d_ + DS_KVSTAGE + lk) = rkB; *(uint2*)(d_ + DS_KVSTAGE + lv) = make_uint2(rvB.x, rvB.y); *(uint2*)(d_ + DS_KVSTAGE + lv + 8) = make_uint2(rvB.z, rvB.w); }
    AT_LOAD(0);
    __syncthreads();
    AT_STORE(0);
    __syncthreads();
    f32x16 o0 = zero16(), o1 = zero16();
    float m = NEG_INF, l = 0.f;
    const float SC = 0.125f * 1.4426950408889634f;
    for (int j = 0; j < nsteps; ++j) {
      const char* stg = smem + (j & 1) * (2 * DS_KVSTAGE);
      if (j + 1 < nsteps) AT_LOAD(j + 1);
      f32x16 sa = zero16(), sb = zero16();
#pragma unroll
      for (int s = 0; s < 4; s++) {
        const bf16x8 kfa = *(const bf16x8*)(stg + fk + s * 32);
        const bf16x8 kfb = *(const bf16x8*)(stg + DS_KVSTAGE + fk + s * 32);
        sa = mfma32(kfa, qf[s], sa); sb = mfma32(kfb, qf[s], sb);
      }
      const unsigned bitsA = maskb[(2 * j) * 64 + lane];
      const unsigned bitsB = (2 * j + 1 <= qt) ? (unsigned)maskb[(2 * j + 1) * 64 + lane] : 0u;
#pragma unroll
      for (int reg = 0; reg < 16; reg++) { sa[reg] = ((bitsA >> reg) & 1u) ? sa[reg] : NEG_INF; sb[reg] = ((bitsB >> reg) & 1u) ? sb[reg] : NEG_INF; }
      float tmax = fmaxf(fmaxf(sa[0], sb[0]), fmaxf(sa[1], sb[1]));
#pragma unroll
      for (int reg = 2; reg < 16; reg += 2) tmax = fmaxf(tmax, fmaxf(fmaxf(sa[reg], sb[reg]), fmaxf(sa[reg + 1], sb[reg + 1])));
      tmax = fmaxf(tmax, __shfl_xor(tmax, 32));
      const float mn = fmaxf(m, tmax);
      const float ms = (mn == NEG_INF) ? 0.f : mn;
      const float nmsc = -ms * SC;
      float ps = 0.f, ps2 = 0.f;
#pragma unroll
      for (int reg = 0; reg < 16; reg++) {
        const float pa = __builtin_amdgcn_exp2f(fmaf(sa[reg], SC, nmsc)), pb = __builtin_amdgcn_exp2f(fmaf(sb[reg], SC, nmsc));
        sa[reg] = pa; sb[reg] = pb; ps += pa; ps2 += pb;
      }
      if (__any(mn != m)) {
        const float alpha = __builtin_amdgcn_exp2f(fmaf(m, SC, nmsc));
        l *= alpha;
#pragma unroll
        for (int reg = 0; reg < 16; reg++) { o0[reg] *= alpha; o1[reg] *= alpha; }
      }
      l += ps + ps2; m = mn;
      {
        const bf16x8 pf0 = pack_frag(sa, 0), pf1 = pack_frag(sa, 8);
        const char* vb = stg + fv;
        const bf16x8 v00 = mk_frag(*(const uint2*)(vb), *(const uint2*)(vb + 16));
        const bf16x8 v01 = mk_frag(*(const uint2*)(vb + 32), *(const uint2*)(vb + 48));
        const bf16x8 v10 = mk_frag(*(const uint2*)(vb + 32 * 72), *(const uint2*)(vb + 32 * 72 + 16));
        const bf16x8 v11 = mk_frag(*(const uint2*)(vb + 32 * 72 + 32), *(const uint2*)(vb + 32 * 72 + 48));
        o0 = mfma32(v00, pf0, o0); o1 = mfma32(v10, pf0, o1);
        o0 = mfma32(v01, pf1, o0); o1 = mfma32(v11, pf1, o1);
      }
      {
        const bf16x8 pf0 = pack_frag(sb, 0), pf1 = pack_frag(sb, 8);
        const char* vb = stg + DS_KVSTAGE + fv;
        const bf16x8 v00 = mk_frag(*(const uint2*)(vb), *(const uint2*)(vb + 16));
        const bf16x8 v01 = mk_frag(*(const uint2*)(vb + 32), *(const uint2*)(vb + 48));
        const bf16x8 v10 = mk_frag(*(const uint2*)(vb + 32 * 72), *(const uint2*)(vb + 32 * 72 + 16));
        const bf16x8 v11 = mk_frag(*(const uint2*)(vb + 32 * 72 + 32), *(const uint2*)(vb + 32 * 72 + 48));
        o0 = mfma32(v00, pf0, o0); o1 = mfma32(v10, pf0, o1);
        o0 = mfma32(v01, pf1, o0); o1 = mfma32(v11, pf1, o1);
      }
      if (j + 1 < nsteps) AT_STORE((j + 1) & 1);
      __syncthreads();
    }
#undef AT_LOAD
#undef AT_STORE
    const float lt = l + __shfl_xor(l, 32);
    const float inv = 1.f / lt;
    u16* cat = (u16*)(p.ws + OFF_HBUF);
    u16* op = cat + (tb + q0 + r) * 1024 + head * 64 + 4 * hh;
#pragma unroll
    for (int gq = 0; gq < 4; gq++) {
      *(uint2*)(op + 8 * gq) = make_uint2(pack2(o0[4 * gq] * inv, o0[4 * gq + 1] * inv), pack2(o0[4 * gq + 2] * inv, o0[4 * gq + 3] * inv));
      *(uint2*)(op + 32 + 8 * gq) = make_uint2(pack2(o1[4 * gq] * inv, o1[4 * gq + 1] * inv), pack2(o1[4 * gq + 2] * inv, o1[4 * gq + 3] * inv));
    }
  }
}

constexpr int SA_ROW = 272;
constexpr int SA_XROW = 144;
constexpr int SA_C = 0, SA_B = 128 * SA_ROW;
constexpr int SA_XDT = 2 * 128 * SA_ROW;
constexpr int SA_XDS = SA_XDT + 128 * SA_XROW;
constexpr int SA_FL = SA_XDS + 128 * SA_XROW;

DEV float silu_fast(float v) { return v * __builtin_amdgcn_rcpf(1.f + __builtin_amdgcn_exp2f(-1.4426950408889634f * v)); }

DEV void conv_pair8(const u16* __restrict__ xbc, const float* __restrict__ cw, const float* __restrict__ cbias, size_t tb, int pos0, int ch, float* o0, float* o1) {
  const float2 w0 = *(const float2*)(cw + ch), w1 = *(const float2*)(cw + 1024 + ch), w2 = *(const float2*)(cw + 2048 + ch), w3 = *(const float2*)(cw + 3072 + ch);
  const float2 bs = *(const float2*)(cbias + ch);
  unsigned xr[11];
#pragma unroll
  for (int j = 0; j < 11; j++) { const int sp = pos0 - 3 + j; xr[j] = (sp >= 0) ? *(const unsigned*)(xbc + (tb + sp) * 1024 + ch) : 0u; }
#pragma unroll
  for (int j = 0; j < 8; j++) {
    float a = bs.x, c = bs.y;
    a = fmaf(w0.x, bflo(xr[j]), a); c = fmaf(w0.y, bfhi(xr[j]), c);
    a = fmaf(w1.x, bflo(xr[j + 1]), a); c = fmaf(w1.y, bfhi(xr[j + 1]), c);
    a = fmaf(w2.x, bflo(xr[j + 2]), a); c = fmaf(w2.y, bfhi(xr[j + 2]), c);
    a = fmaf(w3.x, bflo(xr[j + 3]), a); c = fmaf(w3.y, bfhi(xr[j + 3]), c);
    o0[j] = silu_fast(a); o1[j] = silu_fast(c);
  }
}

DEV bf16x8 gather8(const char* base, int stride, bool perm) {
  unsigned v[8];
#pragma unroll
  for (int j = 0; j < 8; j++) { const int row = perm ? ((j & 3) + 8 * (j >> 2)) : j; v[j] = *(const u16*)(base + row * stride); }
  union { uint4 u; bf16x8 f; } t;
  t.u = make_uint4(v[0] | (v[1] << 16), v[2] | (v[3] << 16), v[4] | (v[5] << 16), v[6] | (v[7] << 16));
  return t.f;
}

DEV void ssdA_item(const Params& p, int b, int c, int g, char* smem) {
  const int tid = opaque_tid(), lane = tid & 63, w = __builtin_amdgcn_readfirstlane(tid >> 6), r = lane & 31, hh = lane >> 5;
  const size_t tb = (size_t)b * 2048;
  const u16* xbc = (const u16*)(p.ws + OFF_XBC);
  const float* dtraw = (const float*)(p.ws + OFF_DT);
  __syncthreads();
  {
    u16* ccg = (u16*)(p.ws + OFF_CC);
#pragma unroll 1
    for (int k = 0; k < 4; k++) {
      const int e = tid + k * 512;
      const int pr = e & 63, lb = (e >> 6) & 15, which = e >> 10;
      const int n = 2 * pr, l0 = lb * 8;
      float o0[8], o1[8];
      conv_pair8(xbc, p.conv_w, p.conv_b, tb, c * 128 + l0, 512 + which * 256 + g * 128 + n, o0, o1);
      char* dst = smem + (which ? SA_C : SA_B) + l0 * SA_ROW + n * 2;
#pragma unroll
      for (int j = 0; j < 8; j++) {
        const unsigned pk = pack2(o0[j], o1[j]);
        *(unsigned*)(dst + j * SA_ROW) = pk;
        if (which) *(unsigned*)(ccg + (tb + c * 128 + l0 + j) * 256 + g * 128 + n) = pk;
      }
    }
  }
  if (w < 4) {
    const int h = g * 4 + w;
    float* dtv_ = (float*)(smem + SA_FL) + w * 384; float* acum_ = dtv_ + 128; float* decs_ = dtv_ + 256;
    {
      const float A = -expf(p.a_log[h]);
      const float bias = p.dt_bias[h];
      float x0 = dtraw[(tb + c * 128 + lane) * 8 + h] + bias;
      float x1 = dtraw[(tb + c * 128 + 64 + lane) * 8 + h] + bias;
      float d0 = (x0 > 20.f) ? x0 : log1pf(expf(x0));
      float d1 = (x1 > 20.f) ? x1 : log1pf(expf(x1));
      dtv_[lane] = d0; dtv_[64 + lane] = d1;
      float v0 = d0 * A, v1 = d1 * A;
#pragma unroll
      for (int o = 1; o < 64; o <<= 1) { float n0 = __shfl_up(v0, o), n1 = __shfl_up(v1, o); if (lane >= o) { v0 += n0; v1 += n1; } }
      const float tot0 = __shfl(v0, 63);
      v1 += tot0;
      acum_[lane] = v0; acum_[64 + lane] = v1;
      const float atot = __shfl(v1, 63);
      decs_[lane] = expf(atot - v0); decs_[64 + lane] = expf(atot - v1);
    }
  }
#pragma unroll 1
  for (int h4 = 0; h4 < 4; h4++) {
    const int h = g * 4 + h4;
    float* dtv = (float*)(smem + SA_FL) + h4 * 384; float* acum = dtv + 128; float* decs = dtv + 256;
    __syncthreads();
    {
      const int pr = tid & 31, lb = tid >> 5;
      const int pp = 2 * pr, l0 = lb * 8;
      float o0[8], o1[8];
      conv_pair8(xbc, p.conv_w, p.conv_b, tb, c * 128 + l0, h * 64 + pp, o0, o1);
#pragma unroll
      for (int j = 0; j < 8; j++) {
        const float d = dtv[l0 + j], ds = decs[l0 + j];
        const float a0 = o0[j] * d, a1 = o1[j] * d;
        *(unsigned*)(smem + SA_XDT + (l0 + j) * SA_XROW + pp * 2) = pack2(a0, a1);
        *(unsigned*)(smem + SA_XDS + (l0 + j) * SA_XROW + pp * 2) = pack2(a0 * ds, a1 * ds);
      }
    }
    __syncthreads();
    {
      const int pt = w & 1, lt = w >> 1;
      const int lidx = lt * 32 + r;
      const float acl = acum[lidx];
      f32x16 yT = zero16();
      for (int st = 0; st <= lt; ++st) {
        f32x16 cb = zero16();
#pragma unroll
        for (int ks = 0; ks < 8; ks++) {
          const bf16x8 a = *(const bf16x8*)(smem + SA_B + (st * 32 + r) * SA_ROW + ks * 32 + hh * 16);
          const bf16x8 bq = *(const bf16x8*)(smem + SA_C + (lt * 32 + r) * SA_ROW + ks * 32 + hh * 16);
          cb = mfma32(a, bq, cb);
        }
#pragma unroll
        for (int reg = 0; reg < 16; reg++) {
          const int sidx = st * 32 + rowmap(reg, hh);
          const float as = acum[sidx];
          cb[reg] = (sidx <= lidx) ? cb[reg] * __builtin_amdgcn_exp2f((acl - as) * 1.4426950408889634f) : 0.f;
        }
        const bf16x8 mf0 = pack_frag(cb, 0), mf1 = pack_frag(cb, 8);
        const char* xb = smem + SA_XDT + (st * 32 + 4 * hh) * SA_XROW + (pt * 32 + r) * 2;
        const bf16x8 x0 = gather8(xb, SA_XROW, true);
        const bf16x8 x1 = gather8(xb + 16 * SA_XROW, SA_XROW, true);
        yT = mfma32(x0, mf0, yT); yT = mfma32(x1, mf1, yT);
      }
      const float dsk = p.d_skip[h] / dtv[lidx];
      float* yp = (float*)(p.ws + OFF_YP) + (tb + c * 128 + lidx) * 512 + h * 64 + pt * 32 + 4 * hh;
#pragma unroll
      for (int gq = 0; gq < 4; gq++) {
        const uint2 xv = *(const uint2*)(smem + SA_XDT + lidx * SA_XROW + (pt * 32 + 8 * gq + 4 * hh) * 2);
        *(float4*)(yp + 8 * gq) = make_float4(yT[4 * gq] + dsk * bflo(xv.x), yT[4 * gq + 1] + dsk * bfhi(xv.x), yT[4 * gq + 2] + dsk * bflo(xv.y), yT[4 * gq + 3] + dsk * bfhi(xv.y));
      }
      const int nt = w >> 1;
      f32x16 sacc = zero16();
#pragma unroll
      for (int ks = 0; ks < 8; ks++) {
        const bf16x8 a = gather8(smem + SA_XDS + (ks * 16 + hh * 8) * SA_XROW + (pt * 32 + r) * 2, SA_XROW, false);
        const bf16x8 bq = gather8(smem + SA_B + (ks * 16 + hh * 8) * SA_ROW + (nt * 32 + r) * 2, SA_ROW, false);
        sacc = mfma32(a, bq, sacc);
      }
      float* stp = (float*)(p.ws + OFF_ST) + ((size_t)((b * 16 + c) * 8 + h) * 64) * 128;
#pragma unroll
      for (int reg = 0; reg < 16; reg++) stp[(pt * 32 + rowmap(reg, hh)) * 128 + nt * 32 + r] = sacc[reg];
      if (tid < 128) ((float*)(p.ws + OFF_ACUM))[((b * 16 + c) * 8 + h) * 128 + tid] = acum[tid];
    }
  }
}

DEV void ssdS_item(const Params& p, int b, int h, int q) {
  const int tid = opaque_tid();
  const float* stb = (const float*)(p.ws + OFF_ST);
  const float* acg = (const float*)(p.ws + OFF_ACUM);
  u16* sin = (u16*)(p.ws + OFF_SIN_ST);
  const int off = q * 2048 + tid * 4;
  float4 S = make_float4(0.f, 0.f, 0.f, 0.f);
  float4 ld[4];
#pragma unroll
  for (int j = 0; j < 4; j++) ld[j] = *(const float4*)(stb + (size_t)((b * 16 + j) * 8 + h) * 8192 + off);
#pragma unroll
  for (int c4 = 0; c4 < 16; c4 += 4) {
    float4 nx[4];
    if (c4 + 4 < 16) {
#pragma unroll
      for (int j = 0; j < 4; j++) nx[j] = *(const float4*)(stb + (size_t)((b * 16 + c4 + 4 + j) * 8 + h) * 8192 + off);
    }
#pragma unroll
    for (int j = 0; j < 4; j++) {
      const int c = c4 + j;
      *(uint2*)(sin + (size_t)((b * 16 + c) * 8 + h) * 8192 + off) = make_uint2(pack2(S.x, S.y), pack2(S.z, S.w));
      const float dec = expf(acg[((b * 16 + c) * 8 + h) * 128 + 127]);
      S.x = fmaf(S.x, dec, ld[j].x); S.y = fmaf(S.y, dec, ld[j].y); S.z = fmaf(S.z, dec, ld[j].z); S.w = fmaf(S.w, dec, ld[j].w);
    }
    if (c4 + 4 < 16) {
#pragma unroll
      for (int j = 0; j < 4; j++) ld[j] = nx[j];
    }
  }
}

DEV void ssdB_item(const Params& p, int b, int c, char* smem) {
  const int tid = opaque_tid(), lane = tid & 63, h = __builtin_amdgcn_readfirstlane(tid >> 6), r = lane & 31, hh = lane >> 5;
  const size_t tb = (size_t)b * 2048;
  const int g = h >> 2;
  float* ssq = (float*)smem;
  const float* acg = (const float*)(p.ws + OFF_ACUM);
  __syncthreads();
  bf16x8 sf[2][8];
  if (c > 0) {
    const u16* sin = (const u16*)(p.ws + OFF_SIN_ST) + (size_t)((b * 16 + c) * 8 + h) * 8192;
#pragma unroll
    for (int pt = 0; pt < 2; pt++)
#pragma unroll
      for (int ks = 0; ks < 8; ks++) sf[pt][ks] = *(const bf16x8*)(sin + (pt * 32 + r) * 128 + ks * 16 + hh * 8);
  }
  const u16* ccg = (const u16*)(p.ws + OFF_CC);
  const u16* zb = (const u16*)(p.ws + OFF_Z);
  const float* ypb = (const float*)(p.ws + OFF_YP);
  u16* cat = (u16*)(p.ws + OFF_HBUF);
  float4 ng0[4], ng1[4];
#pragma unroll
  for (int gq = 0; gq < 4; gq++) {
    ng0[gq] = *(const float4*)(p.ssd_norm_g + h * 64 + 8 * gq + 4 * hh);
    ng1[gq] = *(const float4*)(p.ssd_norm_g + h * 64 + 32 + 8 * gq + 4 * hh);
  }
#pragma unroll 1
  for (int lt = 0; lt < 4; ++lt) {
    const int lidx = lt * 32 + r;
    const size_t t = tb + c * 128 + lidx;
    f32x16 y0 = zero16(), y1 = zero16();
    if (c > 0) {
#pragma unroll
      for (int ks = 0; ks < 8; ks++) {
        const bf16x8 cf = *(const bf16x8*)(ccg + t * 256 + g * 128 + ks * 16 + hh * 8);
        y0 = mfma32(sf[0][ks], cf, y0); y1 = mfma32(sf[1][ks], cf, y1);
      }
      const float e = expf(acg[((b * 16 + c) * 8 + h) * 128 + lidx]);
#pragma unroll
      for (int reg = 0; reg < 16; reg++) { y0[reg] *= e; y1[reg] *= e; }
    }
    float ss = 0.f;
#pragma unroll
    for (int gq = 0; gq < 4; gq++) {
      const int pb = 8 * gq + 4 * hh;
      const float4 a0 = *(const float4*)(ypb + t * 512 + h * 64 + pb);
      const float4 a1 = *(const float4*)(ypb + t * 512 + h * 64 + 32 + pb);
      const uint2 z0 = *(const uint2*)(zb + t * 512 + h * 64 + pb);
      const uint2 z1 = *(const uint2*)(zb + t * 512 + h * 64 + 32 + pb);
      y0[4 * gq + 0] = (y0[4 * gq + 0] + a0.x) * silu_f(bflo(z0.x)); y0[4 * gq + 1] = (y0[4 * gq + 1] + a0.y) * silu_f(bfhi(z0.x));
      y0[4 * gq + 2] = (y0[4 * gq + 2] + a0.z) * silu_f(bflo(z0.y)); y0[4 * gq + 3] = (y0[4 * gq + 3] + a0.w) * silu_f(bfhi(z0.y));
      y1[4 * gq + 0] = (y1[4 * gq + 0] + a1.x) * silu_f(bflo(z1.x)); y1[4 * gq + 1] = (y1[4 * gq + 1] + a1.y) * silu_f(bfhi(z1.x));
      y1[4 * gq + 2] = (y1[4 * gq + 2] + a1.z) * silu_f(bflo(z1.y)); y1[4 * gq + 3] = (y1[4 * gq + 3] + a1.w) * silu_f(bfhi(z1.y));
#pragma unroll
      for (int j = 0; j < 4; j++) ss += y0[4 * gq + j] * y0[4 * gq + j] + y1[4 * gq + j] * y1[4 * gq + j];
    }
    ss += __shfl_xor(ss, 32);
    if (hh == 0) ssq[(lt * 32 + r) * 8 + h] = ss;
    __syncthreads();
    float tot = 0.f;
#pragma unroll
    for (int k = 0; k < 8; k++) tot += ssq[(lt * 32 + r) * 8 + k];
    const float rstd = rsqrtf(tot * (1.f / 512.f) + 1e-6f);
#pragma unroll
    for (int gq = 0; gq < 4; gq++) {
      const int pb = 8 * gq + 4 * hh;
      const float4 g0 = ng0[gq], g1 = ng1[gq];
      *(uint2*)(cat + t * 1024 + 512 + h * 64 + pb) = make_uint2(pack2(y0[4 * gq] * rstd * g0.x, y0[4 * gq + 1] * rstd * g0.y), pack2(y0[4 * gq + 2] * rstd * g0.z, y0[4 * gq + 3] * rstd * g0.w));
      *(uint2*)(cat + t * 1024 + 512 + h * 64 + 32 + pb) = make_uint2(pack2(y1[4 * gq] * rstd * g1.x, y1[4 * gq + 1] * rstd * g1.y), pack2(y1[4 * gq + 2] * rstd * g1.z, y1[4 * gq + 3] * rstd * g1.w));
    }
  }
}


DEV void p3_rows1(const Params& p, int m0) {
  const int tid_ = opaque_tid(); const int lane = tid_ & 63, w = __builtin_amdgcn_readfirstlane(tid_ >> 6);
  const u16* mix = (const u16*)(p.ws + OFF_MIX);
  const float* mod = (const float*)(p.ws + OFF_MOD);
  u16* h2 = (u16*)(p.ws + OFF_HBUF);
  const int b = m0 >> 11;
  float4 pg1[4], fgm[4], sh2[4];
#pragma unroll
  for (int k = 0; k < 4; k++) {
    const int col = (k * 64 + lane) * 4;
    const float4 pg = *(const float4*)(p.post_mix_g + col);
    const float4 g1 = ldmod(mod, b * 6144 + 2048 + col);
    pg1[k] = make_float4(pg.x * g1.x, pg.y * g1.y, pg.z * g1.z, pg.w * g1.w);
    const float4 fg = *(const float4*)(p.pre_ffn_g + col);
    const float4 sc = ldmod(mod, b * 6144 + 4096 + col);
    fgm[k] = make_float4(fg.x * (1.f + sc.x), fg.y * (1.f + sc.y), fg.z * (1.f + sc.z), fg.w * (1.f + sc.w));
    sh2[k] = ldmod(mod, b * 6144 + 3072 + col);
  }
#pragma unroll 2
  for (int i = 0; i < 16; i++) {
    const int t = m0 + w * 16 + i;
    float4 mv[4], xv[4]; float ss = 0.f;
#pragma unroll
    for (int k = 0; k < 4; k++) {
      { const uint2 mq = *(const uint2*)(mix + (size_t)t * 1024 + (k * 64 + lane) * 4); mv[k] = make_float4(bflo(mq.x), bfhi(mq.x), bflo(mq.y), bfhi(mq.y)); }
      xv[k] = *(const float4*)(p.x + (size_t)t * 1024 + (k * 64 + lane) * 4);
      ss += mv[k].x * mv[k].x + mv[k].y * mv[k].y + mv[k].z * mv[k].z + mv[k].w * mv[k].w;
    }
    ss = wave_sum(ss);
    const float rstd = rsqrtf(ss * (1.f / 1024.f) + 1e-6f);
    float s2 = 0.f;
#pragma unroll
    for (int k = 0; k < 4; k++) {
      const int col = (k * 64 + lane) * 4;
      xv[k].x += (mv[k].x * rstd) * pg1[k].x; xv[k].y += (mv[k].y * rstd) * pg1[k].y;
      xv[k].z += (mv[k].z * rstd) * pg1[k].z; xv[k].w += (mv[k].w * rstd) * pg1[k].w;
      s2 += xv[k].x * xv[k].x + xv[k].y * xv[k].y + xv[k].z * xv[k].z + xv[k].w * xv[k].w;
      *(uint2*)((u16*)(p.ws + OFF_X1) + (size_t)t * 1024 + col) = make_uint2(pack2(xv[k].x, xv[k].y), pack2(xv[k].z, xv[k].w));
    }
    s2 = wave_sum(s2);
    const float rstd2 = rsqrtf(s2 * (1.f / 1024.f) + 1e-6f);
#pragma unroll
    for (int k = 0; k < 4; k++) {
      const int col = (k * 64 + lane) * 4;
      const float y0 = (xv[k].x * rstd2) * fgm[k].x + sh2[k].x;
      const float y1 = (xv[k].y * rstd2) * fgm[k].y + sh2[k].y;
      const float y2 = (xv[k].z * rstd2) * fgm[k].z + sh2[k].z;
      const float y3 = (xv[k].w * rstd2) * fgm[k].w + sh2[k].w;
      *(uint2*)(h2 + (size_t)t * 1024 + col) = make_uint2(pack2(y0, y1), pack2(y2, y3));
      xv[k] = make_float4(y0, y1, y2, y3);
    }
    {
      float mx = 0.f;
#pragma unroll
      for (int k = 0; k < 4; k++) mx = fmaxf(mx, fmaxf(fmaxf(fabsf(xv[k].x), fabsf(xv[k].y)), fmaxf(fabsf(xv[k].z), fabsf(xv[k].w))));
#pragma unroll
      for (int o = 32; o > 0; o >>= 1) mx = fmaxf(mx, __shfl_xor(mx, o));
      const float inv = (mx > 0.f) ? 127.f / mx : 0.f;
      unsigned wd[4];
#pragma unroll
      for (int k = 0; k < 4; k++) wd[k] = pack_i8x4(xv[k].x * inv, xv[k].y * inv, xv[k].z * inv, xv[k].w * inv);
      *(uint4*)(p.ws + OFF_H2Q + (size_t)t * 1024 + lane * 16) = make_uint4(wd[0], wd[1], wd[2], wd[3]);
      if (lane == 0) ((float*)(p.ws + OFF_SH))[t] = mx * (1.f / 127.f);
    }
  }
}

#define INS16(L, x) { _Pragma("unroll") for (int j_ = 0; j_ < 16; j_++) { const unsigned hi_ = max(L[j_], x); x = min(L[j_], x); L[j_] = hi_; } }
#define CEX(L, a_, b_) { const unsigned hi_ = max(L[a_], L[b_]); const unsigned lo_ = min(L[a_], L[b_]); L[a_] = hi_; L[b_] = lo_; }
DEV float unordkey(unsigned u) { const unsigned b = (u & 0x80000000u) ? (u ^ 0x80000000u) : ~u; return __uint_as_float(b); }

#define SORT16(L) { \
  _Pragma("unroll") for (int k_ = 2; k_ <= 16; k_ <<= 1) { \
    _Pragma("unroll") for (int j_ = k_ >> 1; j_ > 0; j_ >>= 1) { \
      _Pragma("unroll") for (int i_ = 0; i_ < 16; i_++) { \
        const int l_ = i_ ^ j_; \
        if (l_ > i_) { \
          const unsigned a_ = L[i_], b_ = L[l_]; \
          const bool desc_ = ((i_ & k_) == 0); \
          L[i_] = desc_ ? max(a_, b_) : min(a_, b_); L[l_] = desc_ ? min(a_, b_) : max(a_, b_); \
        } } } } }
#define MERGE16(A, B) { \
  _Pragma("unroll") for (int j_ = 0; j_ < 16; j_++) A[j_] = max(A[j_], B[15 - j_]); \
  _Pragma("unroll") for (int j_ = 0; j_ < 8; j_++) CEX(A, j_, j_ + 8); \
  _Pragma("unroll") for (int j_ = 0; j_ < 16; j_++) if ((j_ & 4) == 0) CEX(A, j_, j_ + 4); \
  _Pragma("unroll") for (int j_ = 0; j_ < 16; j_++) if ((j_ & 2) == 0) CEX(A, j_, j_ + 2); \
  _Pragma("unroll") for (int j_ = 0; j_ < 16; j_ += 2) CEX(A, j_, j_ + 1); }

constexpr int RT_LROW = 36;

DEV void p3_route(const Params& p, int m0, char* smem) {
  const int tid = opaque_tid(), lane = tid & 63, w = __builtin_amdgcn_readfirstlane(tid >> 6), r = lane & 31, hh = lane >> 5;
  const u16* qp = (const u16*)(p.ws + OFF_QP);
  const u16* sk = (const u16*)(p.ws + OFF_SK);
  unsigned* lists = (unsigned*)smem;
  int* eidx = (int*)(p.ws + OFF_EIDX);
  float* gate = (float*)(p.ws + OFF_GATE);
  __syncthreads();
  {
    const int h = w;
#pragma unroll 1
    for (int i = 0; i < 2; i++) {
      bf16x8 af[4][4];
#pragma unroll
      for (int kt4 = 0; kt4 < 4; kt4++)
#pragma unroll
        for (int ks = 0; ks < 4; ks++) af[kt4][ks] = *(const bf16x8*)(sk + ((size_t)(h * 2 + i) * 128 + kt4 * 32 + r) * 64 + ks * 16 + hh * 8);
#pragma unroll 1
      for (int tt = 0; tt < 4; tt++) {
        bf16x8 bq[4];
#pragma unroll
        for (int ks = 0; ks < 4; ks++) bq[ks] = *(const bf16x8*)(qp + (size_t)(m0 + tt * 32 + r) * 1024 + h * 128 + i * 64 + ks * 16 + hh * 8);
        unsigned L0[16], L1[16], L2[16], L3[16];
#define RT_TILE(LL, kt4) { f32x16 acc = zero16(); \
          _Pragma("unroll") for (int ks = 0; ks < 4; ks++) acc = mfma32(af[kt4][ks], bq[ks], acc); \
          const unsigned kb = (unsigned)(127 - (kt4) * 32 - 4 * hh); \
          _Pragma("unroll") for (int reg = 0; reg < 16; reg++) LL[reg] = (ordkey(acc[reg]) & 0xFFFFFF80u) | (kb - (unsigned)((reg & 3) + 8 * (reg >> 2))); \
          SORT16(LL); }
        RT_TILE(L0, 0); RT_TILE(L1, 1);
        MERGE16(L0, L1);
        RT_TILE(L2, 2); RT_TILE(L3, 3);
        MERGE16(L2, L3);
        MERGE16(L0, L2);
#undef RT_TILE
        unsigned C[16];
#pragma unroll
        for (int j = 0; j < 16; j++) C[j] = (unsigned)__shfl_xor((int)L0[j], 32);
        MERGE16(L0, C);
#pragma unroll
        for (int j = 0; j < 16; j++) C[j] = L0[j];
        if (hh == 0) {
          uint4* dst = (uint4*)(lists + ((size_t)(h * 128 + tt * 32 + r)) * RT_LROW + i * 16);
          dst[0] = make_uint4(C[0], C[1], C[2], C[3]); dst[1] = make_uint4(C[4], C[5], C[6], C[7]);
          dst[2] = make_uint4(C[8], C[9], C[10], C[11]); dst[3] = make_uint4(C[12], C[13], C[14], C[15]);
        }
      }
    }
  }
  __syncthreads();
#pragma unroll 1
  for (int k = 0; k < 2; k++) {
    const int task = tid + k * 512;
    const int h = task >> 7, t = task & 127;
    const uint4* src = (const uint4*)(lists + (size_t)(h * 128 + t) * RT_LROW);
    unsigned K0[16], K1[16];
#pragma unroll
    for (int q = 0; q < 4; q++) {
      const uint4 a = src[q], bb = src[4 + q];
      K0[4 * q] = a.x; K0[4 * q + 1] = a.y; K0[4 * q + 2] = a.z; K0[4 * q + 3] = a.w;
      K1[4 * q] = bb.x; K1[4 * q + 1] = bb.y; K1[4 * q + 2] = bb.z; K1[4 * q + 3] = bb.w;
    }
    float s0[16], s1[16];
#pragma unroll
    for (int j = 0; j < 16; j++) { s0[j] = unordkey(K0[j] & 0xFFFFFF80u); s1[j] = unordkey(K1[j] & 0xFFFFFF80u); }
    unsigned L[16];
#pragma unroll
    for (int j = 0; j < 16; j++) L[j] = 0u;
#pragma unroll
    for (int a = 0; a < 16; a++) {
#pragma unroll
      for (int bb = 0; bb < 16; bb++) {
        if ((a + 1) * (bb + 1) <= 16) {
          unsigned x = (ordkey(s0[a] + s1[bb]) & 0xFFFFFF00u) | (unsigned)(255 - (a * 16 + bb));
          INS16(L, x);
        }
      }
    }
    float fv[16]; int ei[16]; float mx = NEG_INF;
#pragma unroll
    for (int j = 0; j < 16; j++) {
      const int code = 255 - (int)(L[j] & 255u); const int a = code >> 4, bb = code & 15;
      const unsigned ka = ((const unsigned*)src)[a], kb2 = ((const unsigned*)src)[16 + bb];
      const float va = unordkey(ka & 0xFFFFFF80u), vb = unordkey(kb2 & 0xFFFFFF80u);
      fv[j] = va + vb;
      ei[j] = (127 - (int)(ka & 127u)) * 128 + (127 - (int)(kb2 & 127u));
      mx = fmaxf(mx, fv[j]);
    }
    float sum = 0.f;
#pragma unroll
    for (int j = 0; j < 16; j++) { fv[j] = __expf(fv[j] - mx); sum += fv[j]; }
    const float inv = 1.f / sum;
    int* ep = eidx + (size_t)(m0 + t) * 128 + h * 16;
    float* gp = gate + (size_t)(m0 + t) * 128 + h * 16;
#pragma unroll
    for (int q = 0; q < 4; q++) {
      *(int4*)(ep + 4 * q) = make_int4(ei[4 * q], ei[4 * q + 1], ei[4 * q + 2], ei[4 * q + 3]);
      *(float4*)(gp + 4 * q) = make_float4(fv[4 * q] * inv, fv[4 * q + 1] * inv, fv[4 * q + 2] * inv, fv[4 * q + 3] * inv);
    }
  }
}

typedef __attribute__((ext_vector_type(2))) float f32x2;
DEV void dec16(const uint4& q, float* f) {
  f32x2 t;
  t = __builtin_amdgcn_cvt_pk_f32_fp8((int)q.x, false); f[0] = t[0]; f[1] = t[1];
  t = __builtin_amdgcn_cvt_pk_f32_fp8((int)q.x, true);  f[2] = t[0]; f[3] = t[1];
  t = __builtin_amdgcn_cvt_pk_f32_fp8((int)q.y, false); f[4] = t[0]; f[5] = t[1];
  t = __builtin_amdgcn_cvt_pk_f32_fp8((int)q.y, true);  f[6] = t[0]; f[7] = t[1];
  t = __builtin_amdgcn_cvt_pk_f32_fp8((int)q.z, false); f[8] = t[0]; f[9] = t[1];
  t = __builtin_amdgcn_cvt_pk_f32_fp8((int)q.z, true);  f[10] = t[0]; f[11] = t[1];
  t = __builtin_amdgcn_cvt_pk_f32_fp8((int)q.w, false); f[12] = t[0]; f[13] = t[1];
  t = __builtin_amdgcn_cvt_pk_f32_fp8((int)q.w, true);  f[14] = t[0]; f[15] = t[1];
}

constexpr int PX_ROW = 132;
constexpr int PX_Z = 0;
constexpr int PX_E = 8 * 16 * PX_ROW * 4;
constexpr int PX_SS = 2 * PX_E;
constexpr int PX_CL = PX_SS + 512;

DEV void p3_ustage(const Params& p, int m0, char* smem) {
  const int tid_ = opaque_tid(); const int lane = tid_ & 63, w = __builtin_amdgcn_readfirstlane(tid_ >> 6);
  const int sl = lane >> 3, ch = lane & 7;
  const unsigned char* h2q = p.ws + OFF_H2Q;
  const unsigned char* U = p.ws + OFF_U;
  const int* eidx = (const int*)(p.ws + OFF_EIDX);
  float* zb = (float*)(smem + PX_Z) + w * 16 * PX_ROW;
  int* eb = (int*)(smem + PX_E) + w * 16 * PX_ROW;
  int* cl = (int*)(smem + PX_CL) + w * 128;
#pragma unroll 1
  for (int i = 0; i < 16; i++) {
    const int t = m0 + w * 16 + i;
    eb[i * PX_ROW + lane] = eidx[(size_t)t * 128 + lane]; eb[i * PX_ROW + 64 + lane] = eidx[(size_t)t * 128 + 64 + lane];
  }
  if (lane < 16) ((float*)(smem + PX_SS))[w * 16 + lane] = 0.f;
#define U_LOAD8(Q, E) { const unsigned char* up_ = U + (size_t)(E) * 1024 + ch * 16; _Pragma("unroll") for (int k_ = 0; k_ < 8; k_++) Q[k_] = *(const uint4*)(up_ + k_ * 128); }
#pragma unroll 1
  for (int rep = 0; rep < PROBE_U; rep++)
#pragma unroll 1
  for (int x = 0; x < 8; x++) {
    float* zbase = zb;
    uint4 hqn[8];
#pragma unroll
    for (int k = 0; k < 8; k++) hqn[k] = *(const uint4*)(h2q + (size_t)(m0 + w * 16) * 1024 + k * 128 + ch * 16);
#pragma unroll 1
    for (int i = 0; i < 16; i++) {
      uint4 hq[8];
#pragma unroll
      for (int k = 0; k < 8; k++) hq[k] = hqn[k];
      const int ev0 = eb[i * PX_ROW + lane], ev1 = eb[i * PX_ROW + 64 + lane];
      const bool f0 = (ev0 >> 11) == x, f1 = (ev1 >> 11) == x;
      const unsigned long long mk0 = __ballot(f0), mk1 = __ballot(f1);
      const int n0 = __builtin_popcountll(mk0), n = n0 + __builtin_popcountll(mk1);
      const int r0 = __builtin_amdgcn_mbcnt_hi((unsigned)(mk0 >> 32), __builtin_amdgcn_mbcnt_lo((unsigned)mk0, 0));
      const int r1 = n0 + __builtin_amdgcn_mbcnt_hi((unsigned)(mk1 >> 32), __builtin_amdgcn_mbcnt_lo((unsigned)mk1, 0));
      if (f0) cl[r0] = ev0 | (lane << 16);
      if (f1) cl[r1] = ev1 | ((64 + lane) << 16);
      float* zrow = zbase + i * PX_ROW;
      uint4 qA[8]; int ceA = 0;
      if (n > 0) { ceA = cl[(sl < n) ? sl : 0]; U_LOAD8(qA, ceA & 0xFFFF); }
      {
        const unsigned char* hp = h2q + (size_t)(m0 + w * 16 + ((i < 15) ? i + 1 : i)) * 1024 + ch * 16;
#pragma unroll
        for (int k = 0; k < 8; k++) hqn[k] = *(const uint4*)(hp + k * 128);
      }
#pragma unroll 1
      for (int bb = 0; bb < n; bb += 8) {
        uint4 qB[8]; int ceB = 0;
        const bool more = (bb + 8 < n);
        if (more) { const int ix = bb + 8 + sl; ceB = cl[(ix < n) ? ix : bb + 8]; U_LOAD8(qB, ceB & 0xFFFF); }
        int d = 0;
#pragma unroll
        for (int k = 0; k < 8; k++) {
          d = __builtin_amdgcn_sdot4((int)qA[k].x, (int)hq[k].x, d, false);
          d = __builtin_amdgcn_sdot4((int)qA[k].y, (int)hq[k].y, d, false);
          d = __builtin_amdgcn_sdot4((int)qA[k].z, (int)hq[k].z, d, false);
          d = __builtin_amdgcn_sdot4((int)qA[k].w, (int)hq[k].w, d, false);
        }
        d += __builtin_amdgcn_update_dpp(0, d, 0xB1, 0xF, 0xF, false);
        d += __builtin_amdgcn_update_dpp(0, d, 0x4E, 0xF, 0xF, false);
        d += __builtin_amdgcn_update_dpp(0, d, 0x141, 0xF, 0xF, false);
        if (ch == 0 && bb + sl < n) zrow[ceA >> 16] = (float)d;
        if (more) {
#pragma unroll
          for (int k = 0; k < 8; k++) qA[k] = qB[k];
          ceA = ceB;
        }
      }
    }
  }
#undef U_LOAD8
  {
    const float* su = (const float*)(p.ws + OFF_SU);
    const float* sv = (const float*)(p.ws + OFF_SV);
    const float* shs = (const float*)(p.ws + OFF_SH);
    const float* gate = (const float*)(p.ws + OFF_GATE);
#pragma unroll 1
    for (int i = 0; i < 16; i++) {
      const int t = m0 + w * 16 + i;
      const float st = shs[t];
#pragma unroll
      for (int half = 0; half < 2; half++) {
        const int e = eb[i * PX_ROW + half * 64 + lane];
        const float z = zb[i * PX_ROW + half * 64 + lane] * (su[e] * st);
        zb[i * PX_ROW + half * 64 + lane] = 0.5f * z * (1.f + erff(z * 0.70710678118654752f)) * gate[(size_t)t * 128 + half * 64 + lane] * sv[e];
      }
    }
  }
}

DEV void p3_vstage(const Params& p, int m0, char* smem) {
  const int tid_ = opaque_tid(); const int lane = tid_ & 63, w = __builtin_amdgcn_readfirstlane(tid_ >> 6);
  const unsigned char* V = p.ws + OFF_V;
  const float* ab = (const float*)(smem + PX_Z) + w * 16 * PX_ROW;
  const int* eb = (const int*)(smem + PX_E) + w * 16 * PX_ROW;
  float* ssq = (float*)(smem + PX_SS) + w * 16;
  u16* F = (u16*)(p.ws + OFF_MIX + (size_t)T_ * 1024 * 2);
  const int ts = lane >> 3, ch = lane & 7;
#define V_LOAD4(Q, E4) { Q[0] = *(const uint4*)(vb + (size_t)(E4).x * 1024); Q[1] = *(const uint4*)(vb + (size_t)(E4).y * 1024); \
    Q[2] = *(const uint4*)(vb + (size_t)(E4).z * 1024); Q[3] = *(const uint4*)(vb + (size_t)(E4).w * 1024); }
#pragma unroll 1
  for (int rep = 0; rep < PROBE_V; rep++)
#pragma unroll 1
  for (int x = 0; x < 8; x++) {
    const unsigned char* vb = V + x * 128 + ch * 16;
#pragma unroll 1
    for (int grp = 0; grp < 2; grp++) {
      const int i = grp * 8 + ts;
      const int t = m0 + w * 16 + i;
      const int4* ep = (const int4*)(eb + i * PX_ROW);
      const float4* ap = (const float4*)(ab + i * PX_ROW);
      f32x2 acc[8];
#pragma unroll
      for (int k = 0; k < 8; k++) acc[k] = (f32x2){0.f, 0.f};
      uint4 qA[4], qB[4];
      int4 e4 = ep[0];
      V_LOAD4(qA, e4);
      e4 = ep[1];
      V_LOAD4(qB, e4);
#pragma unroll 1
      for (int pb = 0; pb < 32; pb += 2) {
#pragma unroll
        for (int half = 0; half < 2; half++) {
          const float4 a4 = ap[pb + half];
          const float av[4] = {a4.x, a4.y, a4.z, a4.w};
#pragma unroll
          for (int u = 0; u < 4; u++) {
            const uint4 qq = half ? qB[u] : qA[u];
            const f32x2 a2 = {av[u], av[u]};
            const unsigned wds[4] = {qq.x, qq.y, qq.z, qq.w};
#pragma unroll
            for (int k2 = 0; k2 < 4; k2++) {
              acc[2 * k2] = __builtin_elementwise_fma(a2, __builtin_amdgcn_cvt_pk_f32_fp8((int)wds[k2], false), acc[2 * k2]);
              acc[2 * k2 + 1] = __builtin_elementwise_fma(a2, __builtin_amdgcn_cvt_pk_f32_fp8((int)wds[k2], true), acc[2 * k2 + 1]);
            }
          }
          const int nx = pb + 2 + half;
          if (nx < 32) { const int4 en = ep[nx]; if (half) { V_LOAD4(qB, en); } else { V_LOAD4(qA, en); } }
        }
      }
      float ss = 0.f;
#pragma unroll
      for (int k = 0; k < 8; k++) ss = fmaf(acc[k][0], acc[k][0], fmaf(acc[k][1], acc[k][1], ss));
      ss += __int_as_float(__builtin_amdgcn_update_dpp(0, __float_as_int(ss), 0xB1, 0xF, 0xF, false));
      ss += __int_as_float(__builtin_amdgcn_update_dpp(0, __float_as_int(ss), 0x4E, 0xF, 0xF, false));
      ss += __int_as_float(__builtin_amdgcn_update_dpp(0, __float_as_int(ss), 0x141, 0xF, 0xF, false));
      if (rep < PROBE_V) {
        u16* fp = F + (size_t)t * 1024 + x * 128 + ch * 16;
        *(uint4*)(fp) = make_uint4(pack2(acc[0][0], acc[0][1]), pack2(acc[1][0], acc[1][1]), pack2(acc[2][0], acc[2][1]), pack2(acc[3][0], acc[3][1]));
        *(uint4*)(fp + 8) = make_uint4(pack2(acc[4][0], acc[4][1]), pack2(acc[5][0], acc[5][1]), pack2(acc[6][0], acc[6][1]), pack2(acc[7][0], acc[7][1]));
        if (ch == 0 && rep == 0) ssq[i] += ss;
      }
    }
  }
#undef V_LOAD4
  {
    const float* mod = (const float*)(p.ws + OFF_MOD);
    const int b = m0 >> 11;
    float4 fg2[4];
#pragma unroll
    for (int j = 0; j < 4; j++) {
      const int col = j * 256 + lane * 4;
      const float4 fg = *(const float4*)(p.post_ffn_g + col);
      const float4 g2 = ldmod(mod, b * 6144 + 5120 + col);
      fg2[j] = make_float4(fg.x * g2.x, fg.y * g2.y, fg.z * g2.z, fg.w * g2.w);
    }
#pragma unroll 2
    for (int i = 0; i < 16; i++) {
      const int t = m0 + w * 16 + i;
      const float rstd = rsqrtf(ssq[i] * (1.f / 1024.f) + 1e-6f);
#pragma unroll
      for (int j = 0; j < 4; j++) {
        const uint2 fq = *(const uint2*)(F + (size_t)t * 1024 + lane * 16 + j * 4);
        const float4 f = make_float4(bflo(fq.x), bfhi(fq.x), bflo(fq.y), bfhi(fq.y));
        const int col = j * 256 + lane * 4;
        const uint2 xq = *(const uint2*)((const u16*)(p.ws + OFF_X1) + (size_t)t * 1024 + col);
        const float4 x1 = make_float4(bflo(xq.x), bfhi(xq.x), bflo(xq.y), bfhi(xq.y));
        float4 o;
        o.x = x1.x + (f.x * rstd) * fg2[j].x; o.y = x1.y + (f.y * rstd) * fg2[j].y;
        o.z = x1.z + (f.z * rstd) * fg2[j].z; o.w = x1.w + (f.w * rstd) * fg2[j].w;
        *(float4*)(p.out + (size_t)t * 1024 + col) = o;
      }
    }
  }
}

DEV void phase3_tile(const Params& p, int mt, char* smem) {
  const int m0 = mt * 128;
  const u16* cat = (const u16*)(p.ws + OFF_HBUF) + (size_t)m0 * 1024;
  {
    const u16* wt = (const u16*)(p.ws + OFF_WTOUT);
    for (int rep = 0; rep < PROBE_G3; rep++)
    for (int nc = 0; nc < 4; nc++) {
      EpiStoreBf16 epi{(u16*)(p.ws + OFF_MIX) + (size_t)m0 * 1024, nc * 256};
      gemm_tile(cat, 1024, wt + (size_t)nc * 256 * 1024, 1024, 1024, smem, epi);
    }
  }
  __syncthreads();
  p3_rows1(p, m0);
#if STAGE >= 6
  __syncthreads();
  {
    const u16* wt = (const u16*)(p.ws + OFF_WTQ);
    for (int rep = 0; rep < PROBE_G3; rep++)
    for (int nc = 0; nc < 4; nc++) {
      EpiStoreBf16 epi{(u16*)(p.ws + OFF_QP) + (size_t)m0 * 1024, nc * 256};
      gemm_tile(cat, 1024, wt + (size_t)nc * 256 * 1024, 1024, 1024, smem, epi);
    }
  }
  __syncthreads();
  for (int rep = 0; rep < PROBE_ROUTE; rep++) p3_route(p, m0, smem);
  __syncthreads();
#endif
}

DEV void grid_barrier(unsigned* counter, unsigned& target) {
  asm volatile("s_waitcnt vmcnt(0)" ::: "memory");
  __syncthreads();
  if (threadIdx.x == 0) {
    __builtin_amdgcn_fence(__ATOMIC_RELEASE, "agent");
    asm volatile("s_waitcnt vmcnt(0)" ::: "memory");
    target += gridDim.x;
    __hip_atomic_fetch_add(counter, 1u, __ATOMIC_RELAXED, __HIP_MEMORY_SCOPE_AGENT);
    while (__hip_atomic_load(counter, __ATOMIC_RELAXED, __HIP_MEMORY_SCOPE_AGENT) < target) __builtin_amdgcn_s_sleep(1);
    __builtin_amdgcn_fence(__ATOMIC_ACQUIRE, "agent");
    asm volatile("s_waitcnt vmcnt(0)" ::: "memory");
  }
  __syncthreads();
}

#define XB_TMO      128
#define XB_XCNT(j)  (256  + 64 * (j))
#define XB_XSUB(j)  (1280 + 64 * (j))
#define XB_XGEN(j)  (2304 + 64 * (j))
#define XB_TOP      3328
#define XB_TOPGEN   3392
#define XB_SPIN_CAP (1u << 22)
DEV unsigned xb_ld(unsigned* p) { return __hip_atomic_load(p, __ATOMIC_RELAXED, __HIP_MEMORY_SCOPE_AGENT); }
DEV unsigned xb_add(unsigned* p, unsigned v) { return __hip_atomic_fetch_add(p, v, __ATOMIC_RELAXED, __HIP_MEMORY_SCOPE_AGENT); }
DEV unsigned xb_xcc_id() { return (unsigned)__builtin_amdgcn_s_getreg((3 << 11) | 20) & 0xFu; }
#define XB_SPIN(cond, bar) do { unsigned _sp = 0; while (cond) { __builtin_amdgcn_s_sleep(1); \
    if ((++_sp & 255u) == 0u) { if (xb_ld(&(bar)[XB_TMO])) break; if (_sp > XB_SPIN_CAP) { atomicAdd(&(bar)[XB_TMO], 1u); break; } } } } while (0)
struct XcdBarrier { unsigned* bar; unsigned x; unsigned* st; };
DEV void xcd_barrier_complete(unsigned* bar, unsigned x, unsigned& nloc, unsigned& nx) {
  const unsigned G = gridDim.x;
  unsigned sum, cnt, mine, sp = 0u;
  for (;;) {
    sum = 0u; cnt = 0u; mine = 0u;
#pragma unroll
    for (unsigned j = 0; j < 16; ++j) { const unsigned c = xb_ld(&bar[XB_XCNT(j)]); sum += c; cnt += (c > 0u) ? 1u : 0u; mine = (j == x) ? c : mine; }
    if (sum == G) break;
    __builtin_amdgcn_s_sleep(1);
    if ((++sp & 255u) == 0u) { if (xb_ld(&bar[XB_TMO])) break; if (sp > XB_SPIN_CAP) { atomicAdd(&bar[XB_TMO], 1u); break; } }
  }
  nloc = mine > 0u ? mine : 1u; nx = cnt > 0u ? cnt : 1u;
}
DEV void xcd_barrier(const XcdBarrier& b) {
  asm volatile("s_waitcnt vmcnt(0)" ::: "memory");
  __syncthreads();
  if (threadIdx.x == 0) {
    unsigned* bar = b.bar;
    __builtin_amdgcn_s_waitcnt(0);
    unsigned nloc = b.st[0], nx = b.st[1];
    if (nloc == 0u) { xcd_barrier_complete(bar, b.x, nloc, nx); b.st[0] = nloc; b.st[1] = nx; }
    const unsigned old = xb_add(&bar[XB_XSUB(b.x)], 1u);
    const unsigned gen = old / nloc;
    if (old + 1u == (gen + 1u) * nloc) {
      __builtin_amdgcn_fence(__ATOMIC_RELEASE, "agent");
      asm volatile("s_waitcnt vmcnt(0)" ::: "memory");
      const unsigned og = xb_add(&bar[XB_TOP], 1u);
      const unsigned tg = og / nx;
      if (og + 1u == (tg + 1u) * nx) xb_add(&bar[XB_TOPGEN], 1u);
      else XB_SPIN(xb_ld(&bar[XB_TOPGEN]) == tg, bar);
      __builtin_amdgcn_fence(__ATOMIC_ACQUIRE, "agent");
      xb_add(&bar[XB_XGEN(b.x)], 1u);
      asm volatile("s_waitcnt vmcnt(0)" ::: "memory");
    } else {
      XB_SPIN(xb_ld(&bar[XB_XGEN(b.x)]) == gen, bar);
      __builtin_amdgcn_fence(__ATOMIC_ACQUIRE, "agent");
      asm volatile("s_waitcnt vmcnt(0)" ::: "memory");
    }
  }
  __syncthreads();
}

__global__ void __launch_bounds__(NT) mega(Params p) {
  __shared__ __attribute__((aligned(16))) char smem[LDS_BYTES + 16];
  cg::grid_group grid = cg::this_grid();
  XcdBarrier xb; xb.bar = (unsigned*)(p.ws + OFF_XB); xb.x = xb_xcc_id(); xb.st = (unsigned*)(smem + LDS_BYTES);
  if (threadIdx.x == 0) { xb.st[0] = 0u; xb.st[1] = 0u; (void)xb_add(&xb.bar[XB_XCNT(xb.x)], 1u); }
  __syncthreads();
#if STAGE == 0
  {
    const size_t n4 = (size_t)T_ * 1024 / 4;
    for (size_t i = (size_t)blockIdx.x * NT + threadIdx.x; i < n4; i += (size_t)gridDim.x * NT) ((float4*)p.out)[i] = ((const float4*)p.x)[i];
  }
#endif
  phase_mod(p, smem);
  if (gridDim.x == 0x7fffffffu) grid.sync();
  xcd_barrier(xb);
#if PH(1)
  for (int rep = 0; rep < PROBE_HN; rep++) phase_hnorm(p);
#endif
#if PH(0)
  for (int rep = 0; rep < PROBE_P0; rep++) phase0(p, smem);
#endif
  xcd_barrier(xb);
#if STAGE >= 1 && PH(2)
  for (int rep = 0; rep < PROBE_P1; rep++) phase1(p, smem);
#endif
  xcd_barrier(xb);
#if STAGE >= 2 && PH(3)
  for (int rep = 0; rep < PROBE_SSDA; rep++)
  for (int it = blockIdx.x; it < 512; it += gridDim.x) { ssdA_item(p, it >> 5, (it >> 1) & 15, it & 1, smem); }
#endif
#if STAGE >= 4 && PH(4)
  for (int rep = 0; rep < PROBE_DSA; rep++)
  for (int k = 0; k < 4; k++) {
    const int i = blockIdx.x + k * gridDim.x;
    if (gridDim.x == 256) {
      const int rr = i & 255; const int b = rr & 15, a = rr >> 4;
      const int qt = (k == 0) ? a : (k == 1) ? 31 - a : (k == 2) ? 32 + a : 63 - a;
      dsa_item(p, b, qt, smem);
    }
  }
  if (gridDim.x != 256) { for (int i = blockIdx.x; i < 1024; i += gridDim.x) dsa_item(p, i & 15, 63 - (i >> 4), smem); }
#if STAGE >= 2
  xcd_barrier(xb);
#endif
  for (int it = blockIdx.x; it < 512; it += gridDim.x) ssdS_item(p, it >> 5, (it >> 2) & 7, it & 3);
#elif STAGE >= 2 && STAGE < 4
  {
    u16* cat = (u16*)(p.ws + OFF_HBUF);
    for (size_t i = (size_t)blockIdx.x * NT + threadIdx.x; i < (size_t)T_ * 64; i += (size_t)gridDim.x * NT) {
      const size_t t = i >> 6, cc = i & 63;
      *(uint4*)(cat + t * 1024 + cc * 8) = make_uint4(0, 0, 0, 0);
    }
  }
#endif
  xcd_barrier(xb);
#if STAGE >= 2 && PH(5)
  for (int rep = 0; rep < PROBE_SSDB; rep++)
  for (int it = blockIdx.x; it < 256; it += gridDim.x) ssdB_item(p, it >> 4, it & 15, smem);
#endif
  xcd_barrier(xb);
#if STAGE >= 3 && PH(6)
  if (gridDim.x == 256) {
    if (blockIdx.x & 1) convert_fp8_rows(p.peer_v, p.ws + OFF_V, (float*)(p.ws + OFF_SV));
    phase3_tile(p, blockIdx.x, smem);
    if (!(blockIdx.x & 1)) convert_fp8_rows(p.peer_v, p.ws + OFF_V, (float*)(p.ws + OFF_SV));
    xcd_barrier(xb);
    p3_ustage(p, blockIdx.x * 128, smem);
    xcd_barrier(xb);
    p3_vstage(p, blockIdx.x * 128, smem);
  } else {
    convert_fp8_rows(p.peer_v, p.ws + OFF_V, (float*)(p.ws + OFF_SV));
    xcd_barrier(xb);
    for (int mt = blockIdx.x; mt < 256; mt += gridDim.x) { phase3_tile(p, mt, smem); p3_ustage(p, mt * 128, smem); p3_vstage(p, mt * 128, smem); __syncthreads(); }
  }
#endif
}

extern "C" void kernel_launch(void* const* d_in, const int* in_sizes, int n_in, void* d_out, int out_size, void* d_ws, size_t ws_size, hipStream_t stream) {
  static int grid_blocks = 0;
  if (!grid_blocks) {
    int dev = 0, cus = 0, per_cu = 0;
    hipGetDevice(&dev);
    hipDeviceGetAttribute(&cus, hipDeviceAttributeMultiprocessorCount, dev);
    hipOccupancyMaxActiveBlocksPerMultiprocessor(&per_cu, mega, NT, 0);
    if (per_cu < 1) { fprintf(stderr, "occupancy query says %d blocks/CU\n", per_cu); per_cu = 1; }
    grid_blocks = cus;
    if (ws_size < WS_END) fprintf(stderr, "workspace too small: %zu < %zu\n", ws_size, (size_t)WS_END);
  }
  Params p{};
  p.x = (const float*)d_in[0]; p.c = (const float*)d_in[1]; p.pos = (const int*)d_in[2]; p.w_ada = (const float*)d_in[3]; p.b_ada = (const float*)d_in[4];
  p.pre_mix_g = (const float*)d_in[5]; p.post_mix_g = (const float*)d_in[6]; p.w_in = (const float*)d_in[7]; p.conv_w = (const float*)d_in[8]; p.conv_b = (const float*)d_in[9];
  p.dt_bias = (const float*)d_in[10]; p.a_log = (const float*)d_in[11]; p.d_skip = (const float*)d_in[12]; p.ssd_norm_g = (const float*)d_in[13]; p.w_out = (const float*)d_in[14];
  p.pre_ffn_g = (const float*)d_in[15]; p.post_ffn_g = (const float*)d_in[16]; p.w_q = (const float*)d_in[17]; p.sub_keys = (const float*)d_in[18]; p.peer_u = (const float*)d_in[19];
  p.peer_v = (const float*)d_in[20]; p.out = (float*)d_out; p.ws = (unsigned char*)d_ws;
  if (hipMemsetAsync((unsigned char*)d_ws + OFF_XB, 0, 16384, stream) != hipSuccess) fprintf(stderr, "memset of the barrier words failed\n");
  void* args[] = {&p};
  hipError_t e = hipLaunchCooperativeKernel((void*)mega, dim3(grid_blocks), dim3(NT), args, 0, stream);
  if (e != hipSuccess) fprintf(stderr, "cooperative launch failed: %s (grid %d)\n", hipGetErrorString(e), grid_blocks);
}
```

```cpp
#include <hip/hip_runtime.h>
#include <hip/hip_cooperative_groups.h>
#include <stdint.h>
#include <stdio.h>
namespace cg = cooperative_groups;

#ifndef STAGE
#define STAGE 99
#endif
#ifndef ONLY
#define ONLY -1
#endif
#define PH(n) (ONLY < 0 || ONLY == (n))
#ifndef PROBE_P0
#define PROBE_P0 1
#endif
#ifndef PROBE_HN
#define PROBE_HN 1
#endif
#ifndef PROBE_P1
#define PROBE_P1 1
#endif
#ifndef PROBE_SSDA
#define PROBE_SSDA 1
#endif
#ifndef PROBE_DSA
#define PROBE_DSA 1
#endif
#ifndef PROBE_SSDB
#define PROBE_SSDB 1
#endif
#ifndef PROBE_UHOT
#define PROBE_UHOT 0
#endif
#ifndef PROBE_VHOT
#define PROBE_VHOT 0
#endif
#ifndef PROBE_DSA_SC
#define PROBE_DSA_SC 1
#endif
#ifndef PROBE_DSA_BIS
#define PROBE_DSA_BIS 1
#endif
#ifndef PROBE_DSA_ATT
#define PROBE_DSA_ATT 1
#endif
#ifndef PROBE_U
#define PROBE_U 1
#endif
#ifndef PROBE_V
#define PROBE_V 1
#endif
#ifndef PROBE_ROUTE
#define PROBE_ROUTE 1
#endif
#ifndef PROBE_G3
#define PROBE_G3 1
#endif

#define NT 512
typedef unsigned short u16;
typedef __attribute__((ext_vector_type(8))) short bf16x8;
typedef __attribute__((ext_vector_type(16))) float f32x16;
typedef __attribute__((ext_vector_type(16))) unsigned u32x16;

#define DEV __device__ __forceinline__

constexpr int B_ = 16, S_ = 2048, D_ = 1024, T_ = B_ * S_;
constexpr int NPROJ = 2896, NPAD = 3072;
constexpr int SV_ = 2048 + 64;
constexpr float NEG_INF = -__builtin_huge_valf();

constexpr size_t OFF_MOD = 0;
constexpr size_t OFF_COS = OFF_MOD + 786432;
constexpr size_t OFF_SIN = OFF_COS + (size_t)T_ * 32 * 4;
constexpr size_t OFF_HBUF = OFF_SIN + (size_t)T_ * 32 * 4;
constexpr size_t OFF_WTIN = OFF_HBUF + (size_t)T_ * 1024 * 2;
constexpr size_t OFF_WTOUT = OFF_WTIN + (size_t)NPAD * 1024 * 2;
constexpr size_t OFF_WTQ = OFF_WTOUT + (size_t)1024 * 1024 * 2;
constexpr size_t OFF_SK = OFF_WTQ + (size_t)1024 * 1024 * 2;
constexpr size_t OFF_U = OFF_SK + (size_t)16 * 128 * 64 * 2;
constexpr size_t OFF_V = OFF_U + (size_t)16384 * 1024;
constexpr size_t OFF_SU = OFF_V + (size_t)16384 * 1024;
constexpr size_t OFF_SV = OFF_SU + (size_t)16384 * 4;
constexpr size_t OFF_Q = OFF_SV + (size_t)16384 * 4;
constexpr size_t OFF_QI = OFF_Q + (size_t)T_ * 512 * 2;
constexpr size_t OFF_XBC = OFF_QI + (size_t)T_ * 512 * 2;
constexpr size_t OFF_SIN_ST = OFF_XBC;
constexpr size_t OFF_MIX = OFF_Q;
constexpr size_t OFF_K = OFF_XBC + (size_t)T_ * 1024 * 2;
constexpr size_t OFF_VT = OFF_K + (size_t)T_ * 128 * 2;
constexpr size_t OFF_KI = OFF_VT + (size_t)16 * 2 * 64 * SV_ * 2;
constexpr size_t OFF_WI = OFF_KI + (size_t)T_ * 64 * 2;
constexpr size_t OFF_DT = OFF_WI + (size_t)T_ * 8 * 4;
constexpr size_t OFF_Z = OFF_DT + (size_t)T_ * 8 * 4;
constexpr size_t OFF_EIDX = OFF_Z;
constexpr size_t OFF_GATE = OFF_Z + (size_t)T_ * 128 * 4;
constexpr size_t OFF_ST = OFF_Z + (size_t)T_ * 512 * 2;
constexpr size_t OFF_YP_ = OFF_ST + (size_t)16 * 16 * 8 * 64 * 128 * 4 + (size_t)16 * 16 * 8 * 128 * 4;
constexpr size_t OFF_X1 = OFF_ST;
constexpr size_t OFF_QP = OFF_YP_;
constexpr size_t OFF_ACUM = OFF_ST + (size_t)16 * 16 * 8 * 64 * 128 * 4;
constexpr size_t OFF_YP = OFF_ACUM + (size_t)16 * 16 * 8 * 128 * 4;
static_assert(OFF_YP_ == OFF_YP, "alias");
constexpr size_t OFF_CC = OFF_YP + (size_t)T_ * 512 * 4;
constexpr size_t OFF_BAR = OFF_CC + (size_t)T_ * 256 * 2;
constexpr size_t OFF_XB = OFF_BAR + 256;
constexpr size_t OFF_H2Q = OFF_XB + 16384;
constexpr size_t OFF_SH = OFF_H2Q + (size_t)T_ * 1024;
constexpr size_t WS_END = OFF_SH + (size_t)T_ * 4;

constexpr int LDS_BYTES = 156672;

struct Params {
  const float* x; const float* c; const int* pos; const float* w_ada; const float* b_ada;
  const float* pre_mix_g; const float* post_mix_g; const float* w_in; const float* conv_w; const float* conv_b;
  const float* dt_bias; const float* a_log; const float* d_skip; const float* ssd_norm_g; const float* w_out;
  const float* pre_ffn_g; const float* post_ffn_g; const float* w_q; const float* sub_keys; const float* peer_u;
  const float* peer_v; float* out; unsigned char* ws;
};

__constant__ float c_inv_freq[32] = {
  1.000000000e+00f, 7.498942614e-01f, 5.623413324e-01f, 4.216965139e-01f, 3.162277639e-01f, 2.371373773e-01f, 1.778279394e-01f, 1.333521307e-01f,
  1.000000015e-01f, 7.498941571e-02f, 5.623413250e-02f, 4.216965288e-02f, 3.162277490e-02f, 2.371373773e-02f, 1.778279431e-02f, 1.333521493e-02f,
  9.999999776e-03f, 7.498941850e-03f, 5.623413250e-03f, 4.216964822e-03f, 3.162277630e-03f, 2.371373586e-03f, 1.778279431e-03f, 1.333521446e-03f,
  1.000000047e-03f, 7.498942432e-04f, 5.623413017e-04f, 4.216965172e-04f, 3.162277571e-04f, 2.371373703e-04f, 1.778279402e-04f, 1.333521504e-04f};

DEV int opaque_tid() { int t = threadIdx.x; asm volatile("" : "+v"(t)); return t; }
DEV u16 f2bf(float f) { unsigned u = __float_as_uint(f); u += 0x7FFFu + ((u >> 16) & 1u); return (u16)(u >> 16); }
DEV float bf2f(u16 h) { return __uint_as_float(((unsigned)h) << 16); }
DEV unsigned pack2(float a, float b) { unsigned r; asm("v_cvt_pk_bf16_f32 %0, %1, %2" : "=v"(r) : "v"(a), "v"(b)); return r; }
DEV float bflo(unsigned u) { return __uint_as_float(u << 16); }
DEV float bfhi(unsigned u) { return __uint_as_float(u & 0xFFFF0000u); }
DEV float wave_sum(float v) {
#pragma unroll
  for (int o = 32; o > 0; o >>= 1) v += __shfl_xor(v, o);
  return v;
}
#define DPP_ADD(v, ctrl, rmask) v += __int_as_float(__builtin_amdgcn_update_dpp(0, __float_as_int(v), ctrl, rmask, 0xF, false))
DEV float wave_sum63(float v) {
  DPP_ADD(v, 0xB1, 0xF);
  DPP_ADD(v, 0x4E, 0xF);
  DPP_ADD(v, 0x141, 0xF);
  DPP_ADD(v, 0x140, 0xF);
  DPP_ADD(v, 0x142, 0xA);
  DPP_ADD(v, 0x143, 0xC);
  return v;
}
DEV f32x16 mfma32(bf16x8 a, bf16x8 b, f32x16 c) { return __builtin_amdgcn_mfma_f32_32x32x16_bf16(a, b, c, 0, 0, 0); }
DEV f32x16 zero16() { f32x16 z;
#pragma unroll
  for (int i = 0; i < 16; i++) z[i] = 0.f;
  return z; }
DEV int rowmap(int reg, int hh) { return (reg & 3) + 8 * (reg >> 2) + 4 * hh; }
DEV float silu_f(float v) { return v / (1.f + expf(-v)); }
DEV unsigned ordkey(float f) { unsigned b = __float_as_uint(f); unsigned m = (unsigned)((int)b >> 31) | 0x80000000u; return b ^ m; }
DEV bf16x8 mk_frag(uint2 lo, uint2 hi) { union { uint4 u; bf16x8 v; } t; t.u = make_uint4(lo.x, lo.y, hi.x, hi.y); return t.v; }
DEV bf16x8 pack_frag(const f32x16& v, int base) {
  union { uint4 u; bf16x8 f; } t;
  t.u = make_uint4(pack2(v[base + 0], v[base + 1]), pack2(v[base + 2], v[base + 3]), pack2(v[base + 4], v[base + 5]), pack2(v[base + 6], v[base + 7]));
  return t.f;
}

DEV float4 ldmod(const float* mod, int off) {
  const float4 a = *(const float4*)(mod + off), b = *(const float4*)(mod + 98304 + off);
  return make_float4(a.x + b.x, a.y + b.y, a.z + b.z, a.w + b.w);
}
DEV void phase_mod(const Params& p, char* smem) {
  float* s_silu = (float*)smem;
  float* s_red = (float*)(smem + 32768);
  float* mod = (float*)(p.ws + OFF_MOD);
  const int tid = threadIdx.x;
  for (int item = blockIdx.x; item < 192; item += gridDim.x) {
    const int cgp = item >> 1, ks = item & 1;
    __syncthreads();
    for (int e = tid; e < 8192; e += NT) { int b = e >> 9, i = e & 511; s_silu[i * 16 + b] = silu_f(p.c[b * 1024 + ks * 512 + i]); }
    __syncthreads();
    const int kg = tid >> 6, col = tid & 63;
    float acc[16];
#pragma unroll
    for (int b = 0; b < 16; b++) acc[b] = 0.f;
    const float* w = p.w_ada + (size_t)(ks * 512 + kg * 64) * 6144 + cgp * 64 + col;
#pragma unroll 1
    for (int i0 = 0; i0 < 64; i0 += 16) {
      float wreg[16];
#pragma unroll
      for (int u = 0; u < 16; u++) wreg[u] = w[(size_t)(i0 + u) * 6144];
#pragma unroll
      for (int u = 0; u < 16; u++) {
        const float wv = wreg[u];
        const float4* sp = (const float4*)(s_silu + (kg * 64 + i0 + u) * 16);
        float4 s0 = sp[0], s1 = sp[1], s2 = sp[2], s3 = sp[3];
        acc[0] += s0.x * wv; acc[1] += s0.y * wv; acc[2] += s0.z * wv; acc[3] += s0.w * wv;
        acc[4] += s1.x * wv; acc[5] += s1.y * wv; acc[6] += s1.z * wv; acc[7] += s1.w * wv;
        acc[8] += s2.x * wv; acc[9] += s2.y * wv; acc[10] += s2.z * wv; acc[11] += s2.w * wv;
        acc[12] += s3.x * wv; acc[13] += s3.y * wv; acc[14] += s3.z * wv; acc[15] += s3.w * wv;
      }
    }
#pragma unroll
    for (int b = 0; b < 16; b++) s_red[(kg * 64 + col) * 16 + b] = acc[b];
    __syncthreads();
    for (int e = tid; e < 1024; e += NT) {
      int cc = e >> 4, b = e & 15; float sum = 0.f;
#pragma unroll
      for (int k = 0; k < 8; k++) sum += s_red[(k * 64 + cc) * 16 + b];
      int j = cgp * 64 + cc;
      mod[ks * 98304 + b * 6144 + j] = sum + (ks == 0 ? p.b_ada[j] : 0.f);
    }
  }
}

DEV int remap_col(int n) {
  if (n < 1344) return n;
  if (n < 1352) return 2880 + (n - 1344);
  if (n < 2888) return n - 8;
  return n;
}

DEV void transpose_convert(const float* __restrict__ src, int N, u16* __restrict__ dst, bool remap, char* smem) {
  float* tile = (float*)smem;
  const int tid = threadIdx.x;
  const int ntn = (N + 63) >> 6;
  const int nitems = 16 * ntn;
  for (int item = blockIdx.x; item < nitems; item += gridDim.x) {
    const int kt = item / ntn, nt = item - kt * ntn;
    const int k0 = kt * 64, n0 = nt * 64;
    __syncthreads();
    for (int e = tid; e < 4096; e += NT) {
      int r = e >> 6, ci = e & 63, n = n0 + ci;
      tile[r * 65 + ci] = (n < N) ? src[(size_t)(k0 + r) * N + n] : 0.f;
    }
    __syncthreads();
    for (int e = tid; e < 4096; e += NT) {
      int nn = e >> 6, kk = e & 63, n = n0 + nn;
      if (n < N) { int n2 = remap ? remap_col(n) : n; dst[(size_t)n2 * 1024 + k0 + kk] = f2bf(tile[kk * 65 + nn]); }
    }
  }
}

DEV void convert_bf16(const float* __restrict__ src, u16* __restrict__ dst, size_t n8) {
  const size_t g = (size_t)blockIdx.x * NT + threadIdx.x, gs = (size_t)gridDim.x * NT;
  for (size_t i = g; i < n8; i += gs) {
    const float4 a = ((const float4*)src)[2 * i], b = ((const float4*)src)[2 * i + 1];
    ((uint4*)dst)[i] = make_uint4(pack2(a.x, a.y), pack2(a.z, a.w), pack2(b.x, b.y), pack2(b.z, b.w));
  }
}

DEV void convert_fp8_rows(const float* __restrict__ src, unsigned char* __restrict__ dst, float* __restrict__ scl) {
  const int tid_ = opaque_tid(); const int lane = tid_ & 63, wave = __builtin_amdgcn_readfirstlane(tid_ >> 6);
  for (int e0 = ((blockIdx.x >> 1) * 8 + wave) * 4 + (blockIdx.x & 1) * 8192; e0 < 8192 + (blockIdx.x & 1) * 8192; e0 += (gridDim.x >> 1) * 32) {
    float4 v[4][4];
#pragma unroll
    for (int u = 0; u < 4; u++)
#pragma unroll
      for (int j = 0; j < 4; j++) v[u][j] = *(const float4*)(src + (size_t)(e0 + u) * 1024 + j * 256 + lane * 4);
#pragma unroll
    for (int u = 0; u < 4; u++) {
      float mx = 0.f;
#pragma unroll
      for (int j = 0; j < 4; j++) mx = fmaxf(mx, fmaxf(fmaxf(fabsf(v[u][j].x), fabsf(v[u][j].y)), fmaxf(fabsf(v[u][j].z), fabsf(v[u][j].w))));
#pragma unroll
      for (int o = 32; o > 0; o >>= 1) mx = fmaxf(mx, __shfl_xor(mx, o));
      const float inv = (mx > 0.f) ? 384.f / mx : 0.f;
      int wd[4];
#pragma unroll
      for (int j = 0; j < 4; j++) {
        int t = 0;
        t = __builtin_amdgcn_cvt_pk_fp8_f32(v[u][j].x * inv, v[u][j].y * inv, t, false);
        t = __builtin_amdgcn_cvt_pk_fp8_f32(v[u][j].z * inv, v[u][j].w * inv, t, true);
        wd[j] = t;
      }
      *(uint4*)(dst + (size_t)(e0 + u) * 1024 + lane * 16) = make_uint4((unsigned)wd[0], (unsigned)wd[1], (unsigned)wd[2], (unsigned)wd[3]);
      if (lane == 0) scl[e0 + u] = mx * (1.f / 384.f);
    }
  }
}

DEV unsigned pack_i8x4(float a, float b, float c, float d) {
  const int ia = (int)rintf(a), ib = (int)rintf(b), ic = (int)rintf(c), id = (int)rintf(d);
  return (unsigned)(ia & 255) | ((unsigned)(ib & 255) << 8) | ((unsigned)(ic & 255) << 16) | ((unsigned)id << 24);
}
DEV void convert_i8_rows(const float* __restrict__ src, unsigned char* __restrict__ dst, float* __restrict__ scl) {
  const int tid_ = opaque_tid(); const int lane = tid_ & 63, wave = __builtin_amdgcn_readfirstlane(tid_ >> 6);
  for (int e0 = ((blockIdx.x >> 1) * 8 + wave) * 4 + (blockIdx.x & 1) * 8192; e0 < 8192 + (blockIdx.x & 1) * 8192; e0 += (gridDim.x >> 1) * 32) {
    float4 v[4][4];
#pragma unroll
    for (int u = 0; u < 4; u++)
#pragma unroll
      for (int j = 0; j < 4; j++) v[u][j] = *(const float4*)(src + (size_t)(e0 + u) * 1024 + j * 256 + lane * 4);
#pragma unroll
    for (int u = 0; u < 4; u++) {
      float mx = 0.f;
#pragma unroll
      for (int j = 0; j < 4; j++) mx = fmaxf(mx, fmaxf(fmaxf(fabsf(v[u][j].x), fabsf(v[u][j].y)), fmaxf(fabsf(v[u][j].z), fabsf(v[u][j].w))));
#pragma unroll
      for (int o = 32; o > 0; o >>= 1) mx = fmaxf(mx, __shfl_xor(mx, o));
      const float inv = (mx > 0.f) ? 127.f / mx : 0.f;
      unsigned wd[4];
#pragma unroll
      for (int j = 0; j < 4; j++) wd[j] = pack_i8x4(v[u][j].x * inv, v[u][j].y * inv, v[u][j].z * inv, v[u][j].w * inv);
      *(uint4*)(dst + (size_t)(e0 + u) * 1024 + lane * 16) = make_uint4(wd[0], wd[1], wd[2], wd[3]);
      if (lane == 0) scl[e0 + u] = mx * (1.f / 127.f);
    }
  }
}

DEV void phase0(const Params& p, char* smem) {
  {
    float* cosT = (float*)(p.ws + OFF_COS); float* sinT = (float*)(p.ws + OFF_SIN);
    const int g = blockIdx.x * NT + threadIdx.x, gs = gridDim.x * NT;
    for (int e = g; e < T_ * 32; e += gs) {
      int t = e >> 5, j = e & 31;
      float ang = (float)p.pos[t] * c_inv_freq[j];
      double rev = (double)ang * 0.15915494309189533577;
      rev -= rint(rev);
      float fr = (float)rev;
      cosT[e] = __builtin_amdgcn_cosf(fr);
      sinT[e] = __builtin_amdgcn_sinf(fr);
    }
  }
  transpose_convert(p.w_in, NPROJ, (u16*)(p.ws + OFF_WTIN), true, smem);
  {
    uint4* z = (uint4*)(p.ws + OFF_WTIN + (size_t)NPROJ * 1024 * 2);
    const int n = (NPAD - NPROJ) * 1024 * 2 / 16;
    for (int i = blockIdx.x * NT + threadIdx.x; i < n; i += gridDim.x * NT) z[i] = make_uint4(0, 0, 0, 0);
  }
  transpose_convert(p.w_out, 1024, (u16*)(p.ws + OFF_WTOUT), false, smem);
  transpose_convert(p.w_q, 1024, (u16*)(p.ws + OFF_WTQ), false, smem);
  convert_bf16(p.sub_keys, (u16*)(p.ws + OFF_SK), (size_t)16 * 128 * 64 / 8);
}

DEV void phase_hnorm(const Params& p) {
  const int tid_ = opaque_tid(); const int lane = tid_ & 63, wave = __builtin_amdgcn_readfirstlane(tid_ >> 6);
  const float* mod = (const float*)(p.ws + OFF_MOD);
  u16* h = (u16*)(p.ws + OFF_HBUF);
  for (int t0 = (blockIdx.x * 8 + wave) * 16; t0 < T_; t0 += gridDim.x * 128) {
    const int b = t0 >> 11;
    float4 gm[4], sh[4];
#pragma unroll
    for (int i = 0; i < 4; i++) {
      const int col = (i * 64 + lane) * 4;
      const float4 g = *(const float4*)(p.pre_mix_g + col);
      const float4 sc = ldmod(mod, b * 6144 + 1024 + col);
      sh[i] = ldmod(mod, b * 6144 + col);
      gm[i] = make_float4(g.x * (1.f + sc.x), g.y * (1.f + sc.y), g.z * (1.f + sc.z), g.w * (1.f + sc.w));
    }
#pragma unroll 2
    for (int r_ = 0; r_ < 16; r_++) {
      const int t = t0 + r_;
      const float4* xr = (const float4*)(p.x + (size_t)t * 1024);
      float4 v[4]; float ss = 0.f;
#pragma unroll
      for (int i = 0; i < 4; i++) { v[i] = xr[i * 64 + lane]; ss += v[i].x * v[i].x + v[i].y * v[i].y + v[i].z * v[i].z + v[i].w * v[i].w; }
      ss = wave_sum(ss);
      const float rstd = rsqrtf(ss * (1.f / 1024.f) + 1e-6f);
#pragma unroll
      for (int i = 0; i < 4; i++) {
        const int col = (i * 64 + lane) * 4;
        const float y0 = (v[i].x * rstd) * gm[i].x + sh[i].x, y1 = (v[i].y * rstd) * gm[i].y + sh[i].y;
        const float y2 = (v[i].z * rstd) * gm[i].z + sh[i].z, y3 = (v[i].w * rstd) * gm[i].w + sh[i].w;
        *(uint2*)(h + (size_t)t * 1024 + col) = make_uint2(pack2(y0, y1), pack2(y2, y3));
      }
    }
  }
}

constexpr int G_ROWB = 144;
constexpr int G_ABYTES = 128 * G_ROWB;
constexpr int G_STAGE = (128 + 256) * G_ROWB;
constexpr int G_SROW = 68;

template <class Epi>
DEV void gemm_tile(const u16* __restrict__ A, int lda, const u16* __restrict__ Bt, int ldb, int K, char* smem, Epi& epi) {
  const int tid = opaque_tid(), lane = tid & 63, wave = __builtin_amdgcn_readfirstlane(tid >> 6), wm = wave >> 2, wn = wave & 3;
  const int r = lane & 31, hh = lane >> 5;
  f32x16 acc00 = zero16(), acc01 = zero16(), acc10 = zero16(), acc11 = zero16();
  uint4 pa0, pa1, pb0, pb1, pb2, pb3;
  uint4 qa0, qa1, qb0, qb1, qb2, qb3;
  const int crow = tid >> 3, ckc = tid & 7;
  const u16* Ap = A + (size_t)crow * lda + ckc * 8;
  const u16* Bp = Bt + (size_t)crow * ldb + ckc * 8;
  const size_t a64 = (size_t)64 * lda, b64 = (size_t)64 * ldb;
  const int loff = crow * G_ROWB + ckc * 16;
#define G_LOAD(S, k0) { S##a0 = *(const uint4*)(Ap + (k0)); S##a1 = *(const uint4*)(Ap + a64 + (k0)); \
    S##b0 = *(const uint4*)(Bp + (k0)); S##b1 = *(const uint4*)(Bp + b64 + (k0)); S##b2 = *(const uint4*)(Bp + 2 * b64 + (k0)); S##b3 = *(const uint4*)(Bp + 3 * b64 + (k0)); }
#define G_STORE(S, buf) { char* sb_ = smem + (buf) * G_STAGE + loff; *(uint4*)(sb_) = S##a0; *(uint4*)(sb_ + 64 * G_ROWB) = S##a1; \
    char* sc_ = sb_ + G_ABYTES; *(uint4*)(sc_) = S##b0; *(uint4*)(sc_ + 64 * G_ROWB) = S##b1; *(uint4*)(sc_ + 128 * G_ROWB) = S##b2; *(uint4*)(sc_ + 192 * G_ROWB) = S##b3; }
#define G_COMPUTE(buf) { const char* sb = smem + (buf) * G_STAGE; _Pragma("unroll") for (int s = 0; s < 4; s++) { \
      const bf16x8 a0 = *(const bf16x8*)(sb + aoff + s * 32); const bf16x8 a1 = *(const bf16x8*)(sb + aoff + 32 * G_ROWB + s * 32); \
      const bf16x8 b0 = *(const bf16x8*)(sb + boff + s * 32); const bf16x8 b1 = *(const bf16x8*)(sb + boff + 32 * G_ROWB + s * 32); \
      acc00 = mfma32(a0, b0, acc00); acc01 = mfma32(a0, b1, acc01); acc10 = mfma32(a1, b0, acc10); acc11 = mfma32(a1, b1, acc11); } }
  const int nk = K >> 6;
  const int aoff = (wm * 64 + r) * G_ROWB + hh * 16;
  const int boff = G_ABYTES + (wn * 64 + r) * G_ROWB + hh * 16;
  G_LOAD(p, 0); G_LOAD(q, 64);
  __syncthreads();
  G_STORE(p, 0);
  __syncthreads();
  for (int kt = 0; kt < nk; kt += 2) {
    if (kt + 2 < nk) G_LOAD(p, (kt + 2) * 64);
    G_COMPUTE(0);
    G_STORE(q, 1);
    __syncthreads();
    if (kt + 3 < nk) G_LOAD(q, (kt + 3) * 64);
    G_COMPUTE(1);
    if (kt + 2 < nk) G_STORE(p, 0);
    __syncthreads();
  }
#undef G_LOAD
#undef G_STORE
#undef G_COMPUTE
  {
    float* stage = (float*)(smem + wave * (64 * G_SROW * 4));
#pragma unroll
    for (int reg = 0; reg < 16; reg++) {
      const int row = (reg & 3) + 8 * (reg >> 2) + 4 * hh;
      stage[row * G_SROW + r] = acc00[reg];
      stage[row * G_SROW + 32 + r] = acc01[reg];
      stage[(32 + row) * G_SROW + r] = acc10[reg];
      stage[(32 + row) * G_SROW + 32 + r] = acc11[reg];
    }
    epi.apply(stage, wm * 64, wn * 64, lane);
  }
}

DEV void ld16(const float* src, float* x) {
  const float4 a = *(const float4*)src, b = *(const float4*)(src + 4), c = *(const float4*)(src + 8), d = *(const float4*)(src + 12);
  x[0] = a.x; x[1] = a.y; x[2] = a.z; x[3] = a.w; x[4] = b.x; x[5] = b.y; x[6] = b.z; x[7] = b.w;
  x[8] = c.x; x[9] = c.y; x[10] = c.z; x[11] = c.w; x[12] = d.x; x[13] = d.y; x[14] = d.z; x[15] = d.w;
}
DEV void st16_bf(u16* dst, const float* x) {
  *(uint4*)dst = make_uint4(pack2(x[0], x[1]), pack2(x[2], x[3]), pack2(x[4], x[5]), pack2(x[6], x[7]));
  *(uint4*)(dst + 8) = make_uint4(pack2(x[8], x[9]), pack2(x[10], x[11]), pack2(x[12], x[13]), pack2(x[14], x[15]));
}
DEV void st16_f(float* dst, const float* x) {
  *(float4*)dst = make_float4(x[0], x[1], x[2], x[3]); *(float4*)(dst + 4) = make_float4(x[4], x[5], x[6], x[7]);
  *(float4*)(dst + 8) = make_float4(x[8], x[9], x[10], x[11]); *(float4*)(dst + 12) = make_float4(x[12], x[13], x[14], x[15]);
}

struct EpiInProj {
  const Params* p; int m0, n0;
  DEV void apply(const float* stage, int rbase, int cbase, int lane) { apply_s<G_SROW>(stage, rbase, cbase, lane); }
  template <int SROW>
  DEV void apply_s(const float* stage, int rbase, int cbase, int lane) {
    const int nb = n0 + cbase;
    unsigned char* ws = p->ws;
    const int tb = m0 + rbase;
    if (nb < 640 || (nb >= 768 && nb < 1344)) {
      u16* dst; int ld, cb;
      if (nb < 512) { dst = (u16*)(ws + OFF_Q); ld = 512; cb = nb; }
      else if (nb < 640) { dst = (u16*)(ws + OFF_K); ld = 128; cb = nb - 512; }
      else if (nb < 1280) { dst = (u16*)(ws + OFF_QI); ld = 512; cb = nb - 768; }
      else { dst = (u16*)(ws + OFF_KI); ld = 64; cb = 0; }
      const float* cosT = (const float*)(ws + OFF_COS); const float* sinT = (const float*)(ws + OFF_SIN);
      const int cg = lane & 1;
#pragma unroll 1
      for (int i = 0; i < 2; i++) {
        const int row = (lane >> 1) + 32 * i; const int t = tb + row;
        float x1[16], x2[16], cs[16], sn[16], o1[16], o2[16];
        ld16(stage + row * SROW + cg * 16, x1); ld16(stage + row * SROW + 32 + cg * 16, x2);
        ld16(cosT + (size_t)t * 32 + cg * 16, cs); ld16(sinT + (size_t)t * 32 + cg * 16, sn);
#pragma unroll
        for (int k = 0; k < 16; k++) { o1[k] = x1[k] * cs[k] - x2[k] * sn[k]; o2[k] = x2[k] * cs[k] + x1[k] * sn[k]; }
        st16_bf(dst + (size_t)t * ld + cb + cg * 16, o1); st16_bf(dst + (size_t)t * ld + cb + 32 + cg * 16, o2);
      }
    } else if (nb >= 640 && nb < 768) {
      u16* vt = (u16*)(ws + OFF_VT);
      const int kvh = (nb - 640) >> 6;
      const int b = tb >> 11, s0 = tb & 2047;
      u16* dp = vt + ((size_t)(b * 2 + kvh) * 64 + lane) * SV_ + s0;
#pragma unroll 1
      for (int q8 = 0; q8 < 8; q8++) {
        float x[8];
#pragma unroll
        for (int k = 0; k < 8; k++) x[k] = stage[(q8 * 8 + k) * SROW + lane];
        *(uint4*)(dp + q8 * 8) = make_uint4(pack2(x[0], x[1]), pack2(x[2], x[3]), pack2(x[4], x[5]), pack2(x[6], x[7]));
      }
    } else if (nb >= 1344 && nb < 2880) {
      u16* dst; int ld, cb;
      if (nb < 1856) { dst = (u16*)(ws + OFF_Z); ld = 512; cb = nb - 1344; }
      else { dst = (u16*)(ws + OFF_XBC); ld = 1024; cb = nb - 1856; }
      const int cg = lane & 1;
#pragma unroll 1
      for (int i = 0; i < 2; i++) {
        const int row = (lane >> 1) + 32 * i; const int t = tb + row;
        float x1[16], x2[16];
        ld16(stage + row * SROW + cg * 16, x1); ld16(stage + row * SROW + 32 + cg * 16, x2);
        st16_bf(dst + (size_t)t * ld + cb + cg * 16, x1); st16_bf(dst + (size_t)t * ld + cb + 32 + cg * 16, x2);
      }
    } else if (nb == 2880) {
      float* wi = (float*)(ws + OFF_WI); float* dtr = (float*)(ws + OFF_DT);
      const int t = tb + lane;
      float x[16];
      ld16(stage + lane * SROW, x);
      const float sc = 0.044194173824159216f;
      *(float4*)(wi + (size_t)t * 8) = make_float4(x[0] * sc, x[1] * sc, x[2] * sc, x[3] * sc);
      *(float4*)(wi + (size_t)t * 8 + 4) = make_float4(x[4] * sc, x[5] * sc, x[6] * sc, x[7] * sc);
      *(float4*)(dtr + (size_t)t * 8) = make_float4(x[8], x[9], x[10], x[11]);
      *(float4*)(dtr + (size_t)t * 8 + 4) = make_float4(x[12], x[13], x[14], x[15]);
    }
  }
};

struct EpiStoreF32 {
  float* dst; int n0;
  DEV void apply(const float* stage, int rbase, int cbase, int lane) {
    const int cg = lane & 1;
#pragma unroll 1
    for (int i = 0; i < 2; i++) {
      const int row = (lane >> 1) + 32 * i;
      float x1[16], x2[16];
      ld16(stage + row * G_SROW + cg * 16, x1); ld16(stage + row * G_SROW + 32 + cg * 16, x2);
      float* d = dst + (size_t)(rbase + row) * 1024 + n0 + cbase + cg * 16;
      st16_f(d, x1); st16_f(d + 32, x2);
    }
  }
};
struct EpiStoreBf16 {
  u16* dst; int n0;
  DEV void apply(const float* stage, int rbase, int cbase, int lane) {
    const int cg = lane & 1;
#pragma unroll 1
    for (int i = 0; i < 2; i++) {
      const int row = (lane >> 1) + 32 * i;
      float x1[16], x2[16];
      ld16(stage + row * G_SROW + cg * 16, x1); ld16(stage + row * G_SROW + 32 + cg * 16, x2);
      u16* d = dst + (size_t)(rbase + row) * 1024 + n0 + cbase + cg * 16;
      st16_bf(d, x1); st16_bf(d + 32, x2);
    }
  }
};

typedef __attribute__((ext_vector_type(4))) float f32x4v;
constexpr int P8_HT = 128 * 64;
constexpr int P8_SROW = 260;
DEV int p8_lds_byte(int r, int c) {
  const int st = (r >> 4) * 2 + (c >> 5), rr = r & 15, cc = c & 31, ob = rr * 64 + cc * 2;
  return st * 1024 + (ob ^ (((ob >> 9) & 1) << 5));
}
DEV void p8_stage_rc(int b, int& R, int& C) {
  const int st = b / 1024, sb = b % 1024, swz = sb ^ (((sb >> 9) & 1) << 5);
  R = (st >> 1) * 16 + swz / 64; C = (st & 1) * 32 + (swz % 64) / 2;
}
template <class Epi>
DEV void gemm256_8phase(const u16* __restrict__ A, const u16* __restrict__ Bt, int brow, int bcol, char* smem, Epi& epi) {
  constexpr int K = 1024, BK = 64, HALF = 128;
  u16* shm = (u16*)smem;
  const int tid = opaque_tid();
#define SA(b,h) (shm+((b)*2+(h))*P8_HT)
#define SB(b,h) (shm+(4+(b)*2+(h))*P8_HT)
#define P8STAGE(P,BASE,br,kt) do{ const long _g=(long)(br)*K+(long)(kt)*BK; \
    _Pragma("unroll") for(int _i=0;_i<2;++_i){ const int _b=tid*16+_i*8192; int _r,_c; p8_stage_rc(_b,_r,_c); \
      __builtin_amdgcn_global_load_lds((const unsigned*)(BASE+_g+(long)_r*K+_c), (__attribute__((address_space(3))) unsigned*)((char*)(P)+_b),16,0,0);} }while(0)
#define LDA(dst,b,h) _Pragma("unroll") for(int m=0;m<4;++m) _Pragma("unroll") for(int k=0;k<2;++k) \
    dst[m][k]=*reinterpret_cast<const bf16x8*>((char*)SA(b,h)+p8_lds_byte(wr*64+m*16+fr,k*32+fq*8))
#define LDB(dst,b,h) _Pragma("unroll") for(int n=0;n<2;++n) _Pragma("unroll") for(int k=0;k<2;++k) \
    dst[n][k]=*reinterpret_cast<const bf16x8*>((char*)SB(b,h)+p8_lds_byte(wc*32+n*16+fr,k*32+fq*8))
#define MMA(ai,bj,At,Bt_) do{ __builtin_amdgcn_s_setprio(1); \
    _Pragma("unroll") for(int m=0;m<4;++m) _Pragma("unroll") for(int n=0;n<2;++n) _Pragma("unroll") for(int k=0;k<2;++k) \
      acc[ai][bj][m][n]=__builtin_amdgcn_mfma_f32_16x16x32_bf16(At[m][k],Bt_[n][k],acc[ai][bj][m][n],0,0,0); \
    __builtin_amdgcn_s_setprio(0);}while(0)
#define WAIT_V(n) asm volatile("s_waitcnt vmcnt(" #n ")":::"memory")
#define WAIT_L(n) asm volatile("s_waitcnt lgkmcnt(" #n ")":::"memory")
#define BAR __builtin_amdgcn_s_barrier()
#define SCHED __builtin_amdgcn_sched_barrier(0)
  const int wid = __builtin_amdgcn_readfirstlane(tid >> 6), lane = tid & 63, wr = wid >> 2, wc = wid & 3, fr = lane & 15, fq = lane >> 4;
  f32x4v acc[2][2][4][2];
#pragma unroll
  for (int a_ = 0; a_ < 2; a_++)
#pragma unroll
    for (int b_ = 0; b_ < 2; b_++)
#pragma unroll
      for (int m = 0; m < 4; m++)
#pragma unroll
        for (int n = 0; n < 2; n++) acc[a_][b_][m][n] = (f32x4v){0.f, 0.f, 0.f, 0.f};
  bf16x8 At[4][2], B0[2][2], B1[2][2];
  constexpr int nt = K / BK;
  asm volatile("s_waitcnt vmcnt(0) lgkmcnt(0)" ::: "memory");
  __syncthreads();
  P8STAGE(SB(0,0),Bt,bcol,0); P8STAGE(SA(0,0),A,brow,0);
  P8STAGE(SB(0,1),Bt,bcol+HALF,0); P8STAGE(SA(0,1),A,brow+HALF,0);
  if(wr==1)BAR;
  WAIT_V(4); BAR;
  P8STAGE(SB(1,0),Bt,bcol,1); P8STAGE(SA(1,0),A,brow,1); P8STAGE(SB(1,1),Bt,bcol+HALF,1);
  WAIT_V(6); BAR;
#pragma unroll 1
  for(int t=0;t<nt-2;t+=2){
    LDB(B0,0,0); SCHED; LDA(At,0,0); P8STAGE(SA(1,1),A,brow+HALF,t+1);
    WAIT_L(8); BAR; WAIT_L(0); MMA(0,0,At,B0); BAR; SCHED;
    LDB(B1,0,1); P8STAGE(SB(0,0),Bt,bcol,t+2);
    BAR; WAIT_L(0); MMA(0,1,At,B1); BAR;
    LDA(At,0,1); P8STAGE(SA(0,0),A,brow,t+2);
    BAR; WAIT_L(0); MMA(1,0,At,B0); BAR; SCHED;
    P8STAGE(SB(0,1),Bt,bcol+HALF,t+2);
    WAIT_V(6); BAR; MMA(1,1,At,B1); BAR;
    LDB(B0,1,0); SCHED; LDA(At,1,0); P8STAGE(SA(0,1),A,brow+HALF,t+2);
    WAIT_L(8); BAR; WAIT_L(0); MMA(0,0,At,B0); BAR; SCHED;
    LDB(B1,1,1); P8STAGE(SB(1,0),Bt,bcol,t+3);
    BAR; WAIT_L(0); MMA(0,1,At,B1); BAR;
    LDA(At,1,1); P8STAGE(SA(1,0),A,brow,t+3);
    BAR; WAIT_L(0); MMA(1,0,At,B0); BAR; SCHED;
    P8STAGE(SB(1,1),Bt,bcol+HALF,t+3);
    WAIT_V(6); BAR; MMA(1,1,At,B1); BAR;
  }
  { LDB(B0,0,0); LDA(At,0,0); P8STAGE(SA(1,1),A,brow+HALF,nt-1);
    BAR; WAIT_L(0); MMA(0,0,At,B0); BAR;
    LDB(B1,0,1); BAR; WAIT_L(0); MMA(0,1,At,B1); BAR;
    LDA(At,0,1); WAIT_V(4); BAR; WAIT_L(0); MMA(1,0,At,B0); MMA(1,1,At,B1); BAR; }
  { LDB(B0,1,0); LDA(At,1,0); WAIT_V(2); BAR; WAIT_L(0); MMA(0,0,At,B0); BAR;
    LDB(B1,1,1); WAIT_V(0); BAR; WAIT_L(0); MMA(0,1,At,B1); BAR;
    LDA(At,1,1); BAR; WAIT_L(0); MMA(1,0,At,B0); MMA(1,1,At,B1); BAR; }
  if(wr==0)BAR;
  float* img = (float*)smem;
#pragma unroll
  for (int ai = 0; ai < 2; ai++) {
    __syncthreads();
#pragma unroll
    for (int bj = 0; bj < 2; bj++)
#pragma unroll
      for (int m = 0; m < 4; m++)
#pragma unroll
        for (int n = 0; n < 2; n++)
#pragma unroll
          for (int j = 0; j < 4; j++)
            img[(wr * 64 + m * 16 + fq * 4 + j) * P8_SROW + bj * HALF + wc * 32 + n * 16 + fr] = acc[ai][bj][m][n][j];
    __syncthreads();
    epi.template apply_s<P8_SROW>(img + (wid >> 2) * 64 * P8_SROW + (wid & 3) * 64, ai * 128 + (wid >> 2) * 64, (wid & 3) * 64, lane);
  }
  __syncthreads();
#undef SA
#undef SB
#undef P8STAGE
#undef LDA
#undef LDB
#undef MMA
#undef WAIT_V
#undef WAIT_L
#undef BAR
#undef SCHED
}

DEV void phase1(const Params& p, char* smem) {
  const u16* h = (const u16*)(p.ws + OFF_HBUF);
  const u16* wt = (const u16*)(p.ws + OFF_WTIN);
  if (blockIdx.x & 1) convert_i8_rows(p.peer_u, p.ws + OFF_U, (float*)(p.ws + OFF_SU));
  const int ntiles = 128 * 12;
  for (int tile = blockIdx.x; tile < ntiles; tile += gridDim.x) {
    const int mt = tile % 128, nt = tile / 128;
    EpiInProj epi{&p, mt * 256, nt * 256};
    gemm256_8phase(h, wt, mt * 256, nt * 256, smem, epi);
  }
  if (!(blockIdx.x & 1)) convert_i8_rows(p.peer_u, p.ws + OFF_U, (float*)(p.ws + OFF_SU));
}

constexpr int DS_QROW = 1040;
constexpr int DS_CNT = 32 * DS_QROW;
constexpr int DS_MASK = DS_CNT + 2 * 8 * 32 * 4;
constexpr int DS_WQ = DS_MASK + 64 * 64 * 2;
constexpr int DS_KV = DS_WQ + 1024;
constexpr int DS_KVSTAGE = 2 * 32 * 144 + 2 * 64 * 72;
constexpr int DS_VOFF = 2 * 32 * 144;

DEV int dsa_reduce(int c, unsigned* cbuf, int& par, int r, int hh, int w) {
  c += __shfl_xor(c, 32);
  unsigned* bq = cbuf + par * 256;
  if (hh == 0) bq[w * 32 + r] = (unsigned)c;
  __syncthreads();
  int tot = 0;
#pragma unroll
  for (int k = 0; k < 8; k++) tot += (int)bq[k * 32 + r];
  par ^= 1;
  return tot;
}

DEV void dsa_item(const Params& p, int b, int qt, char* smem) {
  const int tid = opaque_tid(), lane = tid & 63, w = __builtin_amdgcn_readfirstlane(tid >> 6), r = lane & 31, hh = lane >> 5;
  const int q0 = qt * 32; const size_t tb = (size_t)b * 2048;
  const u16* qi = (const u16*)(p.ws + OFF_QI);
  const u16* ki = (const u16*)(p.ws + OFF_KI);
  const float* wi = (const float*)(p.ws + OFF_WI);
  unsigned* cbuf = (unsigned*)(smem + DS_CNT);
  u16* maskb = (u16*)(smem + DS_MASK);
  const bool need_sel = (qt >= 8);
  __syncthreads();
  if (need_sel) {
#pragma unroll
    for (int i = 0; i < 4; i++) {
      int c = tid + i * 512; int row = c >> 6, cc = c & 63;
      *(uint4*)(smem + row * DS_QROW + cc * 16) = *(const uint4*)(qi + (tb + q0 + row) * 512 + cc * 8);
    }
    if (tid < 256) ((float*)(smem + DS_WQ))[tid] = wi[(tb + q0) * 8 + tid];
  }
  __syncthreads();
  if (need_sel) {
    const float* wql = (const float*)(smem + DS_WQ) + r * 8;
    u32x16 uk[8];
#pragma unroll
    for (int i = 0; i < 8; i++) {
      const int kt = w + 8 * i;
      if (kt <= qt) {
        const u16* kp = ki + (tb + kt * 32 + r) * 64 + hh * 8;
        bf16x8 ka[4];
#pragma unroll
        for (int s = 0; s < 4; s++) ka[s] = *(const bf16x8*)(kp + s * 16);
        f32x16 scr = zero16();
#pragma unroll 2
        for (int h8 = 0; h8 < 8; h8++) {
          f32x16 a = zero16();
          const char* qrow = smem + r * DS_QROW + h8 * 128 + hh * 16;
#pragma unroll
          for (int s = 0; s < 4; s++) {
            const bf16x8 qb = *(const bf16x8*)(qrow + s * 32);
            a = mfma32(ka[s], qb, a);
          }
          const float wv = wql[h8];
#pragma unroll
          for (int reg = 0; reg < 16; reg++) scr[reg] = fmaf(wv, fmaxf(a[reg], 0.f), scr[reg]);
        }
#pragma unroll
        for (int reg = 0; reg < 16; reg++) {
          float v = scr[reg];
          if (kt == qt && ((reg & 3) + 8 * (reg >> 2)) > r - 4 * hh) v = NEG_INF;
          uk[i][reg] = ordkey(v);
        }
      } else {
#pragma unroll
        for (int reg = 0; reg < 16; reg++) uk[i][reg] = 0u;
      }
    }
    int par = 0;
    unsigned T = 0u;
    unsigned* lst = (unsigned*)(smem + DS_KV);
    unsigned* lcnt = (unsigned*)(smem + DS_KV + 16384);
    unsigned* lhic = lcnt + 32;
    unsigned* ltp = lcnt + 64;
    for (int rep_b = 0; rep_b < PROBE_DSA_BIS; rep_b++) {
    T = 0u;
    if (tid < 32) lcnt[tid] = 0u;
    for (int it = 0; it < 12; ++it) {
      const unsigned cand = T | (0x80000000u >> it);
      int c = 0;
#pragma unroll
      for (int i = 0; i < 8; i++) {
        if (w + 8 * i <= qt) {
#pragma unroll
          for (int reg = 0; reg < 16; reg++) c += (uk[i][reg] >= cand) ? 1 : 0;
        }
      }
      if (dsa_reduce(c, cbuf, par, r, hh, w) >= 256) T = cand;
    }
    int hic;
    {
      const bool ovf = (T >= 0xFFF00000u);
      const unsigned hi = T + 0x00100000u;
      int c = 0;
      if (!ovf) {
#pragma unroll
        for (int i = 0; i < 8; i++) {
          if (w + 8 * i <= qt) {
#pragma unroll
            for (int reg = 0; reg < 16; reg++) c += (uk[i][reg] >= hi) ? 1 : 0;
          }
        }
      }
      hic = dsa_reduce(c, cbuf, par, r, hh, w);
    }
#pragma unroll
    for (int i = 0; i < 8; i++) {
      if (w + 8 * i <= qt) {
#pragma unroll
        for (int reg = 0; reg < 16; reg++) {
          const unsigned d = uk[i][reg] - T;
          if (d < 0x00100000u) { const unsigned pos = atomicAdd(&lcnt[r], 1u); if (pos < 128u) lst[r * 128 + pos] = d; }
        }
      }
    }
    if (w == 0 && hh == 0) { lhic[r] = (unsigned)hic; ltp[r] = T; }
    __syncthreads();
    if (!__syncthreads_or(lcnt[r] > 128u)) {
      const int qsub = lane >> 4, l16 = lane & 15, q = 4 * w + qsub;
      const int n = (int)lcnt[q];
      const int kp = 256 - (int)lhic[q];
      unsigned v[8];
#pragma unroll
      for (int j = 0; j < 8; j++) { const int ix = l16 + 16 * j; v[j] = (ix < n) ? lst[q * 128 + ix] : 0u; }
      unsigned Tl = 0u;
#pragma unroll 1
      for (int bit = 19; bit >= 0; --bit) {
        const unsigned cand = Tl | (1u << bit);
        int c = 0;
#pragma unroll
        for (int j = 0; j < 8; j++) c += (v[j] >= cand) ? 1 : 0;
        c += __builtin_amdgcn_update_dpp(0, c, 0xB1, 0xF, 0xF, false);
        c += __builtin_amdgcn_update_dpp(0, c, 0x4E, 0xF, 0xF, false);
        c += __builtin_amdgcn_update_dpp(0, c, 0x141, 0xF, 0xF, false);
        c += __builtin_amdgcn_update_dpp(0, c, 0x140, 0xF, 0xF, false);
        if (c >= kp) Tl = cand;
      }
      const unsigned tq = ltp[q] | Tl;
      __syncthreads();
      if (l16 == 0) ltp[q] = tq;
      __syncthreads();
      T = ltp[r];
    } else {
      for (int it = 12; it < 32; ++it) {
        const unsigned cand = T | (0x80000000u >> it);
        int c = 0;
#pragma unroll
        for (int i = 0; i < 8; i++) {
          if (w + 8 * i <= qt) {
#pragma unroll
            for (int reg = 0; reg < 16; reg++) c += (uk[i][reg] >= cand) ? 1 : 0;
          }
        }
        if (dsa_reduce(c, cbuf, par, r, hh, w) >= 256) T = cand;
      }
    }
    }
    int cge;
    {
      int c = 0;
      unsigned Tv = T;
      asm volatile("" : "+v"(Tv));
#pragma unroll
      for (int i = 0; i < 8; i++) {
        if (w + 8 * i <= qt) {
#pragma unroll
          for (int reg = 0; reg < 16; reg++) c += (uk[i][reg] >= Tv) ? 1 : 0;
        }
      }
      cge = dsa_reduce(c, cbuf, par, r, hh, w);
    }
    unsigned J = 4095u;
    if (__syncthreads_or(cge != 256)) {
      int need;
      {
        int c = 0;
        unsigned Tv = T;
        asm volatile("" : "+v"(Tv));
#pragma unroll
        for (int i = 0; i < 8; i++) {
          if (w + 8 * i <= qt) {
#pragma unroll
            for (int reg = 0; reg < 16; reg++) c += (uk[i][reg] > Tv) ? 1 : 0;
          }
        }
        need = 256 - dsa_reduce(c, cbuf, par, r, hh, w);
      }
      J = 0u;
      for (int it = 0; it < 12; ++it) {
        const unsigned cj = J | (2048u >> it);
        int c = 0;
        unsigned Tv = T;
        asm volatile("" : "+v"(Tv));
#pragma unroll
        for (int i = 0; i < 8; i++) {
          if (w + 8 * i <= qt) {
            const int lim = (int)cj - ((w + 8 * i) * 32 + 4 * hh);
#pragma unroll
            for (int reg = 0; reg < 16; reg++) c += (uk[i][reg] == Tv && ((reg & 3) + 8 * (reg >> 2)) < lim) ? 1 : 0;
          }
        }
        if (dsa_reduce(c, cbuf, par, r, hh, w) <= need) J = cj;
      }
    }
#pragma unroll
    for (int i = 0; i < 8; i++) {
      const int kt = w + 8 * i;
      if (kt <= qt) {
        const int lim = (int)J - (kt * 32 + 4 * hh);
        unsigned bits = 0u;
#pragma unroll
        for (int reg = 0; reg < 16; reg++) {
          const unsigned u = uk[i][reg];
          const bool sel = (u > T) || (u == T && ((reg & 3) + 8 * (reg >> 2)) < lim);
          bits |= (sel ? 1u : 0u) << reg;
        }
        maskb[kt * 64 + lane] = (u16)bits;
      }
    }
  } else {
#pragma unroll
    for (int i = 0; i < 8; i++) {
      const int kt = w + 8 * i;
      if (kt <= qt) {
        unsigned bits = 0xFFFFu;
        if (kt == qt) {
          bits = 0u;
#pragma unroll
          for (int reg = 0; reg < 16; reg++) bits |= ((((reg & 3) + 8 * (reg >> 2)) <= r - 4 * hh) ? 1u : 0u) << reg;
        }
        maskb[kt * 64 + lane] = (u16)bits;
      }
    }
  }
  for (int rep_a = 0; rep_a < PROBE_DSA_ATT; rep_a++)
  {
    const int head = w, kvh = w >> 2;
    const u16* q = (const u16*)(p.ws + OFF_Q);
    const u16* kk = (const u16*)(p.ws + OFF_K);
    const u16* vt = (const u16*)(p.ws + OFF_VT);
    bf16x8 qf[4];
    {
      const u16* qp = q + (tb + q0 + r) * 512 + head * 64 + hh * 8;
#pragma unroll
      for (int s = 0; s < 4; s++) qf[s] = *(const bf16x8*)(qp + s * 16);
    }
    const int l_kvh = tid >> 8;
    const int k_row = (tid >> 3) & 31, k_ch = tid & 7;
    const int v_d = (tid >> 2) & 63, v_ch = tid & 3;
    const u16* gk = kk + (tb + k_row) * 128 + l_kvh * 64 + k_ch * 8;
    const u16* gv = vt + ((size_t)(b * 2 + l_kvh) * 64 + v_d) * SV_ + v_ch * 8;
    const int lk = DS_KV + l_kvh * (32 * 144) + k_row * 144 + k_ch * 16;
    const int lv = DS_KV + DS_VOFF + l_kvh * (64 * 72) + v_d * 72 + v_ch * 16;
    const int fk = DS_KV + kvh * (32 * 144) + r * 144 + hh * 16;
    const int fv = DS_KV + DS_VOFF + kvh * (64 * 72) + r * 72 + hh * 8;
    const int nsteps = (qt + 2) >> 1;
    uint4 rkA, rvA, rkB, rvB;
#define AT_LOAD(j_) { const int ka_ = 2 * (j_), kb_ = (2 * (j_) + 1 <= qt) ? 2 * (j_) + 1 : qt; \
      rkA = *(const uint4*)(gk + (size_t)ka_ * 32 * 128); rvA = *(const uint4*)(gv + ka_ * 32); \
      rkB = *(const uint4*)(gk + (size_t)kb_ * 32 * 128); rvB = *(const uint4*)(gv + kb_ * 32); }
#define AT_STORE(sb_) { char* d_ = smem + (sb_) * (2 * DS_KVSTAGE); \
      *(uint4*)(d_ + lk) = rkA; *(uint2*)(d_ + lv) = make_uint2(rvA.x, rvA.y); *(uint2*)(d_ + lv + 8) = make_uint2(rvA.z, rvA.w); \
      *(uint4*)(d_ + DS_KVSTAGE + lk) = rkB; *(uint2*)(d_ + DS_KVSTAGE + lv) = make_uint2(rvB.x, rvB.y); *(uint2*)(d_ + DS_KVSTAGE + lv + 8) = make_uint2(rvB.z, rvB.w); }
    AT_LOAD(0);
    __syncthreads();
    AT_STORE(0);
    __syncthreads();
    f32x16 o0 = zero16(), o1 = zero16();
    float m = NEG_INF, l = 0.f;
    const float SC = 0.125f * 1.4426950408889634f;
    for (int j = 0; j < nsteps; ++j) {
      const char* stg = smem + (j & 1) * (2 * DS_KVSTAGE);
      if (j + 1 < nsteps) AT_LOAD(j + 1);
      f32x16 sa = zero16(), sb = zero16();
#pragma unroll
      for (int s = 0; s < 4; s++) {
        const bf16x8 kfa = *(const bf16x8*)(stg + fk + s * 32);
        const bf16x8 kfb = *(const bf16x8*)(stg + DS_KVSTAGE + fk + s * 32);
        sa = mfma32(kfa, qf[s], sa); sb = mfma32(kfb, qf[s], sb);
      }
      const unsigned bitsA = maskb[(2 * j) * 64 + lane];
      const unsigned bitsB = (2 * j + 1 <= qt) ? (unsigned)maskb[(2 * j + 1) * 64 + lane] : 0u;
#pragma unroll
      for (int reg = 0; reg < 16; reg++) { sa[reg] = ((bitsA >> reg) & 1u) ? sa[reg] : NEG_INF; sb[reg] = ((bitsB >> reg) & 1u) ? sb[reg] : NEG_INF; }
      float tmax = fmaxf(fmaxf(sa[0], sb[0]), fmaxf(sa[1], sb[1]));
#pragma unroll
      for (int reg = 2; reg < 16; reg += 2) tmax = fmaxf(tmax, fmaxf(fmaxf(sa[reg], sb[reg]), fmaxf(sa[reg + 1], sb[reg + 1])));
      tmax = fmaxf(tmax, __shfl_xor(tmax, 32));
      const float mn = fmaxf(m, tmax);
      const float ms = (mn == NEG_INF) ? 0.f : mn;
      const float nmsc = -ms * SC;
      float ps = 0.f, ps2 = 0.f;
#pragma unroll
      for (int reg = 0; reg < 16; reg++) {
        const float pa = __builtin_amdgcn_exp2f(fmaf(sa[reg], SC, nmsc)), pb = __builtin_amdgcn_exp2f(fmaf(sb[reg], SC, nmsc));
        sa[reg] = pa; sb[reg] = pb; ps += pa; ps2 += pb;
      }
      if (__any(mn != m)) {
        const float alpha = __builtin_amdgcn_exp2f(fmaf(m, SC, nmsc));
        l *= alpha;
#pragma unroll
        for (int reg = 0; reg < 16; reg++) { o0[reg] *= alpha; o1[reg] *= alpha; }
      }
      l += ps + ps2; m = mn;
      {
        const bf16x8 pf0 = pack_frag(sa, 0), pf1 = pack_frag(sa, 8);
        const char* vb = stg + fv;
        const bf16x8 v00 = mk_frag(*(const uint2*)(vb), *(const uint2*)(vb + 16));
        const bf16x8 v01 = mk_frag(*(const uint2*)(vb + 32), *(const uint2*)(vb + 48));
        const bf16x8 v10 = mk_frag(*(const uint2*)(vb + 32 * 72), *(const uint2*)(vb + 32 * 72 + 16));
        const bf16x8 v11 = mk_frag(*(const uint2*)(vb + 32 * 72 + 32), *(const uint2*)(vb + 32 * 72 + 48));
        o0 = mfma32(v00, pf0, o0); o1 = mfma32(v10, pf0, o1);
        o0 = mfma32(v01, pf1, o0); o1 = mfma32(v11, pf1, o1);
      }
      {
        const bf16x8 pf0 = pack_frag(sb, 0), pf1 = pack_frag(sb, 8);
        const char* vb = stg + DS_KVSTAGE + fv;
        const bf16x8 v00 = mk_frag(*(const uint2*)(vb), *(const uint2*)(vb + 16));
        const bf16x8 v01 = mk_frag(*(const uint2*)(vb + 32), *(const uint2*)(vb + 48));
        const bf16x8 v10 = mk_frag(*(const uint2*)(vb + 32 * 72), *(const uint2*)(vb + 32 * 72 + 16));
        const bf16x8 v11 = mk_frag(*(const uint2*)(vb + 32 * 72 + 32), *(const uint2*)(vb + 32 * 72 + 48));
        o0 = mfma32(v00, pf0, o0); o1 = mfma32(v10, pf0, o1);
        o0 = mfma32(v01, pf1, o0); o1 = mfma32(v11, pf1, o1);
      }
      if (j + 1 < nsteps) AT_STORE((j + 1) & 1);
      __syncthreads();
    }
#undef AT_LOAD
#undef AT_STORE
    const float lt = l + __shfl_xor(l, 32);
    const float inv = 1.f / lt;
    u16* cat = (u16*)(p.ws + OFF_HBUF);
    u16* op = cat + (tb + q0 + r) * 1024 + head * 64 + 4 * hh;
#pragma unroll
    for (int gq = 0; gq < 4; gq++) {
      *(uint2*)(op + 8 * gq) = make_uint2(pack2(o0[4 * gq] * inv, o0[4 * gq + 1] * inv), pack2(o0[4 * gq + 2] * inv, o0[4 * gq + 3] * inv));
      *(uint2*)(op + 32 + 8 * gq) = make_uint2(pack2(o1[4 * gq] * inv, o1[4 * gq + 1] * inv), pack2(o1[4 * gq + 2] * inv, o1[4 * gq + 3] * inv));
    }
  }
}

constexpr int SA_ROW = 272;
constexpr int SA_XROW = 144;
constexpr int SA_C = 0, SA_B = 128 * SA_ROW;
constexpr int SA_XDT = 2 * 128 * SA_ROW;
constexpr int SA_XH = 128 * SA_XROW;
constexpr int SA_XDS = SA_XDT + 2 * SA_XH;
constexpr int SA_FL = SA_XDS + 2 * SA_XH;

DEV float silu_fast(float v) { return v * __builtin_amdgcn_rcpf(1.f + __builtin_amdgcn_exp2f(-1.4426950408889634f * v)); }

DEV void conv_pair8(const u16* __restrict__ xbc, const float* __restrict__ cw, const float* __restrict__ cbias, size_t tb, int pos0, int ch, float* o0, float* o1) {
  const float2 w0 = *(const float2*)(cw + ch), w1 = *(const float2*)(cw + 1024 + ch), w2 = *(const float2*)(cw + 2048 + ch), w3 = *(const float2*)(cw + 3072 + ch);
  const float2 bs = *(const float2*)(cbias + ch);
  unsigned xr[11];
#pragma unroll
  for (int j = 0; j < 11; j++) { const int sp = pos0 - 3 + j; xr[j] = (sp >= 0) ? *(const unsigned*)(xbc + (tb + sp) * 1024 + ch) : 0u; }
#pragma unroll
  for (int j = 0; j < 8; j++) {
    float a = bs.x, c = bs.y;
    a = fmaf(w0.x, bflo(xr[j]), a); c = fmaf(w0.y, bfhi(xr[j]), c);
    a = fmaf(w1.x, bflo(xr[j + 1]), a); c = fmaf(w1.y, bfhi(xr[j + 1]), c);
    a = fmaf(w2.x, bflo(xr[j + 2]), a); c = fmaf(w2.y, bfhi(xr[j + 2]), c);
    a = fmaf(w3.x, bflo(xr[j + 3]), a); c = fmaf(w3.y, bfhi(xr[j + 3]), c);
    o0[j] = silu_fast(a); o1[j] = silu_fast(c);
  }
}

DEV bf16x8 gather8(const char* base, int stride, bool perm) {
  unsigned v[8];
#pragma unroll
  for (int j = 0; j < 8; j++) { const int row = perm ? ((j & 3) + 8 * (j >> 2)) : j; v[j] = *(const u16*)(base + row * stride); }
  union { uint4 u; bf16x8 f; } t;
  t.u = make_uint4(v[0] | (v[1] << 16), v[2] | (v[3] << 16), v[4] | (v[5] << 16), v[6] | (v[7] << 16));
  return t.f;
}

DEV void ssdA_item(const Params& p, int b, int c, int g, char* smem) {
  const int tid = opaque_tid(), lane = tid & 63, w = __builtin_amdgcn_readfirstlane(tid >> 6), r = lane & 31, hh = lane >> 5;
  const size_t tb = (size_t)b * 2048;
  const u16* xbc = (const u16*)(p.ws + OFF_XBC);
  const float* dtraw = (const float*)(p.ws + OFF_DT);
  __syncthreads();
  {
    u16* ccg = (u16*)(p.ws + OFF_CC);
#pragma unroll 1
    for (int k = 0; k < 4; k++) {
      const int e = tid + k * 512;
      const int pr = e & 63, lb = (e >> 6) & 15, which = e >> 10;
      const int n = 2 * pr, l0 = lb * 8;
      float o0[8], o1[8];
      conv_pair8(xbc, p.conv_w, p.conv_b, tb, c * 128 + l0, 512 + which * 256 + g * 128 + n, o0, o1);
      char* dst = smem + (which ? SA_C : SA_B) + l0 * SA_ROW + n * 2;
#pragma unroll
      for (int j = 0; j < 8; j++) {
        const unsigned pk = pack2(o0[j], o1[j]);
        *(unsigned*)(dst + j * SA_ROW) = pk;
        if (which) *(unsigned*)(ccg + (tb + c * 128 + l0 + j) * 256 + g * 128 + n) = pk;
      }
    }
  }
  if (w < 4) {
    const int h = g * 4 + w;
    float* dtv_ = (float*)(smem + SA_FL) + w * 384; float* acum_ = dtv_ + 128; float* decs_ = dtv_ + 256;
    {
      const float A = -expf(p.a_log[h]);
      const float bias = p.dt_bias[h];
      float x0 = dtraw[(tb + c * 128 + lane) * 8 + h] + bias;
      float x1 = dtraw[(tb + c * 128 + 64 + lane) * 8 + h] + bias;
      float d0 = (x0 > 20.f) ? x0 : log1pf(expf(x0));
      float d1 = (x1 > 20.f) ? x1 : log1pf(expf(x1));
      dtv_[lane] = d0; dtv_[64 + lane] = d1;
      float v0 = d0 * A, v1 = d1 * A;
#pragma unroll
      for (int o = 1; o < 64; o <<= 1) { float n0 = __shfl_up(v0, o), n1 = __shfl_up(v1, o); if (lane >= o) { v0 += n0; v1 += n1; } }
      const float tot0 = __shfl(v0, 63);
      v1 += tot0;
      acum_[lane] = v0; acum_[64 + lane] = v1;
      const float atot = __shfl(v1, 63);
      decs_[lane] = expf(atot - v0); decs_[64 + lane] = expf(atot - v1);
    }
  }
  const int pt = w & 1, lt = w >> 1, nt = w >> 1;
  const int lidx = lt * 32 + r;
  f32x16 cbt[4];
#pragma unroll 1
  for (int rnd = 0; rnd < 2; rnd++) {
    __syncthreads();
    {
      const int pr = tid & 31, lb = tid >> 5;
      const int pp = 2 * pr, l0 = lb * 8;
      float oa0[8], oa1[8], ob0[8], ob1[8];
      conv_pair8(xbc, p.conv_w, p.conv_b, tb, c * 128 + l0, (g * 4 + 2 * rnd) * 64 + pp, oa0, oa1);
      conv_pair8(xbc, p.conv_w, p.conv_b, tb, c * 128 + l0, (g * 4 + 2 * rnd + 1) * 64 + pp, ob0, ob1);
      const float* dtA = (const float*)(smem + SA_FL) + (2 * rnd) * 384; const float* dtB = dtA + 384;
#pragma unroll
      for (int j = 0; j < 8; j++) {
        const float dA = dtA[l0 + j], sA = dtA[256 + l0 + j], dB = dtB[l0 + j], sB = dtB[256 + l0 + j];
        const float a0 = oa0[j] * dA, a1 = oa1[j] * dA, b0 = ob0[j] * dB, b1 = ob1[j] * dB;
        *(unsigned*)(smem + SA_XDT + (l0 + j) * SA_XROW + pp * 2) = pack2(a0, a1);
        *(unsigned*)(smem + SA_XDS + (l0 + j) * SA_XROW + pp * 2) = pack2(a0 * sA, a1 * sA);
        *(unsigned*)(smem + SA_XDT + SA_XH + (l0 + j) * SA_XROW + pp * 2) = pack2(b0, b1);
        *(unsigned*)(smem + SA_XDS + SA_XH + (l0 + j) * SA_XROW + pp * 2) = pack2(b0 * sB, b1 * sB);
      }
    }
    if (rnd == 0) {
#pragma unroll
      for (int st = 0; st < 4; st++) {
        if (st <= lt) {
          f32x16 cb = zero16();
#pragma unroll
          for (int ks = 0; ks < 8; ks++) {
            const bf16x8 a = *(const bf16x8*)(smem + SA_B + (st * 32 + r) * SA_ROW + ks * 32 + hh * 16);
            const bf16x8 bq = *(const bf16x8*)(smem + SA_C + (lt * 32 + r) * SA_ROW + ks * 32 + hh * 16);
            cb = mfma32(a, bq, cb);
          }
          cbt[st] = cb;
        }
      }
    }
    __syncthreads();
#pragma unroll
    for (int hl = 0; hl < 2; hl++) {
      const int h = g * 4 + 2 * rnd + hl;
      const float* dtv = (const float*)(smem + SA_FL) + (2 * rnd + hl) * 384; const float* acum = dtv + 128;
      const char* xdt_ = smem + SA_XDT + hl * SA_XH; const char* xds_ = smem + SA_XDS + hl * SA_XH;
      const float acl = acum[lidx];
      f32x16 yT = zero16();
#pragma unroll
      for (int st = 0; st < 4; st++) {
        if (st <= lt) {
          f32x16 cb = cbt[st];
#pragma unroll
          for (int reg = 0; reg < 16; reg++) {
            const int sidx = st * 32 + rowmap(reg, hh);
            const float as = acum[sidx];
            cb[reg] = (sidx <= lidx) ? cb[reg] * __builtin_amdgcn_exp2f((acl - as) * 1.4426950408889634f) : 0.f;
          }
          const bf16x8 mf0 = pack_frag(cb, 0), mf1 = pack_frag(cb, 8);
          const char* xb = xdt_ + (st * 32 + 4 * hh) * SA_XROW + (pt * 32 + r) * 2;
          const bf16x8 x0 = gather8(xb, SA_XROW, true);
          const bf16x8 x1 = gather8(xb + 16 * SA_XROW, SA_XROW, true);
          yT = mfma32(x0, mf0, yT); yT = mfma32(x1, mf1, yT);
        }
      }
      const float dsk = p.d_skip[h] / dtv[lidx];
      u16* yp = (u16*)(p.ws + OFF_YP) + (tb + c * 128 + lidx) * 512 + h * 64 + pt * 32 + 4 * hh;
#pragma unroll
      for (int gq = 0; gq < 4; gq++) {
        const uint2 xv = *(const uint2*)(xdt_ + lidx * SA_XROW + (pt * 32 + 8 * gq + 4 * hh) * 2);
        *(uint2*)(yp + 8 * gq) = make_uint2(pack2(yT[4 * gq] + dsk * bflo(xv.x), yT[4 * gq + 1] + dsk * bfhi(xv.x)), pack2(yT[4 * gq + 2] + dsk * bflo(xv.y), yT[4 * gq + 3] + dsk * bfhi(xv.y)));
      }
      f32x16 sacc = zero16();
#pragma unroll
      for (int ks = 0; ks < 8; ks++) {
        const bf16x8 a = gather8(xds_ + (ks * 16 + hh * 8) * SA_XROW + (pt * 32 + r) * 2, SA_XROW, false);
        const bf16x8 bq = gather8(smem + SA_B + (ks * 16 + hh * 8) * SA_ROW + (nt * 32 + r) * 2, SA_ROW, false);
        sacc = mfma32(a, bq, sacc);
      }
      u16* stp = (u16*)(p.ws + OFF_ST) + ((size_t)((b * 16 + c) * 8 + h) * 64) * 128;
#pragma unroll
      for (int reg = 0; reg < 16; reg++) stp[(pt * 32 + rowmap(reg, hh)) * 128 + nt * 32 + r] = f2bf(sacc[reg]);
      if (tid < 128) ((float*)(p.ws + OFF_ACUM))[((b * 16 + c) * 8 + h) * 128 + tid] = acum[tid];
    }
  }
}

DEV void ssdS_item(const Params& p, int b, int h, int q) {
  const int tid = opaque_tid();
  const u16* stb = (const u16*)(p.ws + OFF_ST);
  const float* acg = (const float*)(p.ws + OFF_ACUM);
  u16* sin = (u16*)(p.ws + OFF_SIN_ST);
  const int off = q * 2048 + tid * 4;
  float4 S = make_float4(0.f, 0.f, 0.f, 0.f);
  uint2 ld[4];
#pragma unroll
  for (int j = 0; j < 4; j++) ld[j] = *(const uint2*)(stb + (size_t)((b * 16 + j) * 8 + h) * 8192 + off);
#pragma unroll
  for (int c4 = 0; c4 < 16; c4 += 4) {
    uint2 nx[4];
    if (c4 + 4 < 16) {
#pragma unroll
      for (int j = 0; j < 4; j++) nx[j] = *(const uint2*)(stb + (size_t)((b * 16 + c4 + 4 + j) * 8 + h) * 8192 + off);
    }
#pragma unroll
    for (int j = 0; j < 4; j++) {
      const int c = c4 + j;
      *(uint2*)(sin + (size_t)((b * 16 + c) * 8 + h) * 8192 + off) = make_uint2(pack2(S.x, S.y), pack2(S.z, S.w));
      const float dec = expf(acg[((b * 16 + c) * 8 + h) * 128 + 127]);
      S.x = fmaf(S.x, dec, bflo(ld[j].x)); S.y = fmaf(S.y, dec, bfhi(ld[j].x)); S.z = fmaf(S.z, dec, bflo(ld[j].y)); S.w = fmaf(S.w, dec, bfhi(ld[j].y));
    }
    if (c4 + 4 < 16) {
#pragma unroll
      for (int j = 0; j < 4; j++) ld[j] = nx[j];
    }
  }
}

DEV void ssdB_item(const Params& p, int b, int c, char* smem) {
  const int tid = opaque_tid(), lane = tid & 63, h = __builtin_amdgcn_readfirstlane(tid >> 6), r = lane & 31, hh = lane >> 5;
  const size_t tb = (size_t)b * 2048;
  const int g = h >> 2;
  float* ssq = (float*)smem;
  const float* acg = (const float*)(p.ws + OFF_ACUM);
  __syncthreads();
  bf16x8 sf[2][8];
  if (c > 0) {
    const u16* sin = (const u16*)(p.ws + OFF_SIN_ST) + (size_t)((b * 16 + c) * 8 + h) * 8192;
#pragma unroll
    for (int pt = 0; pt < 2; pt++)
#pragma unroll
      for (int ks = 0; ks < 8; ks++) sf[pt][ks] = *(const bf16x8*)(sin + (pt * 32 + r) * 128 + ks * 16 + hh * 8);
  }
  const u16* ccg = (const u16*)(p.ws + OFF_CC);
  const u16* zb = (const u16*)(p.ws + OFF_Z);
  const u16* ypb = (const u16*)(p.ws + OFF_YP);
  u16* cat = (u16*)(p.ws + OFF_HBUF);
  float4 ng0[4], ng1[4];
#pragma unroll
  for (int gq = 0; gq < 4; gq++) {
    ng0[gq] = *(const float4*)(p.ssd_norm_g + h * 64 + 8 * gq + 4 * hh);
    ng1[gq] = *(const float4*)(p.ssd_norm_g + h * 64 + 32 + 8 * gq + 4 * hh);
  }
#pragma unroll 1
  for (int lt = 0; lt < 4; ++lt) {
    const int lidx = lt * 32 + r;
    const size_t t = tb + c * 128 + lidx;
    f32x16 y0 = zero16(), y1 = zero16();
    if (c > 0) {
#pragma unroll
      for (int ks = 0; ks < 8; ks++) {
        const bf16x8 cf = *(const bf16x8*)(ccg + t * 256 + g * 128 + ks * 16 + hh * 8);
        y0 = mfma32(sf[0][ks], cf, y0); y1 = mfma32(sf[1][ks], cf, y1);
      }
      const float e = expf(acg[((b * 16 + c) * 8 + h) * 128 + lidx]);
#pragma unroll
      for (int reg = 0; reg < 16; reg++) { y0[reg] *= e; y1[reg] *= e; }
    }
    float ss = 0.f;
#pragma unroll
    for (int gq = 0; gq < 4; gq++) {
      const int pb = 8 * gq + 4 * hh;
      const uint2 aq0 = *(const uint2*)(ypb + t * 512 + h * 64 + pb), aq1 = *(const uint2*)(ypb + t * 512 + h * 64 + 32 + pb);
      const float4 a0 = make_float4(bflo(aq0.x), bfhi(aq0.x), bflo(aq0.y), bfhi(aq0.y));
      const float4 a1 = make_float4(bflo(aq1.x), bfhi(aq1.x), bflo(aq1.y), bfhi(aq1.y));
      const uint2 z0 = *(const uint2*)(zb + t * 512 + h * 64 + pb);
      const uint2 z1 = *(const uint2*)(zb + t * 512 + h * 64 + 32 + pb);
      y0[4 * gq + 0] = (y0[4 * gq + 0] + a0.x) * silu_f(bflo(z0.x)); y0[4 * gq + 1] = (y0[4 * gq + 1] + a0.y) * silu_f(bfhi(z0.x));
      y0[4 * gq + 2] = (y0[4 * gq + 2] + a0.z) * silu_f(bflo(z0.y)); y0[4 * gq + 3] = (y0[4 * gq + 3] + a0.w) * silu_f(bfhi(z0.y));
      y1[4 * gq + 0] = (y1[4 * gq + 0] + a1.x) * silu_f(bflo(z1.x)); y1[4 * gq + 1] = (y1[4 * gq + 1] + a1.y) * silu_f(bfhi(z1.x));
      y1[4 * gq + 2] = (y1[4 * gq + 2] + a1.z) * silu_f(bflo(z1.y)); y1[4 * gq + 3] = (y1[4 * gq + 3] + a1.w) * silu_f(bfhi(z1.y));
#pragma unroll
      for (int j = 0; j < 4; j++) ss += y0[4 * gq + j] * y0[4 * gq + j] + y1[4 * gq + j] * y1[4 * gq + j];
    }
    ss += __shfl_xor(ss, 32);
    if (hh == 0) ssq[(lt * 32 + r) * 8 + h] = ss;
    __syncthreads();
    float tot = 0.f;
#pragma unroll
    for (int k = 0; k < 8; k++) tot += ssq[(lt * 32 + r) * 8 + k];
    const float rstd = rsqrtf(tot * (1.f / 512.f) + 1e-6f);
#pragma unroll
    for (int gq = 0; gq < 4; gq++) {
      const int pb = 8 * gq + 4 * hh;
      const float4 g0 = ng0[gq], g1 = ng1[gq];
      *(uint2*)(cat + t * 1024 + 512 + h * 64 + pb) = make_uint2(pack2(y0[4 * gq] * rstd * g0.x, y0[4 * gq + 1] * rstd * g0.y), pack2(y0[4 * gq + 2] * rstd * g0.z, y0[4 * gq + 3] * rstd * g0.w));
      *(uint2*)(cat + t * 1024 + 512 + h * 64 + 32 + pb) = make_uint2(pack2(y1[4 * gq] * rstd * g1.x, y1[4 * gq + 1] * rstd * g1.y), pack2(y1[4 * gq + 2] * rstd * g1.z, y1[4 * gq + 3] * rstd * g1.w));
    }
  }
}


DEV void p3_rows1(const Params& p, int m0) {
  const int tid_ = opaque_tid(); const int lane = tid_ & 63, w = __builtin_amdgcn_readfirstlane(tid_ >> 6);
  const u16* mix = (const u16*)(p.ws + OFF_MIX);
  const float* mod = (const float*)(p.ws + OFF_MOD);
  u16* h2 = (u16*)(p.ws + OFF_HBUF);
  const int b = m0 >> 11;
  float4 pg1[4], fgm[4], sh2[4];
#pragma unroll
  for (int k = 0; k < 4; k++) {
    const int col = (k * 64 + lane) * 4;
    const float4 pg = *(const float4*)(p.post_mix_g + col);
    const float4 g1 = ldmod(mod, b * 6144 + 2048 + col);
    pg1[k] = make_float4(pg.x * g1.x, pg.y * g1.y, pg.z * g1.z, pg.w * g1.w);
    const float4 fg = *(const float4*)(p.pre_ffn_g + col);
    const float4 sc = ldmod(mod, b * 6144 + 4096 + col);
    fgm[k] = make_float4(fg.x * (1.f + sc.x), fg.y * (1.f + sc.y), fg.z * (1.f + sc.z), fg.w * (1.f + sc.w));
    sh2[k] = ldmod(mod, b * 6144 + 3072 + col);
  }
#pragma unroll 2
  for (int i = 0; i < 16; i++) {
    const int t = m0 + w * 16 + i;
    float4 mv[4], xv[4]; float ss = 0.f;
#pragma unroll
    for (int k = 0; k < 4; k++) {
      { const uint2 mq = *(const uint2*)(mix + (size_t)t * 1024 + (k * 64 + lane) * 4); mv[k] = make_float4(bflo(mq.x), bfhi(mq.x), bflo(mq.y), bfhi(mq.y)); }
      xv[k] = *(const float4*)(p.x + (size_t)t * 1024 + (k * 64 + lane) * 4);
      ss += mv[k].x * mv[k].x + mv[k].y * mv[k].y + mv[k].z * mv[k].z + mv[k].w * mv[k].w;
    }
    ss = wave_sum(ss);
    const float rstd = rsqrtf(ss * (1.f / 1024.f) + 1e-6f);
    float s2 = 0.f;
#pragma unroll
    for (int k = 0; k < 4; k++) {
      const int col = (k * 64 + lane) * 4;
      xv[k].x += (mv[k].x * rstd) * pg1[k].x; xv[k].y += (mv[k].y * rstd) * pg1[k].y;
      xv[k].z += (mv[k].z * rstd) * pg1[k].z; xv[k].w += (mv[k].w * rstd) * pg1[k].w;
      s2 += xv[k].x * xv[k].x + xv[k].y * xv[k].y + xv[k].z * xv[k].z + xv[k].w * xv[k].w;
      *(uint2*)((u16*)(p.ws + OFF_X1) + (size_t)t * 1024 + col) = make_uint2(pack2(xv[k].x, xv[k].y), pack2(xv[k].z, xv[k].w));
    }
    s2 = wave_sum(s2);
    const float rstd2 = rsqrtf(s2 * (1.f / 1024.f) + 1e-6f);
#pragma unroll
    for (int k = 0; k < 4; k++) {
      const int col = (k * 64 + lane) * 4;
      const float y0 = (xv[k].x * rstd2) * fgm[k].x + sh2[k].x;
      const float y1 = (xv[k].y * rstd2) * fgm[k].y + sh2[k].y;
      const float y2 = (xv[k].z * rstd2) * fgm[k].z + sh2[k].z;
      const float y3 = (xv[k].w * rstd2) * fgm[k].w + sh2[k].w;
      *(uint2*)(h2 + (size_t)t * 1024 + col) = make_uint2(pack2(y0, y1), pack2(y2, y3));
      xv[k] = make_float4(y0, y1, y2, y3);
    }
    {
      float mx = 0.f;
#pragma unroll
      for (int k = 0; k < 4; k++) mx = fmaxf(mx, fmaxf(fmaxf(fabsf(xv[k].x), fabsf(xv[k].y)), fmaxf(fabsf(xv[k].z), fabsf(xv[k].w))));
#pragma unroll
      for (int o = 32; o > 0; o >>= 1) mx = fmaxf(mx, __shfl_xor(mx, o));
      const float inv = (mx > 0.f) ? 127.f / mx : 0.f;
      unsigned wd[4];
#pragma unroll
      for (int k = 0; k < 4; k++) wd[k] = pack_i8x4(xv[k].x * inv, xv[k].y * inv, xv[k].z * inv, xv[k].w * inv);
      *(uint4*)(p.ws + OFF_H2Q + (size_t)t * 1024 + lane * 16) = make_uint4(wd[0], wd[1], wd[2], wd[3]);
      if (lane == 0) ((float*)(p.ws + OFF_SH))[t] = mx * (1.f / 127.f);
    }
  }
}

#define INS16(L, x) { _Pragma("unroll") for (int j_ = 0; j_ < 16; j_++) { const unsigned hi_ = max(L[j_], x); x = min(L[j_], x); L[j_] = hi_; } }
#define CEX(L, a_, b_) { const unsigned hi_ = max(L[a_], L[b_]); const unsigned lo_ = min(L[a_], L[b_]); L[a_] = hi_; L[b_] = lo_; }
DEV float unordkey(unsigned u) { const unsigned b = (u & 0x80000000u) ? (u ^ 0x80000000u) : ~u; return __uint_as_float(b); }

#define SORT16(L) { \
  _Pragma("unroll") for (int k_ = 2; k_ <= 16; k_ <<= 1) { \
    _Pragma("unroll") for (int j_ = k_ >> 1; j_ > 0; j_ >>= 1) { \
      _Pragma("unroll") for (int i_ = 0; i_ < 16; i_++) { \
        const int l_ = i_ ^ j_; \
        if (l_ > i_) { \
          const unsigned a_ = L[i_], b_ = L[l_]; \
          const bool desc_ = ((i_ & k_) == 0); \
          L[i_] = desc_ ? max(a_, b_) : min(a_, b_); L[l_] = desc_ ? min(a_, b_) : max(a_, b_); \
        } } } } }
#define MERGE16(A, B) { \
  _Pragma("unroll") for (int j_ = 0; j_ < 16; j_++) A[j_] = max(A[j_], B[15 - j_]); \
  _Pragma("unroll") for (int j_ = 0; j_ < 8; j_++) CEX(A, j_, j_ + 8); \
  _Pragma("unroll") for (int j_ = 0; j_ < 16; j_++) if ((j_ & 4) == 0) CEX(A, j_, j_ + 4); \
  _Pragma("unroll") for (int j_ = 0; j_ < 16; j_++) if ((j_ & 2) == 0) CEX(A, j_, j_ + 2); \
  _Pragma("unroll") for (int j_ = 0; j_ < 16; j_ += 2) CEX(A, j_, j_ + 1); }

constexpr int RT_LROW = 36;

DEV void p3_route(const Params& p, int m0, char* smem) {
  const int tid = opaque_tid(), lane = tid & 63, w = __builtin_amdgcn_readfirstlane(tid >> 6), r = lane & 31, hh = lane >> 5;
  const u16* qp = (const u16*)(p.ws + OFF_QP);
  const u16* sk = (const u16*)(p.ws + OFF_SK);
  unsigned* lists = (unsigned*)smem;
  int* eidx = (int*)(p.ws + OFF_EIDX);
  float* gate = (float*)(p.ws + OFF_GATE);
  __syncthreads();
  {
    const int h = w;
#pragma unroll 1
    for (int i = 0; i < 2; i++) {
      bf16x8 af[4][4];
#pragma unroll
      for (int kt4 = 0; kt4 < 4; kt4++)
#pragma unroll
        for (int ks = 0; ks < 4; ks++) af[kt4][ks] = *(const bf16x8*)(sk + ((size_t)(h * 2 + i) * 128 + kt4 * 32 + r) * 64 + ks * 16 + hh * 8);
#pragma unroll 1
      for (int tt = 0; tt < 4; tt++) {
        bf16x8 bq[4];
#pragma unroll
        for (int ks = 0; ks < 4; ks++) bq[ks] = *(const bf16x8*)(qp + (size_t)(m0 + tt * 32 + r) * 1024 + h * 128 + i * 64 + ks * 16 + hh * 8);
        unsigned L0[16], L1[16], L2[16], L3[16];
#define RT_TILE(LL, kt4) { f32x16 acc = zero16(); \
          _Pragma("unroll") for (int ks = 0; ks < 4; ks++) acc = mfma32(af[kt4][ks], bq[ks], acc); \
          const unsigned kb = (unsigned)(127 - (kt4) * 32 - 4 * hh); \
          _Pragma("unroll") for (int reg = 0; reg < 16; reg++) LL[reg] = (ordkey(acc[reg]) & 0xFFFFFF80u) | (kb - (unsigned)((reg & 3) + 8 * (reg >> 2))); \
          SORT16(LL); }
        RT_TILE(L0, 0); RT_TILE(L1, 1);
        MERGE16(L0, L1);
        RT_TILE(L2, 2); RT_TILE(L3, 3);
        MERGE16(L2, L3);
        MERGE16(L0, L2);
#undef RT_TILE
        unsigned C[16];
#pragma unroll
        for (int j = 0; j < 16; j++) C[j] = (unsigned)__shfl_xor((int)L0[j], 32);
        MERGE16(L0, C);
#pragma unroll
        for (int j = 0; j < 16; j++) C[j] = L0[j];
        if (hh == 0) {
          uint4* dst = (uint4*)(lists + ((size_t)(h * 128 + tt * 32 + r)) * RT_LROW + i * 16);
          dst[0] = make_uint4(C[0], C[1], C[2], C[3]); dst[1] = make_uint4(C[4], C[5], C[6], C[7]);
          dst[2] = make_uint4(C[8], C[9], C[10], C[11]); dst[3] = make_uint4(C[12], C[13], C[14], C[15]);
        }
      }
    }
  }
  __syncthreads();
#pragma unroll 1
  for (int k = 0; k < 2; k++) {
    const int task = tid + k * 512;
    const int h = task >> 7, t = task & 127;
    const uint4* src = (const uint4*)(lists + (size_t)(h * 128 + t) * RT_LROW);
    unsigned K0[16], K1[16];
#pragma unroll
    for (int q = 0; q < 4; q++) {
      const uint4 a = src[q], bb = src[4 + q];
      K0[4 * q] = a.x; K0[4 * q + 1] = a.y; K0[4 * q + 2] = a.z; K0[4 * q + 3] = a.w;
      K1[4 * q] = bb.x; K1[4 * q + 1] = bb.y; K1[4 * q + 2] = bb.z; K1[4 * q + 3] = bb.w;
    }
    float s0[16], s1[16];
#pragma unroll
    for (int j = 0; j < 16; j++) { s0[j] = unordkey(K0[j] & 0xFFFFFF80u); s1[j] = unordkey(K1[j] & 0xFFFFFF80u); }
    unsigned L[16];
#pragma unroll
    for (int j = 0; j < 16; j++) L[j] = 0u;
#pragma unroll
    for (int a = 0; a < 16; a++) {
#pragma unroll
      for (int bb = 0; bb < 16; bb++) {
        if ((a + 1) * (bb + 1) <= 16) {
          unsigned x = (ordkey(s0[a] + s1[bb]) & 0xFFFFFF00u) | (unsigned)(255 - (a * 16 + bb));
          INS16(L, x);
        }
      }
    }
    float fv[16]; int ei[16]; float mx = NEG_INF;
#pragma unroll
    for (int j = 0; j < 16; j++) {
      const int code = 255 - (int)(L[j] & 255u); const int a = code >> 4, bb = code & 15;
      const unsigned ka = ((const unsigned*)src)[a], kb2 = ((const unsigned*)src)[16 + bb];
      const float va = unordkey(ka & 0xFFFFFF80u), vb = unordkey(kb2 & 0xFFFFFF80u);
      fv[j] = va + vb;
      ei[j] = (127 - (int)(ka & 127u)) * 128 + (127 - (int)(kb2 & 127u));
      mx = fmaxf(mx, fv[j]);
    }
    float sum = 0.f;
#pragma unroll
    for (int j = 0; j < 16; j++) { fv[j] = __expf(fv[j] - mx); sum += fv[j]; }
    const float inv = 1.f / sum;
    int* ep = eidx + (size_t)(m0 + t) * 128 + h * 16;
    float* gp = gate + (size_t)(m0 + t) * 128 + h * 16;
#pragma unroll
    for (int q = 0; q < 4; q++) {
      *(int4*)(ep + 4 * q) = make_int4(ei[4 * q], ei[4 * q + 1], ei[4 * q + 2], ei[4 * q + 3]);
      *(float4*)(gp + 4 * q) = make_float4(fv[4 * q] * inv, fv[4 * q + 1] * inv, fv[4 * q + 2] * inv, fv[4 * q + 3] * inv);
    }
  }
}

typedef __attribute__((ext_vector_type(2))) float f32x2;
DEV void dec16(const uint4& q, float* f) {
  f32x2 t;
  t = __builtin_amdgcn_cvt_pk_f32_fp8((int)q.x, false); f[0] = t[0]; f[1] = t[1];
  t = __builtin_amdgcn_cvt_pk_f32_fp8((int)q.x, true);  f[2] = t[0]; f[3] = t[1];
  t = __builtin_amdgcn_cvt_pk_f32_fp8((int)q.y, false); f[4] = t[0]; f[5] = t[1];
  t = __builtin_amdgcn_cvt_pk_f32_fp8((int)q.y, true);  f[6] = t[0]; f[7] = t[1];
  t = __builtin_amdgcn_cvt_pk_f32_fp8((int)q.z, false); f[8] = t[0]; f[9] = t[1];
  t = __builtin_amdgcn_cvt_pk_f32_fp8((int)q.z, true);  f[10] = t[0]; f[11] = t[1];
  t = __builtin_amdgcn_cvt_pk_f32_fp8((int)q.w, false); f[12] = t[0]; f[13] = t[1];
  t = __builtin_amdgcn_cvt_pk_f32_fp8((int)q.w, true);  f[14] = t[0]; f[15] = t[1];
}

constexpr int PX_ROW = 132;
constexpr int PX_Z = 0;
constexpr int PX_E = 8 * 16 * PX_ROW * 4;
constexpr int PX_SS = 2 * PX_E;
constexpr int PX_CL = PX_SS + 512;

DEV void p3_ustage(const Params& p, int m0, char* smem) {
  const int tid_ = opaque_tid(); const int lane = tid_ & 63, w = __builtin_amdgcn_readfirstlane(tid_ >> 6);
  const int sl = lane >> 3, ch = lane & 7;
  const unsigned char* h2q = p.ws + OFF_H2Q;
  const unsigned char* U = p.ws + OFF_U;
  const int* eidx = (const int*)(p.ws + OFF_EIDX);
  float* zb = (float*)(smem + PX_Z) + w * 16 * PX_ROW;
  int* eb = (int*)(smem + PX_E) + w * 16 * PX_ROW;
  int* cl = (int*)(smem + PX_CL) + w * 128;
#pragma unroll 1
  for (int i = 0; i < 16; i++) {
    const int t = m0 + w * 16 + i;
    eb[i * PX_ROW + lane] = eidx[(size_t)t * 128 + lane]; eb[i * PX_ROW + 64 + lane] = eidx[(size_t)t * 128 + 64 + lane];
  }
  if (lane < 16) ((float*)(smem + PX_SS))[w * 16 + lane] = 0.f;
#define U_LOAD8(Q, E) { const unsigned char* up_ = U + (size_t)(E) * 1024 + ch * 16; _Pragma("unroll") for (int k_ = 0; k_ < 8; k_++) Q[k_] = *(const uint4*)(up_ + k_ * 128); }
#pragma unroll 1
  for (int rep = 0; rep < PROBE_U; rep++)
#pragma unroll 1
  for (int x = 0; x < 8; x++) {
    float* zbase = zb;
    uint4 hqn[8];
#pragma unroll
    for (int k = 0; k < 8; k++) hqn[k] = *(const uint4*)(h2q + (size_t)(m0 + w * 16) * 1024 + k * 128 + ch * 16);
#pragma unroll 1
    for (int i = 0; i < 16; i++) {
      uint4 hq[8];
#pragma unroll
      for (int k = 0; k < 8; k++) hq[k] = hqn[k];
      const int ev0 = eb[i * PX_ROW + lane], ev1 = eb[i * PX_ROW + 64 + lane];
      const bool f0 = (ev0 >> 11) == x, f1 = (ev1 >> 11) == x;
      const unsigned long long mk0 = __ballot(f0), mk1 = __ballot(f1);
      const int n0 = __builtin_popcountll(mk0), n = n0 + __builtin_popcountll(mk1);
      const int r0 = __builtin_amdgcn_mbcnt_hi((unsigned)(mk0 >> 32), __builtin_amdgcn_mbcnt_lo((unsigned)mk0, 0));
      const int r1 = n0 + __builtin_amdgcn_mbcnt_hi((unsigned)(mk1 >> 32), __builtin_amdgcn_mbcnt_lo((unsigned)mk1, 0));
      if (f0) cl[r0] = ev0 | (lane << 16);
      if (f1) cl[r1] = ev1 | ((64 + lane) << 16);
      float* zrow = zbase + i * PX_ROW;
      uint4 qA[8]; int ceA = 0;
      if (n > 0) { ceA = cl[(sl < n) ? sl : 0]; U_LOAD8(qA, ceA & 0xFFFF); }
      {
        const unsigned char* hp = h2q + (size_t)(m0 + w * 16 + ((i < 15) ? i + 1 : i)) * 1024 + ch * 16;
#pragma unroll
        for (int k = 0; k < 8; k++) hqn[k] = *(const uint4*)(hp + k * 128);
      }
#pragma unroll 1
      for (int bb = 0; bb < n; bb += 8) {
        uint4 qB[8]; int ceB = 0;
        const bool more = (bb + 8 < n);
        if (more) { const int ix = bb + 8 + sl; ceB = cl[(ix < n) ? ix : bb + 8]; U_LOAD8(qB, ceB & 0xFFFF); }
        int d = 0;
#pragma unroll
        for (int k = 0; k < 8; k++) {
          d = __builtin_amdgcn_sdot4((int)qA[k].x, (int)hq[k].x, d, false);
          d = __builtin_amdgcn_sdot4((int)qA[k].y, (int)hq[k].y, d, false);
          d = __builtin_amdgcn_sdot4((int)qA[k].z, (int)hq[k].z, d, false);
          d = __builtin_amdgcn_sdot4((int)qA[k].w, (int)hq[k].w, d, false);
        }
        d += __builtin_amdgcn_update_dpp(0, d, 0xB1, 0xF, 0xF, false);
        d += __builtin_amdgcn_update_dpp(0, d, 0x4E, 0xF, 0xF, false);
        d += __builtin_amdgcn_update_dpp(0, d, 0x141, 0xF, 0xF, false);
        if (ch == 0 && bb + sl < n) zrow[ceA >> 16] = (float)d;
        if (more) {
#pragma unroll
          for (int k = 0; k < 8; k++) qA[k] = qB[k];
          ceA = ceB;
        }
      }
    }
  }
#undef U_LOAD8
  {
    const float* su = (const float*)(p.ws + OFF_SU);
    const float* sv = (const float*)(p.ws + OFF_SV);
    const float* shs = (const float*)(p.ws + OFF_SH);
    const float* gate = (const float*)(p.ws + OFF_GATE);
#pragma unroll 1
    for (int i = 0; i < 16; i++) {
      const int t = m0 + w * 16 + i;
      const float st = shs[t];
#pragma unroll
      for (int half = 0; half < 2; half++) {
        const int e = eb[i * PX_ROW + half * 64 + lane];
        const float z = zb[i * PX_ROW + half * 64 + lane] * (su[e] * st);
        zb[i * PX_ROW + half * 64 + lane] = 0.5f * z * (1.f + erff(z * 0.70710678118654752f)) * gate[(size_t)t * 128 + half * 64 + lane] * sv[e];
      }
    }
  }
}

DEV void p3_vstage(const Params& p, int m0, char* smem) {
  const int tid_ = opaque_tid(); const int lane = tid_ & 63, w = __builtin_amdgcn_readfirstlane(tid_ >> 6);
  const unsigned char* V = p.ws + OFF_V;
  const float* ab = (const float*)(smem + PX_Z) + w * 16 * PX_ROW;
  const int* eb = (const int*)(smem + PX_E) + w * 16 * PX_ROW;
  float* ssq = (float*)(smem + PX_SS) + w * 16;
  u16* F = (u16*)(p.ws + OFF_MIX + (size_t)T_ * 1024 * 2);
  const int ts = lane >> 3, ch = lane & 7;
#define V_LOAD4(Q, E4) { Q[0] = *(const uint4*)(vb + (size_t)(E4).x * 1024); Q[1] = *(const uint4*)(vb + (size_t)(E4).y * 1024); \
    Q[2] = *(const uint4*)(vb + (size_t)(E4).z * 1024); Q[3] = *(const uint4*)(vb + (size_t)(E4).w * 1024); }
#pragma unroll 1
  for (int rep = 0; rep < PROBE_V; rep++)
#pragma unroll 1
  for (int x = 0; x < 8; x++) {
    const unsigned char* vb = V + x * 128 + ch * 16;
#pragma unroll 1
    for (int grp = 0; grp < 2; grp++) {
      const int i = grp * 8 + ts;
      const int t = m0 + w * 16 + i;
      const int4* ep = (const int4*)(eb + i * PX_ROW);
      const float4* ap = (const float4*)(ab + i * PX_ROW);
      f32x2 acc[8];
#pragma unroll
      for (int k = 0; k < 8; k++) acc[k] = (f32x2){0.f, 0.f};
      uint4 qA[4], qB[4];
      int4 e4 = ep[0];
      V_LOAD4(qA, e4);
      e4 = ep[1];
      V_LOAD4(qB, e4);
#pragma unroll 1
      for (int pb = 0; pb < 32; pb += 2) {
#pragma unroll
        for (int half = 0; half < 2; half++) {
          const float4 a4 = ap[pb + half];
          const float av[4] = {a4.x, a4.y, a4.z, a4.w};
#pragma unroll
          for (int u = 0; u < 4; u++) {
            const uint4 qq = half ? qB[u] : qA[u];
            const f32x2 a2 = {av[u], av[u]};
            const unsigned wds[4] = {qq.x, qq.y, qq.z, qq.w};
#pragma unroll
            for (int k2 = 0; k2 < 4; k2++) {
              acc[2 * k2] = __builtin_elementwise_fma(a2, __builtin_amdgcn_cvt_pk_f32_fp8((int)wds[k2], false), acc[2 * k2]);
              acc[2 * k2 + 1] = __builtin_elementwise_fma(a2, __builtin_amdgcn_cvt_pk_f32_fp8((int)wds[k2], true), acc[2 * k2 + 1]);
            }
          }
          const int nx = pb + 2 + half;
          if (nx < 32) { const int4 en = ep[nx]; if (half) { V_LOAD4(qB, en); } else { V_LOAD4(qA, en); } }
        }
      }
      float ss = 0.f;
#pragma unroll
      for (int k = 0; k < 8; k++) ss = fmaf(acc[k][0], acc[k][0], fmaf(acc[k][1], acc[k][1], ss));
      ss += __int_as_float(__builtin_amdgcn_update_dpp(0, __float_as_int(ss), 0xB1, 0xF, 0xF, false));
      ss += __int_as_float(__builtin_amdgcn_update_dpp(0, __float_as_int(ss), 0x4E, 0xF, 0xF, false));
      ss += __int_as_float(__builtin_amdgcn_update_dpp(0, __float_as_int(ss), 0x141, 0xF, 0xF, false));
      if (rep < PROBE_V) {
        u16* fp = F + (size_t)t * 1024 + x * 128 + ch * 16;
        *(uint4*)(fp) = make_uint4(pack2(acc[0][0], acc[0][1]), pack2(acc[1][0], acc[1][1]), pack2(acc[2][0], acc[2][1]), pack2(acc[3][0], acc[3][1]));
        *(uint4*)(fp + 8) = make_uint4(pack2(acc[4][0], acc[4][1]), pack2(acc[5][0], acc[5][1]), pack2(acc[6][0], acc[6][1]), pack2(acc[7][0], acc[7][1]));
        if (ch == 0 && rep == 0) ssq[i] += ss;
      }
    }
  }
#undef V_LOAD4
  {
    const float* mod = (const float*)(p.ws + OFF_MOD);
    const int b = m0 >> 11;
    float4 fg2[4];
#pragma unroll
    for (int j = 0; j < 4; j++) {
      const int col = j * 256 + lane * 4;
      const float4 fg = *(const float4*)(p.post_ffn_g + col);
      const float4 g2 = ldmod(mod, b * 6144 + 5120 + col);
      fg2[j] = make_float4(fg.x * g2.x, fg.y * g2.y, fg.z * g2.z, fg.w * g2.w);
    }
#pragma unroll 2
    for (int i = 0; i < 16; i++) {
      const int t = m0 + w * 16 + i;
      const float rstd = rsqrtf(ssq[i] * (1.f / 1024.f) + 1e-6f);
#pragma unroll
      for (int j = 0; j < 4; j++) {
        const uint2 fq = *(const uint2*)(F + (size_t)t * 1024 + lane * 16 + j * 4);
        const float4 f = make_float4(bflo(fq.x), bfhi(fq.x), bflo(fq.y), bfhi(fq.y));
        const int col = j * 256 + lane * 4;
        const uint2 xq = *(const uint2*)((const u16*)(p.ws + OFF_X1) + (size_t)t * 1024 + col);
        const float4 x1 = make_float4(bflo(xq.x), bfhi(xq.x), bflo(xq.y), bfhi(xq.y));
        float4 o;
        o.x = x1.x + (f.x * rstd) * fg2[j].x; o.y = x1.y + (f.y * rstd) * fg2[j].y;
        o.z = x1.z + (f.z * rstd) * fg2[j].z; o.w = x1.w + (f.w * rstd) * fg2[j].w;
        *(float4*)(p.out + (size_t)t * 1024 + col) = o;
      }
    }
  }
}

DEV void phase3_tile(const Params& p, int mt, char* smem) {
  const int m0 = mt * 128;
  const u16* cat = (const u16*)(p.ws + OFF_HBUF) + (size_t)m0 * 1024;
  {
    const u16* wt = (const u16*)(p.ws + OFF_WTOUT);
    for (int rep = 0; rep < PROBE_G3; rep++)
    for (int nc = 0; nc < 4; nc++) {
      EpiStoreBf16 epi{(u16*)(p.ws + OFF_MIX) + (size_t)m0 * 1024, nc * 256};
      gemm_tile(cat, 1024, wt + (size_t)nc * 256 * 1024, 1024, 1024, smem, epi);
    }
  }
  __syncthreads();
  p3_rows1(p, m0);
#if STAGE >= 6
  __syncthreads();
  {
    const u16* wt = (const u16*)(p.ws + OFF_WTQ);
    for (int rep = 0; rep < PROBE_G3; rep++)
    for (int nc = 0; nc < 4; nc++) {
      EpiStoreBf16 epi{(u16*)(p.ws + OFF_QP) + (size_t)m0 * 1024, nc * 256};
      gemm_tile(cat, 1024, wt + (size_t)nc * 256 * 1024, 1024, 1024, smem, epi);
    }
  }
  __syncthreads();
  for (int rep = 0; rep < PROBE_ROUTE; rep++) p3_route(p, m0, smem);
  __syncthreads();
#endif
}

DEV void grid_barrier(unsigned* counter, unsigned& target) {
  asm volatile("s_waitcnt vmcnt(0)" ::: "memory");
  __syncthreads();
  if (threadIdx.x == 0) {
    __builtin_amdgcn_fence(__ATOMIC_RELEASE, "agent");
    asm volatile("s_waitcnt vmcnt(0)" ::: "memory");
    target += gridDim.x;
    __hip_atomic_fetch_add(counter, 1u, __ATOMIC_RELAXED, __HIP_MEMORY_SCOPE_AGENT);
    while (__hip_atomic_load(counter, __ATOMIC_RELAXED, __HIP_MEMORY_SCOPE_AGENT) < target) __builtin_amdgcn_s_sleep(1);
    __builtin_amdgcn_fence(__ATOMIC_ACQUIRE, "agent");
    asm volatile("s_waitcnt vmcnt(0)" ::: "memory");
  }
  __syncthreads();
}

#define XB_TMO      128
#define XB_XCNT(j)  (256  + 64 * (j))
#define XB_XSUB(j)  (1280 + 64 * (j))
#define XB_XGEN(j)  (2304 + 64 * (j))
#define XB_TOP      3328
#define XB_TOPGEN   3392
#define XB_SPIN_CAP (1u << 22)
DEV unsigned xb_ld(unsigned* p) { return __hip_atomic_load(p, __ATOMIC_RELAXED, __HIP_MEMORY_SCOPE_AGENT); }
DEV unsigned xb_add(unsigned* p, unsigned v) { return __hip_atomic_fetch_add(p, v, __ATOMIC_RELAXED, __HIP_MEMORY_SCOPE_AGENT); }
DEV unsigned xb_xcc_id() { return (unsigned)__builtin_amdgcn_s_getreg((3 << 11) | 20) & 0xFu; }
#define XB_SPIN(cond, bar) do { unsigned _sp = 0; while (cond) { __builtin_amdgcn_s_sleep(1); \
    if ((++_sp & 255u) == 0u) { if (xb_ld(&(bar)[XB_TMO])) break; if (_sp > XB_SPIN_CAP) { atomicAdd(&(bar)[XB_TMO], 1u); break; } } } } while (0)
struct XcdBarrier { unsigned* bar; unsigned x; unsigned* st; };
DEV void xcd_barrier_complete(unsigned* bar, unsigned x, unsigned& nloc, unsigned& nx) {
  const unsigned G = gridDim.x;
  unsigned sum, cnt, mine, sp = 0u;
  for (;;) {
    sum = 0u; cnt = 0u; mine = 0u;
#pragma unroll
    for (unsigned j = 0; j < 16; ++j) { const unsigned c = xb_ld(&bar[XB_XCNT(j)]); sum += c; cnt += (c > 0u) ? 1u : 0u; mine = (j == x) ? c : mine; }
    if (sum == G) break;
    __builtin_amdgcn_s_sleep(1);
    if ((++sp & 255u) == 0u) { if (xb_ld(&bar[XB_TMO])) break; if (sp > XB_SPIN_CAP) { atomicAdd(&bar[XB_TMO], 1u); break; } }
  }
  nloc = mine > 0u ? mine : 1u; nx = cnt > 0u ? cnt : 1u;
}
DEV void xcd_barrier(const XcdBarrier& b) {
  asm volatile("s_waitcnt vmcnt(0)" ::: "memory");
  __syncthreads();
  if (threadIdx.x == 0) {
    unsigned* bar = b.bar;
    __builtin_amdgcn_s_waitcnt(0);
    unsigned nloc = b.st[0], nx = b.st[1];
    if (nloc == 0u) { xcd_barrier_complete(bar, b.x, nloc, nx); b.st[0] = nloc; b.st[1] = nx; }
    const unsigned old = xb_add(&bar[XB_XSUB(b.x)], 1u);
    const unsigned gen = old / nloc;
    if (old + 1u == (gen + 1u) * nloc) {
      __builtin_amdgcn_fence(__ATOMIC_RELEASE, "agent");
      asm volatile("s_waitcnt vmcnt(0)" ::: "memory");
      const unsigned og = xb_add(&bar[XB_TOP], 1u);
      const unsigned tg = og / nx;
      if (og + 1u == (tg + 1u) * nx) xb_add(&bar[XB_TOPGEN], 1u);
      else XB_SPIN(xb_ld(&bar[XB_TOPGEN]) == tg, bar);
      __builtin_amdgcn_fence(__ATOMIC_ACQUIRE, "agent");
      xb_add(&bar[XB_XGEN(b.x)], 1u);
      asm volatile("s_waitcnt vmcnt(0)" ::: "memory");
    } else {
      XB_SPIN(xb_ld(&bar[XB_XGEN(b.x)]) == gen, bar);
      __builtin_amdgcn_fence(__ATOMIC_ACQUIRE, "agent");
      asm volatile("s_waitcnt vmcnt(0)" ::: "memory");
    }
  }
  __syncthreads();
}

__global__ void __launch_bounds__(NT) mega(Params p) {
  __shared__ __attribute__((aligned(16))) char smem[LDS_BYTES + 16];
  cg::grid_group grid = cg::this_grid();
  XcdBarrier xb; xb.bar = (unsigned*)(p.ws + OFF_XB); xb.x = xb_xcc_id(); xb.st = (unsigned*)(smem + LDS_BYTES);
  if (threadIdx.x == 0) { xb.st[0] = 0u; xb.st[1] = 0u; (void)xb_add(&xb.bar[XB_XCNT(xb.x)], 1u); }
  __syncthreads();
#if STAGE == 0
  {
    const size_t n4 = (size_t)T_ * 1024 / 4;
    for (size_t i = (size_t)blockIdx.x * NT + threadIdx.x; i < n4; i += (size_t)gridDim.x * NT) ((float4*)p.out)[i] = ((const float4*)p.x)[i];
  }
#endif
  phase_mod(p, smem);
  if (gridDim.x == 0x7fffffffu) grid.sync();
  xcd_barrier(xb);
#if PH(1)
  for (int rep = 0; rep < PROBE_HN; rep++) phase_hnorm(p);
#endif
#if PH(0)
  for (int rep = 0; rep < PROBE_P0; rep++) phase0(p, smem);
#endif
  xcd_barrier(xb);
#if STAGE >= 1 && PH(2)
  for (int rep = 0; rep < PROBE_P1; rep++) phase1(p, smem);
#endif
  xcd_barrier(xb);
#if STAGE >= 2 && PH(3)
  for (int rep = 0; rep < PROBE_SSDA; rep++)
  for (int it = blockIdx.x; it < 512; it += gridDim.x) { ssdA_item(p, it >> 5, (it >> 1) & 15, it & 1, smem); }
#endif
#if STAGE >= 4 && PH(4)
  for (int rep = 0; rep < PROBE_DSA; rep++)
  for (int k = 0; k < 4; k++) {
    const int i = blockIdx.x + k * gridDim.x;
    if (gridDim.x == 256) {
      const int rr = i & 255; const int b = rr & 15, a = rr >> 4;
      const int qt = (k == 0) ? a : (k == 1) ? 31 - a : (k == 2) ? 32 + a : 63 - a;
      dsa_item(p, b, qt, smem);
    }
  }
  if (gridDim.x != 256) { for (int i = blockIdx.x; i < 1024; i += gridDim.x) dsa_item(p, i & 15, 63 - (i >> 4), smem); }
#if STAGE >= 2
  xcd_barrier(xb);
#endif
  for (int it = blockIdx.x; it < 512; it += gridDim.x) ssdS_item(p, it >> 5, (it >> 2) & 7, it & 3);
#elif STAGE >= 2 && STAGE < 4
  {
    u16* cat = (u16*)(p.ws + OFF_HBUF);
    for (size_t i = (size_t)blockIdx.x * NT + threadIdx.x; i < (size_t)T_ * 64; i += (size_t)gridDim.x * NT) {
      const size_t t = i >> 6, cc = i & 63;
      *(uint4*)(cat + t * 1024 + cc * 8) = make_uint4(0, 0, 0, 0);
    }
  }
#endif
  xcd_barrier(xb);
#if STAGE >= 2 && PH(5)
  for (int rep = 0; rep < PROBE_SSDB; rep++)
  for (int it = blockIdx.x; it < 256; it += gridDim.x) ssdB_item(p, it >> 4, it & 15, smem);
#endif
  xcd_barrier(xb);
#if STAGE >= 3 && PH(6)
  if (gridDim.x == 256) {
    if (blockIdx.x & 1) convert_fp8_rows(p.peer_v, p.ws + OFF_V, (float*)(p.ws + OFF_SV));
    phase3_tile(p, blockIdx.x, smem);
    if (!(blockIdx.x & 1)) convert_fp8_rows(p.peer_v, p.ws + OFF_V, (float*)(p.ws + OFF_SV));
    xcd_barrier(xb);
    p3_ustage(p, blockIdx.x * 128, smem);
    xcd_barrier(xb);
    p3_vstage(p, blockIdx.x * 128, smem);
  } else {
    convert_fp8_rows(p.peer_v, p.ws + OFF_V, (float*)(p.ws + OFF_SV));
    xcd_barrier(xb);
    for (int mt = blockIdx.x; mt < 256; mt += gridDim.x) { phase3_tile(p, mt, smem); p3_ustage(p, mt * 128, smem); p3_vstage(p, mt * 128, smem); __syncthreads(); }
  }
#endif
}

extern "C" void kernel_launch(void* const* d_in, const int* in_sizes, int n_in, void* d_out, int out_size, void* d_ws, size_t ws_size, hipStream_t stream) {
  static int grid_blocks = 0;
  if (!grid_blocks) {
    int dev = 0, cus = 0, per_cu = 0;
    hipGetDevice(&dev);
    hipDeviceGetAttribute(&cus, hipDeviceAttributeMultiprocessorCount, dev);
    hipOccupancyMaxActiveBlocksPerMultiprocessor(&per_cu, mega, NT, 0);
    if (per_cu < 1) { fprintf(stderr, "occupancy query says %d blocks/CU\n", per_cu); per_cu = 1; }
    grid_blocks = cus;
    if (ws_size < WS_END) fprintf(stderr, "workspace too small: %zu < %zu\n", ws_size, (size_t)WS_END);
  }
  Params p{};
  p.x = (const float*)d_in[0]; p.c = (const float*)d_in[1]; p.pos = (const int*)d_in[2]; p.w_ada = (const float*)d_in[3]; p.b_ada = (const float*)d_in[4];
  p.pre_mix_g = (const float*)d_in[5]; p.post_mix_g = (const float*)d_in[6]; p.w_in = (const float*)d_in[7]; p.conv_w = (const float*)d_in[8]; p.conv_b = (const float*)d_in[9];
  p.dt_bias = (const float*)d_in[10]; p.a_log = (const float*)d_in[11]; p.d_skip = (const float*)d_in[12]; p.ssd_norm_g = (const float*)d_in[13]; p.w_out = (const float*)d_in[14];
  p.pre_ffn_g = (const float*)d_in[15]; p.post_ffn_g = (const float*)d_in[16]; p.w_q = (const float*)d_in[17]; p.sub_keys = (const float*)d_in[18]; p.peer_u = (const float*)d_in[19];
  p.peer_v = (const float*)d_in[20]; p.out = (float*)d_out; p.ws = (unsigned char*)d_ws;
  if (hipMemsetAsync((unsigned char*)d_ws + OFF_XB, 0, 16384, stream) != hipSuccess) fprintf(stderr, "memset of the barrier words failed\n");
  void* args[] = {&p};
  hipError_t e = hipLaunchCooperativeKernel((void*)mega, dim3(grid_blocks), dim3(NT), args, 0, stream);
  if (e != hipSuccess) fprintf(stderr, "cooperative launch failed: %s (grid %d)\n", hipGetErrorString(e), grid_blocks);
}
```

```cpp
#include <hip/hip_runtime.h>
#include <hip/hip_cooperative_groups.h>
#include <stdint.h>
#include <stdio.h>
namespace cg = cooperative_groups;

#ifndef STAGE
#define STAGE 99
#endif
#ifndef ONLY
#define ONLY -1
#endif
#define PH(n) (ONLY < 0 || ONLY == (n))
#ifndef PROBE_P0
#define PROBE_P0 1
#endif
#ifndef PROBE_HN
#define PROBE_HN 1
#endif
#ifndef PROBE_P1
#define PROBE_P1 1
#endif
#ifndef PROBE_SSDA
#define PROBE_SSDA 1
#endif
#ifndef PROBE_DSA
#define PROBE_DSA 1
#endif
#ifndef PROBE_SSDB
#define PROBE_SSDB 1
#endif
#ifndef PROBE_UHOT
#define PROBE_UHOT 0
#endif
#ifndef PROBE_VHOT
#define PROBE_VHOT 0
#endif
#ifndef PROBE_DSA_SC
#define PROBE_DSA_SC 1
#endif
#ifndef PROBE_DSA_BIS
#define PROBE_DSA_BIS 1
#endif
#ifndef PROBE_DSA_ATT
#define PROBE_DSA_ATT 1
#endif
#ifndef PROBE_U
#define PROBE_U 1
#endif
#ifndef PROBE_V
#define PROBE_V 1
#endif
#ifndef PROBE_ROUTE
#define PROBE_ROUTE 1
#endif
#ifndef PROBE_G3
#define PROBE_G3 1
#endif

#define NT 512
typedef unsigned short u16;
typedef __attribute__((ext_vector_type(8))) short bf16x8;
typedef __attribute__((ext_vector_type(16))) float f32x16;
typedef __attribute__((ext_vector_type(16))) unsigned u32x16;

#define DEV __device__ __forceinline__

constexpr int B_ = 16, S_ = 2048, D_ = 1024, T_ = B_ * S_;
constexpr int NPROJ = 2896, NPAD = 3072;
constexpr int SV_ = 2048 + 64;
constexpr float NEG_INF = -__builtin_huge_valf();

constexpr size_t OFF_MOD = 0;
constexpr size_t OFF_COS = OFF_MOD + 786432;
constexpr size_t OFF_SIN = OFF_COS + (size_t)T_ * 32 * 4;
constexpr size_t OFF_HBUF = OFF_SIN + (size_t)T_ * 32 * 4;
constexpr size_t OFF_WTIN = OFF_HBUF + (size_t)T_ * 1024 * 2;
constexpr size_t OFF_WTOUT = OFF_WTIN + (size_t)NPAD * 1024 * 2;
constexpr size_t OFF_WTQ = OFF_WTOUT + (size_t)1024 * 1024 * 2;
constexpr size_t OFF_SK = OFF_WTQ + (size_t)1024 * 1024 * 2;
constexpr size_t OFF_U = OFF_SK + (size_t)16 * 128 * 64 * 2;
constexpr size_t OFF_V = OFF_U + (size_t)16384 * 1024;
constexpr size_t OFF_SU = OFF_V + (size_t)16384 * 1024;
constexpr size_t OFF_SV = OFF_SU + (size_t)16384 * 4;
constexpr size_t OFF_Q = OFF_SV + (size_t)16384 * 4;
constexpr size_t OFF_QI = OFF_Q + (size_t)T_ * 512 * 2;
constexpr size_t OFF_XBC = OFF_QI + (size_t)T_ * 512 * 2;
constexpr size_t OFF_SIN_ST = OFF_XBC;
constexpr size_t OFF_MIX = OFF_Q;
constexpr size_t OFF_K = OFF_XBC + (size_t)T_ * 1024 * 2;
constexpr size_t OFF_VT = OFF_K + (size_t)T_ * 128 * 2;
constexpr size_t OFF_KI = OFF_VT + (size_t)16 * 2 * 64 * SV_ * 2;
constexpr size_t OFF_WI = OFF_KI + (size_t)T_ * 64 * 2;
constexpr size_t OFF_DT = OFF_WI + (size_t)T_ * 8 * 4;
constexpr size_t OFF_Z = OFF_DT + (size_t)T_ * 8 * 4;

constexpr size_t OFF_ST = OFF_Z + (size_t)T_ * 512 * 2;
constexpr size_t OFF_YP_ = OFF_ST + (size_t)16 * 16 * 8 * 64 * 128 * 4 + (size_t)16 * 16 * 8 * 128 * 4;
constexpr size_t OFF_X1 = OFF_ST;
constexpr size_t OFF_QP = OFF_MIX;
constexpr size_t OFF_EIDX = OFF_YP_ + (size_t)T_ * 512 * 2;
constexpr size_t OFF_GATE = OFF_EIDX + (size_t)T_ * 128 * 4;
constexpr size_t OFF_ACUM = OFF_ST + (size_t)16 * 16 * 8 * 64 * 128 * 4;
constexpr size_t OFF_YP = OFF_ACUM + (size_t)16 * 16 * 8 * 128 * 4;
static_assert(OFF_YP_ == OFF_YP, "alias");
constexpr size_t OFF_CC = OFF_YP + (size_t)T_ * 512 * 4;
constexpr size_t OFF_BAR = OFF_CC + (size_t)T_ * 256 * 2;
constexpr size_t OFF_XB = OFF_BAR + 256;
constexpr size_t OFF_H2Q = OFF_XB + 16384;
constexpr size_t OFF_SH = OFF_H2Q + (size_t)T_ * 1024;
constexpr size_t WS_END = OFF_SH + (size_t)T_ * 4;

constexpr int LDS_BYTES = 156672;

struct Params {
  const float* x; const float* c; const int* pos; const float* w_ada; const float* b_ada;
  const float* pre_mix_g; const float* post_mix_g; const float* w_in; const float* conv_w; const float* conv_b;
  const float* dt_bias; const float* a_log; const float* d_skip; const float* ssd_norm_g; const float* w_out;
  const float* pre_ffn_g; const float* post_ffn_g; const float* w_q; const float* sub_keys; const float* peer_u;
  const float* peer_v; float* out; unsigned char* ws;
};

__constant__ float c_inv_freq[32] = {
  1.000000000e+00f, 7.498942614e-01f, 5.623413324e-01f, 4.216965139e-01f, 3.162277639e-01f, 2.371373773e-01f, 1.778279394e-01f, 1.333521307e-01f,
  1.000000015e-01f, 7.498941571e-02f, 5.623413250e-02f, 4.216965288e-02f, 3.162277490e-02f, 2.371373773e-02f, 1.778279431e-02f, 1.333521493e-02f,
  9.999999776e-03f, 7.498941850e-03f, 5.623413250e-03f, 4.216964822e-03f, 3.162277630e-03f, 2.371373586e-03f, 1.778279431e-03f, 1.333521446e-03f,
  1.000000047e-03f, 7.498942432e-04f, 5.623413017e-04f, 4.216965172e-04f, 3.162277571e-04f, 2.371373703e-04f, 1.778279402e-04f, 1.333521504e-04f};

DEV int opaque_tid() { int t = threadIdx.x; asm volatile("" : "+v"(t)); return t; }
DEV u16 f2bf(float f) { unsigned u = __float_as_uint(f); u += 0x7FFFu + ((u >> 16) & 1u); return (u16)(u >> 16); }
DEV float bf2f(u16 h) { return __uint_as_float(((unsigned)h) << 16); }
DEV unsigned pack2(float a, float b) { unsigned r; asm("v_cvt_pk_bf16_f32 %0, %1, %2" : "=v"(r) : "v"(a), "v"(b)); return r; }
DEV float bflo(unsigned u) { return __uint_as_float(u << 16); }
DEV float bfhi(unsigned u) { return __uint_as_float(u & 0xFFFF0000u); }
DEV float wave_sum(float v) {
#pragma unroll
  for (int o = 32; o > 0; o >>= 1) v += __shfl_xor(v, o);
  return v;
}
#define DPP_ADD(v, ctrl, rmask) v += __int_as_float(__builtin_amdgcn_update_dpp(0, __float_as_int(v), ctrl, rmask, 0xF, false))
DEV float wave_sum63(float v) {
  DPP_ADD(v, 0xB1, 0xF);
  DPP_ADD(v, 0x4E, 0xF);
  DPP_ADD(v, 0x141, 0xF);
  DPP_ADD(v, 0x140, 0xF);
  DPP_ADD(v, 0x142, 0xA);
  DPP_ADD(v, 0x143, 0xC);
  return v;
}
DEV f32x16 mfma32(bf16x8 a, bf16x8 b, f32x16 c) { return __builtin_amdgcn_mfma_f32_32x32x16_bf16(a, b, c, 0, 0, 0); }
DEV f32x16 zero16() { f32x16 z;
#pragma unroll
  for (int i = 0; i < 16; i++) z[i] = 0.f;
  return z; }
DEV int rowmap(int reg, int hh) { return (reg & 3) + 8 * (reg >> 2) + 4 * hh; }
DEV float silu_f(float v) { return v / (1.f + expf(-v)); }
DEV unsigned ordkey(float f) { unsigned b = __float_as_uint(f); unsigned m = (unsigned)((int)b >> 31) | 0x80000000u; return b ^ m; }
DEV bf16x8 mk_frag(uint2 lo, uint2 hi) { union { uint4 u; bf16x8 v; } t; t.u = make_uint4(lo.x, lo.y, hi.x, hi.y); return t.v; }
DEV bf16x8 pack_frag(const f32x16& v, int base) {
  union { uint4 u; bf16x8 f; } t;
  t.u = make_uint4(pack2(v[base + 0], v[base + 1]), pack2(v[base + 2], v[base + 3]), pack2(v[base + 4], v[base + 5]), pack2(v[base + 6], v[base + 7]));
  return t.f;
}

DEV float4 ldmod(const float* mod, int off) {
  const float4 a = *(const float4*)(mod + off), b = *(const float4*)(mod + 98304 + off);
  return make_float4(a.x + b.x, a.y + b.y, a.z + b.z, a.w + b.w);
}
DEV void phase_mod(const Params& p, char* smem) {
  float* s_silu = (float*)smem;
  float* s_red = (float*)(smem + 32768);
  float* mod = (float*)(p.ws + OFF_MOD);
  const int tid = threadIdx.x;
  for (int item = blockIdx.x; item < 192; item += gridDim.x) {
    const int cgp = item >> 1, ks = item & 1;
    __syncthreads();
    for (int e = tid; e < 8192; e += NT) { int b = e >> 9, i = e & 511; s_silu[i * 16 + b] = silu_f(p.c[b * 1024 + ks * 512 + i]); }
    __syncthreads();
    const int kg = tid >> 6, col = tid & 63;
    float acc[16];
#pragma unroll
    for (int b = 0; b < 16; b++) acc[b] = 0.f;
    const float* w = p.w_ada + (size_t)(ks * 512 + kg * 64) * 6144 + cgp * 64 + col;
#pragma unroll 1
    for (int i0 = 0; i0 < 64; i0 += 16) {
      float wreg[16];
#pragma unroll
      for (int u = 0; u < 16; u++) wreg[u] = w[(size_t)(i0 + u) * 6144];
#pragma unroll
      for (int u = 0; u < 16; u++) {
        const float wv = wreg[u];
        const float4* sp = (const float4*)(s_silu + (kg * 64 + i0 + u) * 16);
        float4 s0 = sp[0], s1 = sp[1], s2 = sp[2], s3 = sp[3];
        acc[0] += s0.x * wv; acc[1] += s0.y * wv; acc[2] += s0.z * wv; acc[3] += s0.w * wv;
        acc[4] += s1.x * wv; acc[5] += s1.y * wv; acc[6] += s1.z * wv; acc[7] += s1.w * wv;
        acc[8] += s2.x * wv; acc[9] += s2.y * wv; acc[10] += s2.z * wv; acc[11] += s2.w * wv;
        acc[12] += s3.x * wv; acc[13] += s3.y * wv; acc[14] += s3.z * wv; acc[15] += s3.w * wv;
      }
    }
#pragma unroll
    for (int b = 0; b < 16; b++) s_red[(kg * 64 + col) * 16 + b] = acc[b];
    __syncthreads();
    for (int e = tid; e < 1024; e += NT) {
      int cc = e >> 4, b = e & 15; float sum = 0.f;
#pragma unroll
      for (int k = 0; k < 8; k++) sum += s_red[(k * 64 + cc) * 16 + b];
      int j = cgp * 64 + cc;
      mod[ks * 98304 + b * 6144 + j] = sum + (ks == 0 ? p.b_ada[j] : 0.f);
    }
  }
}

DEV int remap_col(int n) {
  if (n < 1344) return n;
  if (n < 1352) return 2880 + (n - 1344);
  if (n < 2888) return n - 8;
  return n;
}

DEV void transpose_convert(const float* __restrict__ src, int N, u16* __restrict__ dst, bool remap, char* smem) {
  float* tile = (float*)smem;
  const int tid = threadIdx.x;
  const int ntn = (N + 63) >> 6;
  const int nitems = 16 * ntn;
#define TC_LOAD(V, IT) { const int kt_ = (IT) / ntn, nt_ = (IT) - kt_ * ntn; _Pragma("unroll") for (int j_ = 0; j_ < 8; j_++) { const int e_ = tid + j_ * NT; \
      const int r_ = e_ >> 6, n_ = nt_ * 64 + (e_ & 63); V[j_] = (n_ < N) ? src[(size_t)(kt_ * 64 + r_) * N + n_] : 0.f; } }
  float v[8], vn[8];
  int item = blockIdx.x;
  if (item < nitems) TC_LOAD(v, item);
  for (; item < nitems; item += gridDim.x) {
    const int kt = item / ntn, nt = item - kt * ntn;
    const int k0 = kt * 64, n0 = nt * 64;
    const int nxt = item + gridDim.x;
    if (nxt < nitems) TC_LOAD(vn, nxt);
    __syncthreads();
#pragma unroll
    for (int j = 0; j < 8; j++) { const int e = tid + j * NT; tile[(e >> 6) * 65 + (e & 63)] = v[j]; }
    __syncthreads();
    for (int e = tid; e < 1024; e += NT) {
      const int kq = e & 15, nn = e >> 4, n = n0 + nn;
      if (n < N) {
        const int n2 = remap ? remap_col(n) : n;
        const float* tp = tile + (4 * kq) * 65 + nn;
        *(uint2*)(dst + (size_t)n2 * 1024 + k0 + 4 * kq) = make_uint2(pack2(tp[0], tp[65]), pack2(tp[130], tp[195]));
      }
    }
#pragma unroll
    for (int j = 0; j < 8; j++) v[j] = vn[j];
  }
#undef TC_LOAD
}

DEV void convert_bf16(const float* __restrict__ src, u16* __restrict__ dst, size_t n8) {
  const size_t g = (size_t)blockIdx.x * NT + threadIdx.x, gs = (size_t)gridDim.x * NT;
  for (size_t i = g; i < n8; i += gs) {
    const float4 a = ((const float4*)src)[2 * i], b = ((const float4*)src)[2 * i + 1];
    ((uint4*)dst)[i] = make_uint4(pack2(a.x, a.y), pack2(a.z, a.w), pack2(b.x, b.y), pack2(b.z, b.w));
  }
}

DEV void convert_fp8_rows(const float* __restrict__ src, unsigned char* __restrict__ dst, float* __restrict__ scl) {
  const int tid_ = opaque_tid(); const int lane = tid_ & 63, wave = __builtin_amdgcn_readfirstlane(tid_ >> 6);
  for (int e0 = ((blockIdx.x >> 1) * 8 + wave) * 4 + (blockIdx.x & 1) * 8192; e0 < 8192 + (blockIdx.x & 1) * 8192; e0 += (gridDim.x >> 1) * 32) {
    float4 v[4][4];
#pragma unroll
    for (int u = 0; u < 4; u++)
#pragma unroll
      for (int j = 0; j < 4; j++) v[u][j] = *(const float4*)(src + (size_t)(e0 + u) * 1024 + j * 256 + lane * 4);
#pragma unroll
    for (int u = 0; u < 4; u++) {
      float mx = 0.f;
#pragma unroll
      for (int j = 0; j < 4; j++) mx = fmaxf(mx, fmaxf(fmaxf(fabsf(v[u][j].x), fabsf(v[u][j].y)), fmaxf(fabsf(v[u][j].z), fabsf(v[u][j].w))));
#pragma unroll
      for (int o = 32; o > 0; o >>= 1) mx = fmaxf(mx, __shfl_xor(mx, o));
      const float inv = (mx > 0.f) ? 384.f / mx : 0.f;
      int wd[4];
#pragma unroll
      for (int j = 0; j < 4; j++) {
        int t = 0;
        t = __builtin_amdgcn_cvt_pk_fp8_f32(v[u][j].x * inv, v[u][j].y * inv, t, false);
        t = __builtin_amdgcn_cvt_pk_fp8_f32(v[u][j].z * inv, v[u][j].w * inv, t, true);
        wd[j] = t;
      }
      *(uint4*)(dst + (size_t)(lane >> 3) * (16384 * 128) + (size_t)(e0 + u) * 128 + (lane & 7) * 16) = make_uint4((unsigned)wd[0], (unsigned)wd[1], (unsigned)wd[2], (unsigned)wd[3]);
      if (lane == 0) scl[e0 + u] = mx * (1.f / 384.f);
    }
  }
}

DEV unsigned pack_i8x4(float a, float b, float c, float d) {
  const int ia = (int)rintf(a), ib = (int)rintf(b), ic = (int)rintf(c), id = (int)rintf(d);
  return (unsigned)(ia & 255) | ((unsigned)(ib & 255) << 8) | ((unsigned)(ic & 255) << 16) | ((unsigned)id << 24);
}
DEV void convert_i8_rows(const float* __restrict__ src, unsigned char* __restrict__ dst, float* __restrict__ scl) {
  const int tid_ = opaque_tid(); const int lane = tid_ & 63, wave = __builtin_amdgcn_readfirstlane(tid_ >> 6);
  for (int e0 = ((blockIdx.x >> 1) * 8 + wave) * 4 + (blockIdx.x & 1) * 8192; e0 < 8192 + (blockIdx.x & 1) * 8192; e0 += (gridDim.x >> 1) * 32) {
    float4 v[4][4];
#pragma unroll
    for (int u = 0; u < 4; u++)
#pragma unroll
      for (int j = 0; j < 4; j++) v[u][j] = *(const float4*)(src + (size_t)(e0 + u) * 1024 + j * 256 + lane * 4);
#pragma unroll
    for (int u = 0; u < 4; u++) {
      float mx = 0.f;
#pragma unroll
      for (int j = 0; j < 4; j++) mx = fmaxf(mx, fmaxf(fmaxf(fabsf(v[u][j].x), fabsf(v[u][j].y)), fmaxf(fabsf(v[u][j].z), fabsf(v[u][j].w))));
#pragma unroll
      for (int o = 32; o > 0; o >>= 1) mx = fmaxf(mx, __shfl_xor(mx, o));
      const float inv = (mx > 0.f) ? 127.f / mx : 0.f;
      unsigned wd[4];
#pragma unroll
      for (int j = 0; j < 4; j++) wd[j] = pack_i8x4(v[u][j].x * inv, v[u][j].y * inv, v[u][j].z * inv, v[u][j].w * inv);
      *(uint4*)(dst + (size_t)(e0 + u) * 1024 + lane * 16) = make_uint4(wd[0], wd[1], wd[2], wd[3]);
      if (lane == 0) scl[e0 + u] = mx * (1.f / 127.f);
    }
  }
}

DEV void phase0(const Params& p, char* smem) {
  {
    float* cosT = (float*)(p.ws + OFF_COS); float* sinT = (float*)(p.ws + OFF_SIN);
    const int g = blockIdx.x * NT + threadIdx.x, gs = gridDim.x * NT;
    for (int e = g; e < T_ * 32; e += gs) {
      int t = e >> 5, j = e & 31;
      float ang = (float)p.pos[t] * c_inv_freq[j];
      double rev = (double)ang * 0.15915494309189533577;
      rev -= rint(rev);
      float fr = (float)rev;
      cosT[e] = __builtin_amdgcn_cosf(fr);
      sinT[e] = __builtin_amdgcn_sinf(fr);
    }
  }
  transpose_convert(p.w_in, NPROJ, (u16*)(p.ws + OFF_WTIN), true, smem);
  {
    uint4* z = (uint4*)(p.ws + OFF_WTIN + (size_t)NPROJ * 1024 * 2);
    const int n = (NPAD - NPROJ) * 1024 * 2 / 16;
    for (int i = blockIdx.x * NT + threadIdx.x; i < n; i += gridDim.x * NT) z[i] = make_uint4(0, 0, 0, 0);
  }
  transpose_convert(p.w_out, 1024, (u16*)(p.ws + OFF_WTOUT), false, smem);
  transpose_convert(p.w_q, 1024, (u16*)(p.ws + OFF_WTQ), false, smem);
  convert_bf16(p.sub_keys, (u16*)(p.ws + OFF_SK), (size_t)16 * 128 * 64 / 8);
}

DEV void phase_hnorm(const Params& p) {
  const int tid_ = opaque_tid(); const int lane = tid_ & 63, wave = __builtin_amdgcn_readfirstlane(tid_ >> 6);
  const float* mod = (const float*)(p.ws + OFF_MOD);
  u16* h = (u16*)(p.ws + OFF_HBUF);
  for (int t0 = (blockIdx.x * 8 + wave) * 16; t0 < T_; t0 += gridDim.x * 128) {
    const int b = t0 >> 11;
    float4 gm[4], sh[4];
#pragma unroll
    for (int i = 0; i < 4; i++) {
      const int col = (i * 64 + lane) * 4;
      const float4 g = *(const float4*)(p.pre_mix_g + col);
      const float4 sc = ldmod(mod, b * 6144 + 1024 + col);
      sh[i] = ldmod(mod, b * 6144 + col);
      gm[i] = make_float4(g.x * (1.f + sc.x), g.y * (1.f + sc.y), g.z * (1.f + sc.z), g.w * (1.f + sc.w));
    }
#pragma unroll 2
    for (int r_ = 0; r_ < 16; r_++) {
      const int t = t0 + r_;
      const float4* xr = (const float4*)(p.x + (size_t)t * 1024);
      float4 v[4]; float ss = 0.f;
#pragma unroll
      for (int i = 0; i < 4; i++) { v[i] = xr[i * 64 + lane]; ss += v[i].x * v[i].x + v[i].y * v[i].y + v[i].z * v[i].z + v[i].w * v[i].w; }
      ss = wave_sum(ss);
      const float rstd = rsqrtf(ss * (1.f / 1024.f) + 1e-6f);
#pragma unroll
      for (int i = 0; i < 4; i++) {
        const int col = (i * 64 + lane) * 4;
        const float y0 = (v[i].x * rstd) * gm[i].x + sh[i].x, y1 = (v[i].y * rstd) * gm[i].y + sh[i].y;
        const float y2 = (v[i].z * rstd) * gm[i].z + sh[i].z, y3 = (v[i].w * rstd) * gm[i].w + sh[i].w;
        *(uint2*)(h + (size_t)t * 1024 + col) = make_uint2(pack2(y0, y1), pack2(y2, y3));
      }
    }
  }
}

constexpr int G_ROWB = 144;
constexpr int G_ABYTES = 128 * G_ROWB;
constexpr int G_STAGE = (128 + 256) * G_ROWB;
constexpr int G_SROW = 68;

template <class Epi>
DEV void gemm_tile(const u16* __restrict__ A, int lda, const u16* __restrict__ Bt, int ldb, int K, char* smem, Epi& epi) {
  const int tid = opaque_tid(), lane = tid & 63, wave = __builtin_amdgcn_readfirstlane(tid >> 6), wm = wave >> 2, wn = wave & 3;
  const int r = lane & 31, hh = lane >> 5;
  f32x16 acc00 = zero16(), acc01 = zero16(), acc10 = zero16(), acc11 = zero16();
  uint4 pa0, pa1, pb0, pb1, pb2, pb3;
  uint4 qa0, qa1, qb0, qb1, qb2, qb3;
  const int crow = tid >> 3, ckc = tid & 7;
  const u16* Ap = A + (size_t)crow * lda + ckc * 8;
  const u16* Bp = Bt + (size_t)crow * ldb + ckc * 8;
  const size_t a64 = (size_t)64 * lda, b64 = (size_t)64 * ldb;
  const int loff = crow * G_ROWB + ckc * 16;
#define G_LOAD(S, k0) { S##a0 = *(const uint4*)(Ap + (k0)); S##a1 = *(const uint4*)(Ap + a64 + (k0)); \
    S##b0 = *(const uint4*)(Bp + (k0)); S##b1 = *(const uint4*)(Bp + b64 + (k0)); S##b2 = *(const uint4*)(Bp + 2 * b64 + (k0)); S##b3 = *(const uint4*)(Bp + 3 * b64 + (k0)); }
#define G_STORE(S, buf) { char* sb_ = smem + (buf) * G_STAGE + loff; *(uint4*)(sb_) = S##a0; *(uint4*)(sb_ + 64 * G_ROWB) = S##a1; \
    char* sc_ = sb_ + G_ABYTES; *(uint4*)(sc_) = S##b0; *(uint4*)(sc_ + 64 * G_ROWB) = S##b1; *(uint4*)(sc_ + 128 * G_ROWB) = S##b2; *(uint4*)(sc_ + 192 * G_ROWB) = S##b3; }
#define G_COMPUTE(buf) { const char* sb = smem + (buf) * G_STAGE; _Pragma("unroll") for (int s = 0; s < 4; s++) { \
      const bf16x8 a0 = *(const bf16x8*)(sb + aoff + s * 32); const bf16x8 a1 = *(const bf16x8*)(sb + aoff + 32 * G_ROWB + s * 32); \
      const bf16x8 b0 = *(const bf16x8*)(sb + boff + s * 32); const bf16x8 b1 = *(const bf16x8*)(sb + boff + 32 * G_ROWB + s * 32); \
      acc00 = mfma32(a0, b0, acc00); acc01 = mfma32(a0, b1, acc01); acc10 = mfma32(a1, b0, acc10); acc11 = mfma32(a1, b1, acc11); } }
  const int nk = K >> 6;
  const int aoff = (wm * 64 + r) * G_ROWB + hh * 16;
  const int boff = G_ABYTES + (wn * 64 + r) * G_ROWB + hh * 16;
  G_LOAD(p, 0); G_LOAD(q, 64);
  __syncthreads();
  G_STORE(p, 0);
  __syncthreads();
  for (int kt = 0; kt < nk; kt += 2) {
    if (kt + 2 < nk) G_LOAD(p, (kt + 2) * 64);
    G_COMPUTE(0);
    G_STORE(q, 1);
    __syncthreads();
    if (kt + 3 < nk) G_LOAD(q, (kt + 3) * 64);
    G_COMPUTE(1);
    if (kt + 2 < nk) G_STORE(p, 0);
    __syncthreads();
  }
#undef G_LOAD
#undef G_STORE
#undef G_COMPUTE
  {
    float* stage = (float*)(smem + wave * (64 * G_SROW * 4));
#pragma unroll
    for (int reg = 0; reg < 16; reg++) {
      const int row = (reg & 3) + 8 * (reg >> 2) + 4 * hh;
      stage[row * G_SROW + r] = acc00[reg];
      stage[row * G_SROW + 32 + r] = acc01[reg];
      stage[(32 + row) * G_SROW + r] = acc10[reg];
      stage[(32 + row) * G_SROW + 32 + r] = acc11[reg];
    }
    epi.apply(stage, wm * 64, wn * 64, lane);
  }
}

DEV void ld16(const float* src, float* x) {
  const float4 a = *(const float4*)src, b = *(const float4*)(src + 4), c = *(const float4*)(src + 8), d = *(const float4*)(src + 12);
  x[0] = a.x; x[1] = a.y; x[2] = a.z; x[3] = a.w; x[4] = b.x; x[5] = b.y; x[6] = b.z; x[7] = b.w;
  x[8] = c.x; x[9] = c.y; x[10] = c.z; x[11] = c.w; x[12] = d.x; x[13] = d.y; x[14] = d.z; x[15] = d.w;
}
DEV void st16_bf(u16* dst, const float* x) {
  *(uint4*)dst = make_uint4(pack2(x[0], x[1]), pack2(x[2], x[3]), pack2(x[4], x[5]), pack2(x[6], x[7]));
  *(uint4*)(dst + 8) = make_uint4(pack2(x[8], x[9]), pack2(x[10], x[11]), pack2(x[12], x[13]), pack2(x[14], x[15]));
}
DEV void st16_f(float* dst, const float* x) {
  *(float4*)dst = make_float4(x[0], x[1], x[2], x[3]); *(float4*)(dst + 4) = make_float4(x[4], x[5], x[6], x[7]);
  *(float4*)(dst + 8) = make_float4(x[8], x[9], x[10], x[11]); *(float4*)(dst + 12) = make_float4(x[12], x[13], x[14], x[15]);
}

struct EpiInProj {
  const Params* p; int m0, n0;
  DEV void apply(const float* stage, int rbase, int cbase, int lane) { apply_s<G_SROW>(stage, rbase, cbase, lane); }
  template <int SROW>
  DEV void apply_s(const float* stage, int rbase, int cbase, int lane) {
    const int nb = n0 + cbase;
    unsigned char* ws = p->ws;
    const int tb = m0 + rbase;
    if (nb < 640 || (nb >= 768 && nb < 1344)) {
      u16* dst; int ld, cb;
      if (nb < 512) { dst = (u16*)(ws + OFF_Q); ld = 512; cb = nb; }
      else if (nb < 640) { dst = (u16*)(ws + OFF_K); ld = 128; cb = nb - 512; }
      else if (nb < 1280) { dst = (u16*)(ws + OFF_QI); ld = 512; cb = nb - 768; }
      else { dst = (u16*)(ws + OFF_KI); ld = 64; cb = 0; }
      const float* cosT = (const float*)(ws + OFF_COS); const float* sinT = (const float*)(ws + OFF_SIN);
      const int cg = lane & 1;
#pragma unroll 1
      for (int i = 0; i < 2; i++) {
        const int row = (lane >> 1) + 32 * i; const int t = tb + row;
        float x1[16], x2[16], cs[16], sn[16], o1[16], o2[16];
        ld16(stage + row * SROW + cg * 16, x1); ld16(stage + row * SROW + 32 + cg * 16, x2);
        ld16(cosT + (size_t)t * 32 + cg * 16, cs); ld16(sinT + (size_t)t * 32 + cg * 16, sn);
#pragma unroll
        for (int k = 0; k < 16; k++) { o1[k] = x1[k] * cs[k] - x2[k] * sn[k]; o2[k] = x2[k] * cs[k] + x1[k] * sn[k]; }
        st16_bf(dst + (size_t)t * ld + cb + cg * 16, o1); st16_bf(dst + (size_t)t * ld + cb + 32 + cg * 16, o2);
      }
    } else if (nb >= 640 && nb < 768) {
      u16* vt = (u16*)(ws + OFF_VT);
      const int kvh = (nb - 640) >> 6;
      const int b = tb >> 11, s0 = tb & 2047;
      u16* dp = vt + ((size_t)(b * 2 + kvh) * 64 + lane) * SV_ + s0;
#pragma unroll 1
      for (int q8 = 0; q8 < 8; q8++) {
        float x[8];
#pragma unroll
        for (int k = 0; k < 8; k++) x[k] = stage[(q8 * 8 + k) * SROW + lane];
        *(uint4*)(dp + q8 * 8) = make_uint4(pack2(x[0], x[1]), pack2(x[2], x[3]), pack2(x[4], x[5]), pack2(x[6], x[7]));
      }
    } else if (nb >= 1344 && nb < 2880) {
      u16* dst; int ld, cb;
      if (nb < 1856) { dst = (u16*)(ws + OFF_Z); ld = 512; cb = nb - 1344; }
      else { dst = (u16*)(ws + OFF_XBC); ld = 1024; cb = nb - 1856; }
      const int cg = lane & 1;
#pragma unroll 1
      for (int i = 0; i < 2; i++) {
        const int row = (lane >> 1) + 32 * i; const int t = tb + row;
        float x1[16], x2[16];
        ld16(stage + row * SROW + cg * 16, x1); ld16(stage + row * SROW + 32 + cg * 16, x2);
        st16_bf(dst + (size_t)t * ld + cb + cg * 16, x1); st16_bf(dst + (size_t)t * ld + cb + 32 + cg * 16, x2);
      }
    } else if (nb == 2880) {
      float* wi = (float*)(ws + OFF_WI); float* dtr = (float*)(ws + OFF_DT);
      const int t = tb + lane;
      float x[16];
      ld16(stage + lane * SROW, x);
      const float sc = 0.044194173824159216f;
      *(float4*)(wi + (size_t)t * 8) = make_float4(x[0] * sc, x[1] * sc, x[2] * sc, x[3] * sc);
      *(float4*)(wi + (size_t)t * 8 + 4) = make_float4(x[4] * sc, x[5] * sc, x[6] * sc, x[7] * sc);
      *(float4*)(dtr + (size_t)t * 8) = make_float4(x[8], x[9], x[10], x[11]);
      *(float4*)(dtr + (size_t)t * 8 + 4) = make_float4(x[12], x[13], x[14], x[15]);
    }
  }
};

struct EpiStoreF32 {
  float* dst; int n0;
  DEV void apply(const float* stage, int rbase, int cbase, int lane) {
    const int cg = lane & 1;
#pragma unroll 1
    for (int i = 0; i < 2; i++) {
      const int row = (lane >> 1) + 32 * i;
      float x1[16], x2[16];
      ld16(stage + row * G_SROW + cg * 16, x1); ld16(stage + row * G_SROW + 32 + cg * 16, x2);
      float* d = dst + (size_t)(rbase + row) * 1024 + n0 + cbase + cg * 16;
      st16_f(d, x1); st16_f(d + 32, x2);
    }
  }
};
struct EpiStoreBf16 {
  u16* dst; int n0;
  DEV void apply(const float* stage, int rbase, int cbase, int lane) {
    const int cg = lane & 1;
#pragma unroll 1
    for (int i = 0; i < 2; i++) {
      const int row = (lane >> 1) + 32 * i;
      float x1[16], x2[16];
      ld16(stage + row * G_SROW + cg * 16, x1); ld16(stage + row * G_SROW + 32 + cg * 16, x2);
      u16* d = dst + (size_t)(rbase + row) * 1024 + n0 + cbase + cg * 16;
      st16_bf(d, x1); st16_bf(d + 32, x2);
    }
  }
};

typedef __attribute__((ext_vector_type(4))) float f32x4v;
constexpr int P8_HT = 128 * 64;
constexpr int P8_SROW = 260;
DEV int p8_lds_byte(int r, int c) {
  const int st = (r >> 4) * 2 + (c >> 5), rr = r & 15, cc = c & 31, ob = rr * 64 + cc * 2;
  return st * 1024 + (ob ^ (((ob >> 9) & 1) << 5));
}
DEV void p8_stage_rc(int b, int& R, int& C) {
  const int st = b / 1024, sb = b % 1024, swz = sb ^ (((sb >> 9) & 1) << 5);
  R = (st >> 1) * 16 + swz / 64; C = (st & 1) * 32 + (swz % 64) / 2;
}
template <class Epi>
DEV void gemm256_8phase(const u16* __restrict__ A, const u16* __restrict__ Bt, int brow, int bcol, char* smem, Epi& epi) {
  constexpr int K = 1024, BK = 64, HALF = 128;
  u16* shm = (u16*)smem;
  const int tid = opaque_tid();
#define SA(b,h) (shm+((b)*2+(h))*P8_HT)
#define SB(b,h) (shm+(4+(b)*2+(h))*P8_HT)
#define P8STAGE(P,BASE,br,kt) do{ const long _g=(long)(br)*K+(long)(kt)*BK; \
    _Pragma("unroll") for(int _i=0;_i<2;++_i){ const int _b=tid*16+_i*8192; int _r,_c; p8_stage_rc(_b,_r,_c); \
      __builtin_amdgcn_global_load_lds((const unsigned*)(BASE+_g+(long)_r*K+_c), (__attribute__((address_space(3))) unsigned*)((char*)(P)+_b),16,0,0);} }while(0)
#define LDA(dst,b,h) _Pragma("unroll") for(int m=0;m<4;++m) _Pragma("unroll") for(int k=0;k<2;++k) \
    dst[m][k]=*reinterpret_cast<const bf16x8*>((char*)SA(b,h)+p8_lds_byte(wr*64+m*16+fr,k*32+fq*8))
#define LDB(dst,b,h) _Pragma("unroll") for(int n=0;n<2;++n) _Pragma("unroll") for(int k=0;k<2;++k) \
    dst[n][k]=*reinterpret_cast<const bf16x8*>((char*)SB(b,h)+p8_lds_byte(wc*32+n*16+fr,k*32+fq*8))
#define MMA(ai,bj,At,Bt_) do{ __builtin_amdgcn_s_setprio(1); \
    _Pragma("unroll") for(int m=0;m<4;++m) _Pragma("unroll") for(int n=0;n<2;++n) _Pragma("unroll") for(int k=0;k<2;++k) \
      acc[ai][bj][m][n]=__builtin_amdgcn_mfma_f32_16x16x32_bf16(At[m][k],Bt_[n][k],acc[ai][bj][m][n],0,0,0); \
    __builtin_amdgcn_s_setprio(0);}while(0)
#define WAIT_V(n) asm volatile("s_waitcnt vmcnt(" #n ")":::"memory")
#define WAIT_L(n) asm volatile("s_waitcnt lgkmcnt(" #n ")":::"memory")
#define BAR __builtin_amdgcn_s_barrier()
#define SCHED __builtin_amdgcn_sched_barrier(0)
  const int wid = __builtin_amdgcn_readfirstlane(tid >> 6), lane = tid & 63, wr = wid >> 2, wc = wid & 3, fr = lane & 15, fq = lane >> 4;
  f32x4v acc[2][2][4][2];
#pragma unroll
  for (int a_ = 0; a_ < 2; a_++)
#pragma unroll
    for (int b_ = 0; b_ < 2; b_++)
#pragma unroll
      for (int m = 0; m < 4; m++)
#pragma unroll
        for (int n = 0; n < 2; n++) acc[a_][b_][m][n] = (f32x4v){0.f, 0.f, 0.f, 0.f};
  bf16x8 At[4][2], B0[2][2], B1[2][2];
  constexpr int nt = K / BK;
  asm volatile("s_waitcnt vmcnt(0) lgkmcnt(0)" ::: "memory");
  __syncthreads();
  P8STAGE(SB(0,0),Bt,bcol,0); P8STAGE(SA(0,0),A,brow,0);
  P8STAGE(SB(0,1),Bt,bcol+HALF,0); P8STAGE(SA(0,1),A,brow+HALF,0);
  if(wr==1)BAR;
  WAIT_V(4); BAR;
  P8STAGE(SB(1,0),Bt,bcol,1); P8STAGE(SA(1,0),A,brow,1); P8STAGE(SB(1,1),Bt,bcol+HALF,1);
  WAIT_V(6); BAR;
#pragma unroll 1
  for(int t=0;t<nt-2;t+=2){
    LDB(B0,0,0); SCHED; LDA(At,0,0); P8STAGE(SA(1,1),A,brow+HALF,t+1);
    WAIT_L(8); BAR; WAIT_L(0); MMA(0,0,At,B0); BAR; SCHED;
    LDB(B1,0,1); P8STAGE(SB(0,0),Bt,bcol,t+2);
    BAR; WAIT_L(0); MMA(0,1,At,B1); BAR;
    LDA(At,0,1); P8STAGE(SA(0,0),A,brow,t+2);
    BAR; WAIT_L(0); MMA(1,0,At,B0); BAR; SCHED;
    P8STAGE(SB(0,1),Bt,bcol+HALF,t+2);
    WAIT_V(6); BAR; MMA(1,1,At,B1); BAR;
    LDB(B0,1,0); SCHED; LDA(At,1,0); P8STAGE(SA(0,1),A,brow+HALF,t+2);
    WAIT_L(8); BAR; WAIT_L(0); MMA(0,0,At,B0); BAR; SCHED;
    LDB(B1,1,1); P8STAGE(SB(1,0),Bt,bcol,t+3);
    BAR; WAIT_L(0); MMA(0,1,At,B1); BAR;
    LDA(At,1,1); P8STAGE(SA(1,0),A,brow,t+3);
    BAR; WAIT_L(0); MMA(1,0,At,B0); BAR; SCHED;
    P8STAGE(SB(1,1),Bt,bcol+HALF,t+3);
    WAIT_V(6); BAR; MMA(1,1,At,B1); BAR;
  }
  { LDB(B0,0,0); LDA(At,0,0); P8STAGE(SA(1,1),A,brow+HALF,nt-1);
    BAR; WAIT_L(0); MMA(0,0,At,B0); BAR;
    LDB(B1,0,1); BAR; WAIT_L(0); MMA(0,1,At,B1); BAR;
    LDA(At,0,1); WAIT_V(4); BAR; WAIT_L(0); MMA(1,0,At,B0); MMA(1,1,At,B1); BAR; }
  { LDB(B0,1,0); LDA(At,1,0); WAIT_V(2); BAR; WAIT_L(0); MMA(0,0,At,B0); BAR;
    LDB(B1,1,1); WAIT_V(0); BAR; WAIT_L(0); MMA(0,1,At,B1); BAR;
    LDA(At,1,1); BAR; WAIT_L(0); MMA(1,0,At,B0); MMA(1,1,At,B1); BAR; }
  if(wr==0)BAR;
  float* img = (float*)smem;
#pragma unroll
  for (int ai = 0; ai < 2; ai++) {
    __syncthreads();
#pragma unroll
    for (int bj = 0; bj < 2; bj++)
#pragma unroll
      for (int m = 0; m < 4; m++)
#pragma unroll
        for (int n = 0; n < 2; n++)
#pragma unroll
          for (int j = 0; j < 4; j++)
            img[(wr * 64 + m * 16 + fq * 4 + j) * P8_SROW + bj * HALF + wc * 32 + n * 16 + fr] = acc[ai][bj][m][n][j];
    __syncthreads();
    epi.template apply_s<P8_SROW>(img + (wid >> 2) * 64 * P8_SROW + (wid & 3) * 64, ai * 128 + (wid >> 2) * 64, (wid & 3) * 64, lane);
  }
  __syncthreads();
#undef SA
#undef SB
#undef P8STAGE
#undef LDA
#undef LDB
#undef MMA
#undef WAIT_V
#undef WAIT_L
#undef BAR
#undef SCHED
}

DEV void phase1(const Params& p, char* smem) {
  const u16* h = (const u16*)(p.ws + OFF_HBUF);
  const u16* wt = (const u16*)(p.ws + OFF_WTIN);
  if (gridDim.x != 256 && (blockIdx.x & 1)) convert_i8_rows(p.peer_u, p.ws + OFF_U, (float*)(p.ws + OFF_SU));
  const int ntiles = 128 * 12;
  for (int tile = blockIdx.x; tile < ntiles; tile += gridDim.x) {
    const int mt = tile % 128, nt = tile / 128;
    EpiInProj epi{&p, mt * 256, nt * 256};
    gemm256_8phase(h, wt, mt * 256, nt * 256, smem, epi);
  }
  if (gridDim.x != 256 && !(blockIdx.x & 1)) convert_i8_rows(p.peer_u, p.ws + OFF_U, (float*)(p.ws + OFF_SU));
}

constexpr int DS_QROW = 1040;
constexpr int DS_CNT = 32 * DS_QROW;
constexpr int DS_MASK = DS_CNT + 2 * 8 * 32 * 4;
constexpr int DS_WQ = DS_MASK + 64 * 64 * 2;
constexpr int DS_KV = DS_WQ + 1024;
constexpr int DS_VROW = 80;
constexpr int DS_KVSTAGE = 2 * 32 * 144 + 2 * 64 * DS_VROW;
constexpr int DS_VOFF = 2 * 32 * 144;

DEV int dsa_reduce(int c, unsigned* cbuf, int& par, int r, int hh, int w) {
  c += __shfl_xor(c, 32);
  unsigned* bq = cbuf + par * 256;
  if (hh == 0) bq[w * 32 + r] = (unsigned)c;
  __syncthreads();
  int tot = 0;
#pragma unroll
  for (int k = 0; k < 8; k++) tot += (int)bq[k * 32 + r];
  par ^= 1;
  return tot;
}

DEV void dsa_item(const Params& p, int b, int qt, char* smem) {
  const int tid = opaque_tid(), lane = tid & 63, w = __builtin_amdgcn_readfirstlane(tid >> 6), r = lane & 31, hh = lane >> 5;
  const int q0 = qt * 32; const size_t tb = (size_t)b * 2048;
  const u16* qi = (const u16*)(p.ws + OFF_QI);
  const u16* ki = (const u16*)(p.ws + OFF_KI);
  const float* wi = (const float*)(p.ws + OFF_WI);
  unsigned* cbuf = (unsigned*)(smem + DS_CNT);
  u16* maskb = (u16*)(smem + DS_MASK);
  const bool need_sel = (qt >= 8);
  __syncthreads();
  if (need_sel) {
#pragma unroll
    for (int i = 0; i < 4; i++) {
      int c = tid + i * 512; int row = c >> 6, cc = c & 63;
      *(uint4*)(smem + row * DS_QROW + cc * 16) = *(const uint4*)(qi + (tb + q0 + row) * 512 + cc * 8);
    }
    if (tid < 256) ((float*)(smem + DS_WQ))[tid] = wi[(tb + q0) * 8 + tid];
  }
  __syncthreads();
  if (need_sel) {
    const float* wql = (const float*)(smem + DS_WQ) + r * 8;
    u32x16 uk[8];
#pragma unroll
    for (int i = 0; i < 8; i++) {
      const int kt = w + 8 * i;
      if (kt <= qt) {
        const u16* kp = ki + (tb + kt * 32 + r) * 64 + hh * 8;
        bf16x8 ka[4];
#pragma unroll
        for (int s = 0; s < 4; s++) ka[s] = *(const bf16x8*)(kp + s * 16);
        f32x16 scr = zero16();
        f32x16 aE, aO;
        bf16x8 q0, q1, q2, q3;
        const char* qbase = smem + r * DS_QROW + hh * 16;
#define SC_R4(acc_, wv_, r0_) { _Pragma("unroll") for (int reg = r0_; reg < r0_ + 4; reg++) scr[reg] = fmaf(wv_, __builtin_elementwise_maximum((float)acc_[reg], 0.f), scr[reg]); }
#define SC_STEP(accN_, accP_, hp_, hn_) { const float wv_ = wql[hp_]; \
          accN_ = mfma32(ka[0], q0, zero16()); SC_R4(accP_, wv_, 0) __builtin_amdgcn_sched_barrier(0); \
          accN_ = mfma32(ka[1], q1, accN_); SC_R4(accP_, wv_, 4) \
          if ((hn_) < 8) { q0 = *(const bf16x8*)(qbase + (hn_) * 128); q1 = *(const bf16x8*)(qbase + (hn_) * 128 + 32); } __builtin_amdgcn_sched_barrier(0); \
          accN_ = mfma32(ka[2], q2, accN_); SC_R4(accP_, wv_, 8) __builtin_amdgcn_sched_barrier(0); \
          accN_ = mfma32(ka[3], q3, accN_); SC_R4(accP_, wv_, 12) \
          if ((hn_) < 8) { q2 = *(const bf16x8*)(qbase + (hn_) * 128 + 64); q3 = *(const bf16x8*)(qbase + (hn_) * 128 + 96); } __builtin_amdgcn_sched_barrier(0); }
        q0 = *(const bf16x8*)(qbase); q1 = *(const bf16x8*)(qbase + 32); q2 = *(const bf16x8*)(qbase + 64); q3 = *(const bf16x8*)(qbase + 96);
        aE = mfma32(ka[0], q0, zero16()); aE = mfma32(ka[1], q1, aE);
        q0 = *(const bf16x8*)(qbase + 128); q1 = *(const bf16x8*)(qbase + 128 + 32);
        aE = mfma32(ka[2], q2, aE); aE = mfma32(ka[3], q3, aE);
        q2 = *(const bf16x8*)(qbase + 128 + 64); q3 = *(const bf16x8*)(qbase + 128 + 96);

#pragma unroll 1
        for (int hp2 = 0; hp2 < 6; hp2 += 2) {
          SC_STEP(aO, aE, hp2, hp2 + 2)
          SC_STEP(aE, aO, hp2 + 1, hp2 + 3)
        }
        SC_STEP(aO, aE, 6, 8)
        { const float wv_ = wql[7]; SC_R4(aO, wv_, 0) SC_R4(aO, wv_, 4) SC_R4(aO, wv_, 8) SC_R4(aO, wv_, 12) }
#undef SC_R4
#undef SC_STEP
#pragma unroll
        for (int reg = 0; reg < 16; reg++) {
          float v = scr[reg];
          if (kt == qt && ((reg & 3) + 8 * (reg >> 2)) > r - 4 * hh) v = NEG_INF;
          uk[i][reg] = ordkey(v);
        }
      } else {
#pragma unroll
        for (int reg = 0; reg < 16; reg++) uk[i][reg] = 0u;
      }
    }
    int par = 0;
    unsigned T = 0u;
    unsigned* lst = (unsigned*)(smem + DS_KV);
    unsigned* lcnt = (unsigned*)(smem + DS_KV + 16384);
    unsigned* lhic = lcnt + 32;
    unsigned* ltp = lcnt + 64;
    for (int rep_b = 0; rep_b < PROBE_DSA_BIS; rep_b++) {
    T = 0u;
    if (tid < 32) lcnt[tid] = 0u;
    for (int it = 0; it < 12; ++it) {
      const unsigned cand = T | (0x80000000u >> it);
      int c = 0;
#pragma unroll
      for (int i = 0; i < 8; i++) {
        if (w + 8 * i <= qt) {
#pragma unroll
          for (int reg = 0; reg < 16; reg++) c += (uk[i][reg] >= cand) ? 1 : 0;
        }
      }
      if (dsa_reduce(c, cbuf, par, r, hh, w) >= 256) T = cand;
    }
    int hic;
    {
      const bool ovf = (T >= 0xFFF00000u);
      const unsigned hi = T + 0x00100000u;
      int c = 0;
      if (!ovf) {
#pragma unroll
        for (int i = 0; i < 8; i++) {
          if (w + 8 * i <= qt) {
#pragma unroll
            for (int reg = 0; reg < 16; reg++) c += (uk[i][reg] >= hi) ? 1 : 0;
          }
        }
      }
      hic = dsa_reduce(c, cbuf, par, r, hh, w);
    }
#pragma unroll
    for (int i = 0; i < 8; i++) {
      if (w + 8 * i <= qt) {
#pragma unroll
        for (int reg = 0; reg < 16; reg++) {
          const unsigned d = uk[i][reg] - T;
          if (d < 0x00100000u) { const unsigned pos = atomicAdd(&lcnt[r], 1u); if (pos < 128u) lst[r * 128 + pos] = d; }
        }
      }
    }
    if (w == 0 && hh == 0) { lhic[r] = (unsigned)hic; ltp[r] = T; }
    __syncthreads();
    if (!__syncthreads_or(lcnt[r] > 128u)) {
      const int qsub = lane >> 4, l16 = lane & 15, q = 4 * w + qsub;
      const int n = (int)lcnt[q];
      const int kp = 256 - (int)lhic[q];
      unsigned v[8];
#pragma unroll
      for (int j = 0; j < 8; j++) { const int ix = l16 + 16 * j; v[j] = (ix < n) ? lst[q * 128 + ix] : 0u; }
      unsigned Tl = 0u;
#pragma unroll 1
      for (int bit = 19; bit >= 0; --bit) {
        const unsigned cand = Tl | (1u << bit);
        int c = 0;
#pragma unroll
        for (int j = 0; j < 8; j++) c += (v[j] >= cand) ? 1 : 0;
        c += __builtin_amdgcn_update_dpp(0, c, 0xB1, 0xF, 0xF, false);
        c += __builtin_amdgcn_update_dpp(0, c, 0x4E, 0xF, 0xF, false);
        c += __builtin_amdgcn_update_dpp(0, c, 0x141, 0xF, 0xF, false);
        c += __builtin_amdgcn_update_dpp(0, c, 0x140, 0xF, 0xF, false);
        if (c >= kp) Tl = cand;
      }
      const unsigned tq = ltp[q] | Tl;
      __syncthreads();
      if (l16 == 0) ltp[q] = tq;
      __syncthreads();
      T = ltp[r];
    } else {
      for (int it = 12; it < 32; ++it) {
        const unsigned cand = T | (0x80000000u >> it);
        int c = 0;
#pragma unroll
        for (int i = 0; i < 8; i++) {
          if (w + 8 * i <= qt) {
#pragma unroll
            for (int reg = 0; reg < 16; reg++) c += (uk[i][reg] >= cand) ? 1 : 0;
          }
        }
        if (dsa_reduce(c, cbuf, par, r, hh, w) >= 256) T = cand;
      }
    }
    }
    int cge;
    {
      int c = 0;
      unsigned Tv = T;
      asm volatile("" : "+v"(Tv));
#pragma unroll
      for (int i = 0; i < 8; i++) {
        if (w + 8 * i <= qt) {
#pragma unroll
          for (int reg = 0; reg < 16; reg++) c += (uk[i][reg] >= Tv) ? 1 : 0;
        }
      }
      cge = dsa_reduce(c, cbuf, par, r, hh, w);
    }
    unsigned J = 4095u;
    if (__syncthreads_or(cge != 256)) {
      int need;
      {
        int c = 0;
        unsigned Tv = T;
        asm volatile("" : "+v"(Tv));
#pragma unroll
        for (int i = 0; i < 8; i++) {
          if (w + 8 * i <= qt) {
#pragma unroll
            for (int reg = 0; reg < 16; reg++) c += (uk[i][reg] > Tv) ? 1 : 0;
          }
        }
        need = 256 - dsa_reduce(c, cbuf, par, r, hh, w);
      }
      J = 0u;
      for (int it = 0; it < 12; ++it) {
        const unsigned cj = J | (2048u >> it);
        int c = 0;
        unsigned Tv = T;
        asm volatile("" : "+v"(Tv));
#pragma unroll
        for (int i = 0; i < 8; i++) {
          if (w + 8 * i <= qt) {
            const int lim = (int)cj - ((w + 8 * i) * 32 + 4 * hh);
#pragma unroll
            for (int reg = 0; reg < 16; reg++) c += (uk[i][reg] == Tv && ((reg & 3) + 8 * (reg >> 2)) < lim) ? 1 : 0;
          }
        }
        if (dsa_reduce(c, cbuf, par, r, hh, w) <= need) J = cj;
      }
    }
#pragma unroll
    for (int i = 0; i < 8; i++) {
      const int kt = w + 8 * i;
      if (kt <= qt) {
        const int lim = (int)J - (kt * 32 + 4 * hh);
        unsigned bits = 0u;
#pragma unroll
        for (int reg = 0; reg < 16; reg++) {
          const unsigned u = uk[i][reg];
          const bool sel = (u > T) || (u == T && ((reg & 3) + 8 * (reg >> 2)) < lim);
          bits |= (sel ? 1u : 0u) << reg;
        }
        maskb[kt * 64 + lane] = (u16)bits;
      }
    }
  } else {
#pragma unroll
    for (int i = 0; i < 8; i++) {
      const int kt = w + 8 * i;
      if (kt <= qt) {
        unsigned bits = 0xFFFFu;
        if (kt == qt) {
          bits = 0u;
#pragma unroll
          for (int reg = 0; reg < 16; reg++) bits |= ((((reg & 3) + 8 * (reg >> 2)) <= r - 4 * hh) ? 1u : 0u) << reg;
        }
        maskb[kt * 64 + lane] = (u16)bits;
      }
    }
  }
  for (int rep_a = 0; rep_a < PROBE_DSA_ATT; rep_a++)
  {
    const int head = w, kvh = w >> 2;
    const u16* q = (const u16*)(p.ws + OFF_Q);
    const u16* kk = (const u16*)(p.ws + OFF_K);
    const u16* vt = (const u16*)(p.ws + OFF_VT);
    bf16x8 qf[4];
    {
      const u16* qp = q + (tb + q0 + r) * 512 + head * 64 + hh * 8;
#pragma unroll
      for (int s = 0; s < 4; s++) qf[s] = *(const bf16x8*)(qp + s * 16);
    }
    const int l_kvh = tid >> 8;
    const int k_row = (tid >> 3) & 31, k_ch = tid & 7;
    const int v_d = (tid >> 2) & 63, v_ch = tid & 3;
    const u16* gk = kk + (tb + k_row) * 128 + l_kvh * 64 + k_ch * 8;
    const u16* gv = vt + ((size_t)(b * 2 + l_kvh) * 64 + v_d) * SV_ + v_ch * 8;
    const int lk = DS_KV + l_kvh * (32 * 144) + k_row * 144 + k_ch * 16;
    const int lv = DS_KV + DS_VOFF + l_kvh * (64 * DS_VROW) + v_d * DS_VROW + ((v_ch & 1) + (v_ch >> 1) * 4) * 8;
    const int fk = DS_KV + kvh * (32 * 144) + r * 144 + hh * 16;
    const int fv = DS_KV + DS_VOFF + kvh * (64 * DS_VROW) + r * DS_VROW + hh * 16;
    const int nsteps = (qt + 2) >> 1;
    uint4 rkA, rvA, rkB, rvB;
#define AT_LOAD(j_) { const int ka_ = 2 * (j_), kb_ = (2 * (j_) + 1 <= qt) ? 2 * (j_) + 1 : qt; \
      rkA = *(const uint4*)(gk + (size_t)ka_ * 32 * 128); rvA = *(const uint4*)(gv + ka_ * 32); \
      rkB = *(const uint4*)(gk + (size_t)kb_ * 32 * 128); rvB = *(const uint4*)(gv + kb_ * 32); }
#define AT_STORE(sb_) { char* d_ = smem + (sb_) * (2 * DS_KVSTAGE); \
      *(uint4*)(d_ + lk) = rkA; *(uint2*)(d_ + lv) = make_uint2(rvA.x, rvA.y); *(uint2*)(d_ + lv + 16) = make_uint2(rvA.z, rvA.w); \
      *(uint4*)(d_ + DS_KVSTAGE + lk) = rkB; *(uint2*)(d_ + DS_KVSTAGE + lv) = make_uint2(rvB.x, rvB.y); *(uint2*)(d_ + DS_KVSTAGE + lv + 16) = make_uint2(rvB.z, rvB.w); }
    AT_LOAD(0);
    __syncthreads();
    AT_STORE(0);
    __syncthreads();
    f32x16 o0 = zero16(), o1 = zero16();
    float m = NEG_INF, l = 0.f;
    const float SC = 0.125f * 1.4426950408889634f;
#define AT_B1(acc_, nb_, r_) { int t_; asm("v_bfe_i32 %0, %1, " #r_ ", 1" : "=v"(t_) : "v"(nb_)); acc_[r_] = __int_as_float(t_ & (int)0xFF800000u); }
#define AT_BIAS(acc_, nb_) { AT_B1(acc_, nb_, 0) AT_B1(acc_, nb_, 1) AT_B1(acc_, nb_, 2) AT_B1(acc_, nb_, 3) AT_B1(acc_, nb_, 4) AT_B1(acc_, nb_, 5) AT_B1(acc_, nb_, 6) AT_B1(acc_, nb_, 7) \
      AT_B1(acc_, nb_, 8) AT_B1(acc_, nb_, 9) AT_B1(acc_, nb_, 10) AT_B1(acc_, nb_, 11) AT_B1(acc_, nb_, 12) AT_B1(acc_, nb_, 13) AT_B1(acc_, nb_, 14) AT_B1(acc_, nb_, 15) }
#define AT_MAX3(d_, a_, b_, c_) d_ = __builtin_elementwise_maximum(__builtin_elementwise_maximum((float)(a_), (float)(b_)), (float)(c_))
    for (int j = 0; j < nsteps; ++j) {
      const char* stg = smem + (j & 1) * (2 * DS_KVSTAGE);
      if (j + 1 < nsteps) AT_LOAD(j + 1);
#define SB __builtin_amdgcn_sched_barrier(0)
      f32x16 sa, sb;
      const bool vB = (2 * j + 1 <= qt);
      const unsigned nA = ~(unsigned)maskb[(2 * j) * 64 + lane];
      const unsigned mb = maskb[(vB ? 2 * j + 1 : qt) * 64 + lane];
      const unsigned nB = vB ? ~mb : 0xFFFFFFFFu;
      const bf16x8 kA0 = *(const bf16x8*)(stg + fk), kA1 = *(const bf16x8*)(stg + fk + 32), kA2 = *(const bf16x8*)(stg + fk + 64), kA3 = *(const bf16x8*)(stg + fk + 96);
      const bf16x8 kB0 = *(const bf16x8*)(stg + DS_KVSTAGE + fk), kB1 = *(const bf16x8*)(stg + DS_KVSTAGE + fk + 32);
      const bf16x8 kB2 = *(const bf16x8*)(stg + DS_KVSTAGE + fk + 64), kB3 = *(const bf16x8*)(stg + DS_KVSTAGE + fk + 96);
      SB;
      AT_BIAS(sa, nA);
      SB;
      sa = mfma32(kA0, qf[0], sa); AT_B1(sb, nB, 0) AT_B1(sb, nB, 1) AT_B1(sb, nB, 2) AT_B1(sb, nB, 3)
      SB;
      sa = mfma32(kA1, qf[1], sa); AT_B1(sb, nB, 4) AT_B1(sb, nB, 5) AT_B1(sb, nB, 6) AT_B1(sb, nB, 7)
      SB;
      sa = mfma32(kA2, qf[2], sa); AT_B1(sb, nB, 8) AT_B1(sb, nB, 9) AT_B1(sb, nB, 10) AT_B1(sb, nB, 11)
      SB;
      sa = mfma32(kA3, qf[3], sa); AT_B1(sb, nB, 12) AT_B1(sb, nB, 13) AT_B1(sb, nB, 14) AT_B1(sb, nB, 15)
      SB;
      const char* vbA = stg + fv; const char* vbB = stg + DS_KVSTAGE + fv;
      sb = mfma32(kB0, qf[0], sb);
      const bf16x8 vA00 = *(const bf16x8*)(vbA);
      const bf16x8 vA01 = *(const bf16x8*)(vbA + 32);
      SB;
      sb = mfma32(kB1, qf[1], sb);
      const bf16x8 vA10 = *(const bf16x8*)(vbA + 32 * DS_VROW);
      const bf16x8 vA11 = *(const bf16x8*)(vbA + 32 * DS_VROW + 32);
      SB;
      float x, y;
      sb = mfma32(kB2, qf[2], sb);
      AT_MAX3(x, sa[0], sa[1], sa[2]); AT_MAX3(x, x, sa[3], sa[4]); AT_MAX3(x, x, sa[5], sa[6]); AT_MAX3(x, x, sa[7], sa[8]);
      SB;
      sb = mfma32(kB3, qf[3], sb);
      AT_MAX3(x, x, sa[9], sa[10]); AT_MAX3(x, x, sa[11], sa[12]); AT_MAX3(x, x, sa[13], sa[14]); AT_MAX3(x, x, sa[15], sa[15]);
      SB;
      const bf16x8 vB00 = *(const bf16x8*)(vbB);
      const bf16x8 vB01 = *(const bf16x8*)(vbB + 32);
      const bf16x8 vB10 = *(const bf16x8*)(vbB + 32 * DS_VROW);
      const bf16x8 vB11 = *(const bf16x8*)(vbB + 32 * DS_VROW + 32);
      AT_MAX3(y, sb[0], sb[1], sb[2]); AT_MAX3(y, y, sb[3], sb[4]); AT_MAX3(y, y, sb[5], sb[6]); AT_MAX3(y, y, sb[7], sb[8]);
      AT_MAX3(y, y, sb[9], sb[10]); AT_MAX3(y, y, sb[11], sb[12]); AT_MAX3(y, y, sb[13], sb[14]); AT_MAX3(x, x, sb[15], y);
      float tmax;
      {
        const auto sw = __builtin_amdgcn_permlane32_swap(__float_as_uint(x), __float_as_uint(x), false, false);
        AT_MAX3(tmax, x, __uint_as_float(sw[0]), __uint_as_float(sw[1]));
      }
      const float mn = fmaxf(m, tmax);
      const float ms = (mn == NEG_INF) ? 0.f : mn;
      const float nmsc = -ms * SC;
      if (__any(mn != m)) {
        const float alpha = __builtin_amdgcn_exp2f(fmaf(m, SC, nmsc));
        l *= alpha;
#pragma unroll
        for (int reg = 0; reg < 16; reg++) { o0[reg] *= alpha; o1[reg] *= alpha; }
      }
      m = mn;
      float ps = 0.f, ps2 = 0.f;
#pragma unroll
      for (int reg = 0; reg < 16; reg++) { const float pa = __builtin_amdgcn_exp2f(fmaf(sa[reg], SC, nmsc)); sa[reg] = pa; ps += pa; }
      const bf16x8 pfA0 = pack_frag(sa, 0), pfA1 = pack_frag(sa, 8);
      SB;
#define AT_EXPB(r0_) { _Pragma("unroll") for (int reg = r0_; reg < r0_ + 4; reg++) { const float pb = __builtin_amdgcn_exp2f(fmaf(sb[reg], SC, nmsc)); sb[reg] = pb; ps2 += pb; } }
      o0 = mfma32(vA00, pfA0, o0); AT_EXPB(0)
      SB;
      o1 = mfma32(vA10, pfA0, o1); AT_EXPB(4)
      SB;
      o0 = mfma32(vA01, pfA1, o0); AT_EXPB(8)
      SB;
      o1 = mfma32(vA11, pfA1, o1); AT_EXPB(12)
      SB;
#undef AT_EXPB
      l += ps + ps2;
      {
        const bf16x8 pf0 = pack_frag(sb, 0), pf1 = pack_frag(sb, 8);
        o0 = mfma32(vB00, pf0, o0); o1 = mfma32(vB10, pf0, o1);
        o0 = mfma32(vB01, pf1, o0); o1 = mfma32(vB11, pf1, o1);
      }
#undef SB
      if (j + 1 < nsteps) AT_STORE((j + 1) & 1);
      __syncthreads();
    }
#undef AT_LOAD
#undef AT_STORE
#undef AT_B1
#undef AT_BIAS
#undef AT_MAX3
    const float lt = l + __shfl_xor(l, 32);
    const float inv = 1.f / lt;
    u16* cat = (u16*)(p.ws + OFF_HBUF);
    u16* op = cat + (tb + q0 + r) * 1024 + head * 64 + 4 * hh;
#pragma unroll
    for (int gq = 0; gq < 4; gq++) {
      *(uint2*)(op + 8 * gq) = make_uint2(pack2(o0[4 * gq] * inv, o0[4 * gq + 1] * inv), pack2(o0[4 * gq + 2] * inv, o0[4 * gq + 3] * inv));
      *(uint2*)(op + 32 + 8 * gq) = make_uint2(pack2(o1[4 * gq] * inv, o1[4 * gq + 1] * inv), pack2(o1[4 * gq + 2] * inv, o1[4 * gq + 3] * inv));
    }
  }
}

constexpr int SA_ROW = 272;
constexpr int SA_XROW = 144;
constexpr int SA_C = 0, SA_B = 128 * SA_ROW;
constexpr int SA_XDT = 2 * 128 * SA_ROW;
constexpr int SA_XH = 128 * SA_XROW;
constexpr int SA_XDS = SA_XDT + 2 * SA_XH;
constexpr int SA_FL = SA_XDS + 2 * SA_XH;

DEV float silu_fast(float v) { return v * __builtin_amdgcn_rcpf(1.f + __builtin_amdgcn_exp2f(-1.4426950408889634f * v)); }

DEV void conv_load11(const u16* __restrict__ xbc, size_t tb, int pos0, int ch, unsigned* xr) {
#pragma unroll
  for (int j = 0; j < 11; j++) { const int sp = pos0 - 3 + j; xr[j] = (sp >= 0) ? *(const unsigned*)(xbc + (tb + sp) * 1024 + ch) : 0u; }
}
DEV void conv_calc8(const unsigned* xr, const float* __restrict__ cw, const float* __restrict__ cbias, int ch, float* o0, float* o1) {
  const float2 w0 = *(const float2*)(cw + ch), w1 = *(const float2*)(cw + 1024 + ch), w2 = *(const float2*)(cw + 2048 + ch), w3 = *(const float2*)(cw + 3072 + ch);
  const float2 bs = *(const float2*)(cbias + ch);
#pragma unroll
  for (int j = 0; j < 8; j++) {
    float a = bs.x, c = bs.y;
    a = fmaf(w0.x, bflo(xr[j]), a); c = fmaf(w0.y, bfhi(xr[j]), c);
    a = fmaf(w1.x, bflo(xr[j + 1]), a); c = fmaf(w1.y, bfhi(xr[j + 1]), c);
    a = fmaf(w2.x, bflo(xr[j + 2]), a); c = fmaf(w2.y, bfhi(xr[j + 2]), c);
    a = fmaf(w3.x, bflo(xr[j + 3]), a); c = fmaf(w3.y, bfhi(xr[j + 3]), c);
    o0[j] = silu_fast(a); o1[j] = silu_fast(c);
  }
}
DEV void conv_pair8(const u16* __restrict__ xbc, const float* __restrict__ cw, const float* __restrict__ cbias, size_t tb, int pos0, int ch, float* o0, float* o1) {
  const float2 w0 = *(const float2*)(cw + ch), w1 = *(const float2*)(cw + 1024 + ch), w2 = *(const float2*)(cw + 2048 + ch), w3 = *(const float2*)(cw + 3072 + ch);
  const float2 bs = *(const float2*)(cbias + ch);
  unsigned xr[11];
#pragma unroll
  for (int j = 0; j < 11; j++) { const int sp = pos0 - 3 + j; xr[j] = (sp >= 0) ? *(const unsigned*)(xbc + (tb + sp) * 1024 + ch) : 0u; }
#pragma unroll
  for (int j = 0; j < 8; j++) {
    float a = bs.x, c = bs.y;
    a = fmaf(w0.x, bflo(xr[j]), a); c = fmaf(w0.y, bfhi(xr[j]), c);
    a = fmaf(w1.x, bflo(xr[j + 1]), a); c = fmaf(w1.y, bfhi(xr[j + 1]), c);
    a = fmaf(w2.x, bflo(xr[j + 2]), a); c = fmaf(w2.y, bfhi(xr[j + 2]), c);
    a = fmaf(w3.x, bflo(xr[j + 3]), a); c = fmaf(w3.y, bfhi(xr[j + 3]), c);
    o0[j] = silu_fast(a); o1[j] = silu_fast(c);
  }
}

DEV bf16x8 gather8(const char* base, int stride, bool perm) {
  unsigned v[8];
#pragma unroll
  for (int j = 0; j < 8; j++) { const int row = perm ? ((j & 3) + 8 * (j >> 2)) : j; v[j] = *(const u16*)(base + row * stride); }
  union { uint4 u; bf16x8 f; } t;
  t.u = make_uint4(v[0] | (v[1] << 16), v[2] | (v[3] << 16), v[4] | (v[5] << 16), v[6] | (v[7] << 16));
  return t.f;
}

typedef short v4i16_t __attribute__((ext_vector_type(4)));
DEV bf16x8 tr_pair(const char* p0, const char* p1) {
  const v4i16_t a = __builtin_amdgcn_ds_read_tr16_b64_v4i16((__attribute__((address_space(3))) v4i16_t*)p0);
  const v4i16_t b = __builtin_amdgcn_ds_read_tr16_b64_v4i16((__attribute__((address_space(3))) v4i16_t*)p1);
  return __builtin_shufflevector(a, b, 0, 1, 2, 3, 4, 5, 6, 7);
}

DEV void ssdA_item(const Params& p, int b, int c, int g, char* smem) {
  const int tid = opaque_tid(), lane = tid & 63, w = __builtin_amdgcn_readfirstlane(tid >> 6), r = lane & 31, hh = lane >> 5;
  const size_t tb = (size_t)b * 2048;
  const u16* xbc = (const u16*)(p.ws + OFF_XBC);
  const float* dtraw = (const float*)(p.ws + OFF_DT);
  __syncthreads();
  unsigned xsa[11], xsb[11];
  {
    u16* ccg = (u16*)(p.ws + OFF_CC);
    unsigned xa[11], xn[11];
    conv_load11(xbc, tb, c * 128 + ((tid >> 6) & 15) * 8, 512 + g * 128 + 2 * (tid & 63), xa);
#pragma unroll
    for (int k = 0; k < 4; k++) {
      const int e = tid + k * 512;
      const int pr = e & 63, lb = (e >> 6) & 15, which = e >> 10;
      const int n = 2 * pr, l0 = lb * 8;
      if (k < 3) {
        const int e2 = e + 512;
        conv_load11(xbc, tb, c * 128 + ((e2 >> 6) & 15) * 8, 512 + (e2 >> 10) * 256 + g * 128 + 2 * (e2 & 63), xn);
      } else {
        conv_load11(xbc, tb, c * 128 + (tid >> 5) * 8, (g * 4) * 64 + 2 * (tid & 31), xsa);
        conv_load11(xbc, tb, c * 128 + (tid >> 5) * 8, (g * 4 + 1) * 64 + 2 * (tid & 31), xsb);
      }
      float o0[8], o1[8];
      conv_calc8(xa, p.conv_w, p.conv_b, 512 + which * 256 + g * 128 + n, o0, o1);
#pragma unroll
      for (int j = 0; j < 11; j++) xa[j] = xn[j];
      char* dst = smem + (which ? SA_C : SA_B) + l0 * SA_ROW + n * 2;
#pragma unroll
      for (int j = 0; j < 8; j++) {
        const unsigned pk = pack2(o0[j], o1[j]);
        *(unsigned*)(dst + j * SA_ROW) = pk;
        if (which) *(unsigned*)(ccg + (tb + c * 128 + l0 + j) * 256 + g * 128 + n) = pk;
      }
    }
  }
  if (w < 4) {
    const int h = g * 4 + w;
    float* dtv_ = (float*)(smem + SA_FL) + w * 384; float* acum_ = dtv_ + 128; float* decs_ = dtv_ + 256;
    {
      const float A = -expf(p.a_log[h]);
      const float bias = p.dt_bias[h];
      float x0 = dtraw[(tb + c * 128 + lane) * 8 + h] + bias;
      float x1 = dtraw[(tb + c * 128 + 64 + lane) * 8 + h] + bias;
      float d0 = (x0 > 20.f) ? x0 : log1pf(expf(x0));
      float d1 = (x1 > 20.f) ? x1 : log1pf(expf(x1));
      dtv_[lane] = d0; dtv_[64 + lane] = d1;
      float v0 = d0 * A, v1 = d1 * A;
#pragma unroll
      for (int o = 1; o < 64; o <<= 1) { float n0 = __shfl_up(v0, o), n1 = __shfl_up(v1, o); if (lane >= o) { v0 += n0; v1 += n1; } }
      const float tot0 = __shfl(v0, 63);
      v1 += tot0;
      acum_[lane] = v0; acum_[64 + lane] = v1;
      const float atot = __shfl(v1, 63);
      decs_[lane] = expf(atot - v0); decs_[64 + lane] = expf(atot - v1);
    }
  }
  const int pt = w & 1, lt = w >> 1, nt = w >> 1;
  const int lidx = lt * 32 + r;
  const int trq = (lane & 15) >> 2, trc = (16 * ((lane >> 4) & 1) + 4 * (lane & 3)) * 2;
  const int trx = trq * SA_XROW + trc, trb = trq * SA_ROW + trc;
  f32x16 cbt[4];
#pragma unroll 1
  for (int rnd = 0; rnd < 2; rnd++) {
    __syncthreads();
    {
      const int pr = tid & 31, lb = tid >> 5;
      const int pp = 2 * pr, l0 = lb * 8;
      float oa0[8], oa1[8], ob0[8], ob1[8];
      conv_calc8(xsa, p.conv_w, p.conv_b, (g * 4 + 2 * rnd) * 64 + pp, oa0, oa1);
      conv_calc8(xsb, p.conv_w, p.conv_b, (g * 4 + 2 * rnd + 1) * 64 + pp, ob0, ob1);
      if (rnd == 0) {
        conv_load11(xbc, tb, c * 128 + l0, (g * 4 + 2) * 64 + pp, xsa);
        conv_load11(xbc, tb, c * 128 + l0, (g * 4 + 3) * 64 + pp, xsb);
      }
      const float* dtA = (const float*)(smem + SA_FL) + (2 * rnd) * 384; const float* dtB = dtA + 384;
#pragma unroll
      for (int j = 0; j < 8; j++) {
        const float dA = dtA[l0 + j], sA = dtA[256 + l0 + j], dB = dtB[l0 + j], sB = dtB[256 + l0 + j];
        const float a0 = oa0[j] * dA, a1 = oa1[j] * dA, b0 = ob0[j] * dB, b1 = ob1[j] * dB;
        *(unsigned*)(smem + SA_XDT + (l0 + j) * SA_XROW + pp * 2) = pack2(a0, a1);
        *(unsigned*)(smem + SA_XDS + (l0 + j) * SA_XROW + pp * 2) = pack2(a0 * sA, a1 * sA);
        *(unsigned*)(smem + SA_XDT + SA_XH + (l0 + j) * SA_XROW + pp * 2) = pack2(b0, b1);
        *(unsigned*)(smem + SA_XDS + SA_XH + (l0 + j) * SA_XROW + pp * 2) = pack2(b0 * sB, b1 * sB);
      }
    }
    if (rnd == 0) {
#pragma unroll
      for (int st = 0; st < 4; st++) {
        if (st <= lt) {
          f32x16 cb = zero16();
#pragma unroll
          for (int ks = 0; ks < 8; ks++) {
            const bf16x8 a = *(const bf16x8*)(smem + SA_B + (st * 32 + r) * SA_ROW + ks * 32 + hh * 16);
            const bf16x8 bq = *(const bf16x8*)(smem + SA_C + (lt * 32 + r) * SA_ROW + ks * 32 + hh * 16);
            cb = mfma32(a, bq, cb);
          }
          if (st == lt) {
#pragma unroll
            for (int reg = 0; reg < 16; reg++) cb[reg] = (rowmap(reg, hh) <= r) ? cb[reg] : 0.f;
          }
          cbt[st] = cb;
        }
      }
    }
    __syncthreads();
#pragma unroll
    for (int hl = 0; hl < 2; hl++) {
      const int h = g * 4 + 2 * rnd + hl;
      const float* dtv = (const float*)(smem + SA_FL) + (2 * rnd + hl) * 384; const float* acum = dtv + 128;
      const char* xdt_ = smem + SA_XDT + hl * SA_XH; const char* xds_ = smem + SA_XDS + hl * SA_XH;
      const float acl = acum[lidx];
      f32x16 yT = zero16();
#pragma unroll
      for (int st = 0; st < 4; st++) {
        if (st <= lt) {
          f32x16 cb = cbt[st];
          const float* ap = acum + st * 32 + 4 * hh;
          const float4 a0 = *(const float4*)(ap), a1 = *(const float4*)(ap + 8), a2 = *(const float4*)(ap + 16), a3 = *(const float4*)(ap + 24);
          const float av[16] = {a0.x, a0.y, a0.z, a0.w, a1.x, a1.y, a1.z, a1.w, a2.x, a2.y, a2.z, a2.w, a3.x, a3.y, a3.z, a3.w};
          if (st < lt) {
#pragma unroll
            for (int reg = 0; reg < 16; reg++) cb[reg] *= __builtin_amdgcn_exp2f((acl - av[reg]) * 1.4426950408889634f);
          } else {
#pragma unroll
            for (int reg = 0; reg < 16; reg++)
              cb[reg] *= __builtin_amdgcn_exp2f(__builtin_elementwise_minimum(acl - av[reg], 0.f) * 1.4426950408889634f);
          }
          const bf16x8 mf0 = pack_frag(cb, 0), mf1 = pack_frag(cb, 8);
          const char* xb = xdt_ + (st * 32 + 4 * hh) * SA_XROW + (pt * 32) * 2 + trx;
          const bf16x8 x0 = tr_pair(xb, xb + 8 * SA_XROW);
          const bf16x8 x1 = tr_pair(xb + 16 * SA_XROW, xb + 24 * SA_XROW);
          yT = mfma32(x0, mf0, yT); yT = mfma32(x1, mf1, yT);
        }
      }
      const float dsk = p.d_skip[h] / dtv[lidx];
      u16* yp = (u16*)(p.ws + OFF_YP) + (tb + c * 128 + lidx) * 512 + h * 64 + pt * 32 + 4 * hh;
#pragma unroll
      for (int gq = 0; gq < 4; gq++) {
        const uint2 xv = *(const uint2*)(xdt_ + lidx * SA_XROW + (pt * 32 + 8 * gq + 4 * hh) * 2);
        *(uint2*)(yp + 8 * gq) = make_uint2(pack2(yT[4 * gq] + dsk * bflo(xv.x), yT[4 * gq + 1] + dsk * bfhi(xv.x)), pack2(yT[4 * gq + 2] + dsk * bflo(xv.y), yT[4 * gq + 3] + dsk * bfhi(xv.y)));
      }
      f32x16 sacc = zero16();
      {
        const char* ap0 = xds_ + (hh * 8) * SA_XROW + (pt * 32) * 2 + trx;
        const char* bp0 = smem + SA_B + (hh * 8) * SA_ROW + (nt * 32) * 2 + trb;
        bf16x8 an = tr_pair(ap0, ap0 + 4 * SA_XROW), bn = tr_pair(bp0, bp0 + 4 * SA_ROW);
#pragma unroll
        for (int ks = 0; ks < 8; ks++) {
          const bf16x8 a = an, bq = bn;
          if (ks < 7) {
            const char* ap = ap0 + (ks + 1) * 16 * SA_XROW; const char* bp = bp0 + (ks + 1) * 16 * SA_ROW;
            an = tr_pair(ap, ap + 4 * SA_XROW); bn = tr_pair(bp, bp + 4 * SA_ROW);
          }
          __builtin_amdgcn_sched_barrier(0);
          sacc = mfma32(a, bq, sacc);
          __builtin_amdgcn_sched_barrier(0);
        }
      }
      u16* stp = (u16*)(p.ws + OFF_ST) + ((size_t)((b * 16 + c) * 8 + h) * 64) * 128;
#pragma unroll
      for (int reg = 0; reg < 16; reg++) stp[(pt * 32 + rowmap(reg, hh)) * 128 + nt * 32 + r] = f2bf(sacc[reg]);
      if (tid < 128) ((float*)(p.ws + OFF_ACUM))[((b * 16 + c) * 8 + h) * 128 + tid] = acum[tid];
    }
  }
}

DEV void ssdS_item(const Params& p, int b, int h, int q) {
  const int tid = opaque_tid();
  const u16* stb = (const u16*)(p.ws + OFF_ST);
  const float* acg = (const float*)(p.ws + OFF_ACUM);
  u16* sin = (u16*)(p.ws + OFF_SIN_ST);
  const int off = q * 2048 + tid * 4;
  float4 S = make_float4(0.f, 0.f, 0.f, 0.f);
  uint2 ld[4];
#pragma unroll
  for (int j = 0; j < 4; j++) ld[j] = *(const uint2*)(stb + (size_t)((b * 16 + j) * 8 + h) * 8192 + off);
#pragma unroll
  for (int c4 = 0; c4 < 16; c4 += 4) {
    uint2 nx[4];
    if (c4 + 4 < 16) {
#pragma unroll
      for (int j = 0; j < 4; j++) nx[j] = *(const uint2*)(stb + (size_t)((b * 16 + c4 + 4 + j) * 8 + h) * 8192 + off);
    }
#pragma unroll
    for (int j = 0; j < 4; j++) {
      const int c = c4 + j;
      *(uint2*)(sin + (size_t)((b * 16 + c) * 8 + h) * 8192 + off) = make_uint2(pack2(S.x, S.y), pack2(S.z, S.w));
      const float dec = expf(acg[((b * 16 + c) * 8 + h) * 128 + 127]);
      S.x = fmaf(S.x, dec, bflo(ld[j].x)); S.y = fmaf(S.y, dec, bfhi(ld[j].x)); S.z = fmaf(S.z, dec, bflo(ld[j].y)); S.w = fmaf(S.w, dec, bfhi(ld[j].y));
    }
    if (c4 + 4 < 16) {
#pragma unroll
      for (int j = 0; j < 4; j++) ld[j] = nx[j];
    }
  }
}

DEV void ssdS_pair16(const Params& p, int it0) {
  const int tid = opaque_tid();
  const int it = it0 + ((tid >> 8) << 8);
  const int b = it >> 5, h = (it >> 2) & 7, q = it & 3;
  const u16* stb = (const u16*)(p.ws + OFF_ST);
  const float* acg = (const float*)(p.ws + OFF_ACUM);
  u16* sin = (u16*)(p.ws + OFF_SIN_ST);
  const int off = q * 2048 + (tid & 255) * 8;
  uint4 ld[16]; float dec[16];
#pragma unroll
  for (int c = 0; c < 16; c++) ld[c] = *(const uint4*)(stb + (size_t)((b * 16 + c) * 8 + h) * 8192 + off);
#pragma unroll
  for (int c = 0; c < 16; c++) dec[c] = acg[((b * 16 + c) * 8 + h) * 128 + 127];
  float S[8];
#pragma unroll
  for (int k = 0; k < 8; k++) S[k] = 0.f;
#pragma unroll
  for (int c = 0; c < 16; c++) {
    *(uint4*)(sin + (size_t)((b * 16 + c) * 8 + h) * 8192 + off) = make_uint4(pack2(S[0], S[1]), pack2(S[2], S[3]), pack2(S[4], S[5]), pack2(S[6], S[7]));
    const float d = expf(dec[c]);
    const unsigned wv[4] = {ld[c].x, ld[c].y, ld[c].z, ld[c].w};
#pragma unroll
    for (int k = 0; k < 4; k++) { S[2 * k] = fmaf(S[2 * k], d, bflo(wv[k])); S[2 * k + 1] = fmaf(S[2 * k + 1], d, bfhi(wv[k])); }
  }
}

DEV void ssdB_item(const Params& p, int b, int c, char* smem) {
  const int tid = opaque_tid(), lane = tid & 63, h = __builtin_amdgcn_readfirstlane(tid >> 6), r = lane & 31, hh = lane >> 5;
  const size_t tb = (size_t)b * 2048;
  const int g = h >> 2;
  float* ssq = (float*)smem;
  const float* acg = (const float*)(p.ws + OFF_ACUM);
  __syncthreads();
  bf16x8 sf[2][8];
  if (c > 0) {
    const u16* sin = (const u16*)(p.ws + OFF_SIN_ST) + (size_t)((b * 16 + c) * 8 + h) * 8192;
#pragma unroll
    for (int pt = 0; pt < 2; pt++)
#pragma unroll
      for (int ks = 0; ks < 8; ks++) sf[pt][ks] = *(const bf16x8*)(sin + (pt * 32 + r) * 128 + ks * 16 + hh * 8);
  }
  const u16* ccg = (const u16*)(p.ws + OFF_CC);
  const u16* zb = (const u16*)(p.ws + OFF_Z);
  const u16* ypb = (const u16*)(p.ws + OFF_YP);
  u16* cat = (u16*)(p.ws + OFF_HBUF);
  float4 ng0[4], ng1[4];
#pragma unroll
  for (int gq = 0; gq < 4; gq++) {
    ng0[gq] = *(const float4*)(p.ssd_norm_g + h * 64 + 8 * gq + 4 * hh);
    ng1[gq] = *(const float4*)(p.ssd_norm_g + h * 64 + 32 + 8 * gq + 4 * hh);
  }
#pragma unroll 1
  for (int lt = 0; lt < 4; ++lt) {
    const int lidx = lt * 32 + r;
    const size_t t = tb + c * 128 + lidx;
    f32x16 y0 = zero16(), y1 = zero16();
    if (c > 0) {
#pragma unroll
      for (int ks = 0; ks < 8; ks++) {
        const bf16x8 cf = *(const bf16x8*)(ccg + t * 256 + g * 128 + ks * 16 + hh * 8);
        y0 = mfma32(sf[0][ks], cf, y0); y1 = mfma32(sf[1][ks], cf, y1);
      }
      const float e = expf(acg[((b * 16 + c) * 8 + h) * 128 + lidx]);
#pragma unroll
      for (int reg = 0; reg < 16; reg++) { y0[reg] *= e; y1[reg] *= e; }
    }
    float ss = 0.f;
#pragma unroll
    for (int gq = 0; gq < 4; gq++) {
      const int pb = 8 * gq + 4 * hh;
      const uint2 aq0 = *(const uint2*)(ypb + t * 512 + h * 64 + pb), aq1 = *(const uint2*)(ypb + t * 512 + h * 64 + 32 + pb);
      const float4 a0 = make_float4(bflo(aq0.x), bfhi(aq0.x), bflo(aq0.y), bfhi(aq0.y));
      const float4 a1 = make_float4(bflo(aq1.x), bfhi(aq1.x), bflo(aq1.y), bfhi(aq1.y));
      const uint2 z0 = *(const uint2*)(zb + t * 512 + h * 64 + pb);
      const uint2 z1 = *(const uint2*)(zb + t * 512 + h * 64 + 32 + pb);
      y0[4 * gq + 0] = (y0[4 * gq + 0] + a0.x) * silu_fast(bflo(z0.x)); y0[4 * gq + 1] = (y0[4 * gq + 1] + a0.y) * silu_fast(bfhi(z0.x));
      y0[4 * gq + 2] = (y0[4 * gq + 2] + a0.z) * silu_fast(bflo(z0.y)); y0[4 * gq + 3] = (y0[4 * gq + 3] + a0.w) * silu_fast(bfhi(z0.y));
      y1[4 * gq + 0] = (y1[4 * gq + 0] + a1.x) * silu_fast(bflo(z1.x)); y1[4 * gq + 1] = (y1[4 * gq + 1] + a1.y) * silu_fast(bfhi(z1.x));
      y1[4 * gq + 2] = (y1[4 * gq + 2] + a1.z) * silu_fast(bflo(z1.y)); y1[4 * gq + 3] = (y1[4 * gq + 3] + a1.w) * silu_fast(bfhi(z1.y));
#pragma unroll
      for (int j = 0; j < 4; j++) ss += y0[4 * gq + j] * y0[4 * gq + j] + y1[4 * gq + j] * y1[4 * gq + j];
    }
    ss += __shfl_xor(ss, 32);
    if (hh == 0) ssq[(lt * 32 + r) * 8 + h] = ss;
    __syncthreads();
    float tot = 0.f;
#pragma unroll
    for (int k = 0; k < 8; k++) tot += ssq[(lt * 32 + r) * 8 + k];
    const float rstd = rsqrtf(tot * (1.f / 512.f) + 1e-6f);
#pragma unroll
    for (int gq = 0; gq < 4; gq++) {
      const int pb = 8 * gq + 4 * hh;
      const float4 g0 = ng0[gq], g1 = ng1[gq];
      *(uint2*)(cat + t * 1024 + 512 + h * 64 + pb) = make_uint2(pack2(y0[4 * gq] * rstd * g0.x, y0[4 * gq + 1] * rstd * g0.y), pack2(y0[4 * gq + 2] * rstd * g0.z, y0[4 * gq + 3] * rstd * g0.w));
      *(uint2*)(cat + t * 1024 + 512 + h * 64 + 32 + pb) = make_uint2(pack2(y1[4 * gq] * rstd * g1.x, y1[4 * gq + 1] * rstd * g1.y), pack2(y1[4 * gq + 2] * rstd * g1.z, y1[4 * gq + 3] * rstd * g1.w));
    }
  }
}


DEV void p3_rows1(const Params& p, int m0) {
  const int tid_ = opaque_tid(); const int lane = tid_ & 63, w = __builtin_amdgcn_readfirstlane(tid_ >> 6);
  const u16* mix = (const u16*)(p.ws + OFF_MIX);
  const float* mod = (const float*)(p.ws + OFF_MOD);
  u16* h2 = (u16*)(p.ws + OFF_HBUF);
  const int b = m0 >> 11;
  float4 pg1[4], fgm[4], sh2[4];
#pragma unroll
  for (int k = 0; k < 4; k++) {
    const int col = (k * 64 + lane) * 4;
    const float4 pg = *(const float4*)(p.post_mix_g + col);
    const float4 g1 = ldmod(mod, b * 6144 + 2048 + col);
    pg1[k] = make_float4(pg.x * g1.x, pg.y * g1.y, pg.z * g1.z, pg.w * g1.w);
    const float4 fg = *(const float4*)(p.pre_ffn_g + col);
    const float4 sc = ldmod(mod, b * 6144 + 4096 + col);
    fgm[k] = make_float4(fg.x * (1.f + sc.x), fg.y * (1.f + sc.y), fg.z * (1.f + sc.z), fg.w * (1.f + sc.w));
    sh2[k] = ldmod(mod, b * 6144 + 3072 + col);
  }
#pragma unroll 2
  for (int i = 0; i < 16; i++) {
    const int t = m0 + w * 16 + i;
    float4 mv[4], xv[4]; float ss = 0.f;
#pragma unroll
    for (int k = 0; k < 4; k++) {
      { const uint2 mq = *(const uint2*)(mix + (size_t)t * 1024 + (k * 64 + lane) * 4); mv[k] = make_float4(bflo(mq.x), bfhi(mq.x), bflo(mq.y), bfhi(mq.y)); }
      xv[k] = *(const float4*)(p.x + (size_t)t * 1024 + (k * 64 + lane) * 4);
      ss += mv[k].x * mv[k].x + mv[k].y * mv[k].y + mv[k].z * mv[k].z + mv[k].w * mv[k].w;
    }
    ss = wave_sum(ss);
    const float rstd = rsqrtf(ss * (1.f / 1024.f) + 1e-6f);
    float s2 = 0.f;
    unsigned x1w[8];
#pragma unroll
    for (int k = 0; k < 4; k++) {
      xv[k].x += (mv[k].x * rstd) * pg1[k].x; xv[k].y += (mv[k].y * rstd) * pg1[k].y;
      xv[k].z += (mv[k].z * rstd) * pg1[k].z; xv[k].w += (mv[k].w * rstd) * pg1[k].w;
      s2 += xv[k].x * xv[k].x + xv[k].y * xv[k].y + xv[k].z * xv[k].z + xv[k].w * xv[k].w;
      x1w[2 * k] = pack2(xv[k].x, xv[k].y); x1w[2 * k + 1] = pack2(xv[k].z, xv[k].w);
    }
    {
      u16* xp = (u16*)(p.ws + OFF_X1) + (size_t)t * 1024 + lane * 16;
      *(uint4*)(xp) = make_uint4(x1w[0], x1w[1], x1w[2], x1w[3]); *(uint4*)(xp + 8) = make_uint4(x1w[4], x1w[5], x1w[6], x1w[7]);
    }
    s2 = wave_sum(s2);
    const float rstd2 = rsqrtf(s2 * (1.f / 1024.f) + 1e-6f);
#pragma unroll
    for (int k = 0; k < 4; k++) {
      const int col = (k * 64 + lane) * 4;
      const float y0 = (xv[k].x * rstd2) * fgm[k].x + sh2[k].x;
      const float y1 = (xv[k].y * rstd2) * fgm[k].y + sh2[k].y;
      const float y2 = (xv[k].z * rstd2) * fgm[k].z + sh2[k].z;
      const float y3 = (xv[k].w * rstd2) * fgm[k].w + sh2[k].w;
      *(uint2*)(h2 + (size_t)t * 1024 + col) = make_uint2(pack2(y0, y1), pack2(y2, y3));
      xv[k] = make_float4(y0, y1, y2, y3);
    }
    {
      float mx = 0.f;
#pragma unroll
      for (int k = 0; k < 4; k++) mx = fmaxf(mx, fmaxf(fmaxf(fabsf(xv[k].x), fabsf(xv[k].y)), fmaxf(fabsf(xv[k].z), fabsf(xv[k].w))));
#pragma unroll
      for (int o = 32; o > 0; o >>= 1) mx = fmaxf(mx, __shfl_xor(mx, o));
      const float inv = (mx > 0.f) ? 127.f / mx : 0.f;
      unsigned wd[4];
#pragma unroll
      for (int k = 0; k < 4; k++) wd[k] = pack_i8x4(xv[k].x * inv, xv[k].y * inv, xv[k].z * inv, xv[k].w * inv);
      *(uint4*)(p.ws + OFF_H2Q + (size_t)t * 1024 + lane * 16) = make_uint4(wd[0], wd[1], wd[2], wd[3]);
      if (lane == 0) ((float*)(p.ws + OFF_SH))[t] = mx * (1.f / 127.f);
    }
  }
}

#define INS16(L, x) { _Pragma("unroll") for (int j_ = 0; j_ < 16; j_++) { const unsigned hi_ = max(L[j_], x); x = min(L[j_], x); L[j_] = hi_; } }
#define CEX(L, a_, b_) { const unsigned hi_ = max(L[a_], L[b_]); const unsigned lo_ = min(L[a_], L[b_]); L[a_] = hi_; L[b_] = lo_; }
DEV float unordkey(unsigned u) { const unsigned b = (u & 0x80000000u) ? (u ^ 0x80000000u) : ~u; return __uint_as_float(b); }

#define SORT16(L) { \
  _Pragma("unroll") for (int k_ = 2; k_ <= 16; k_ <<= 1) { \
    _Pragma("unroll") for (int j_ = k_ >> 1; j_ > 0; j_ >>= 1) { \
      _Pragma("unroll") for (int i_ = 0; i_ < 16; i_++) { \
        const int l_ = i_ ^ j_; \
        if (l_ > i_) { \
          const unsigned a_ = L[i_], b_ = L[l_]; \
          const bool desc_ = ((i_ & k_) == 0); \
          L[i_] = desc_ ? max(a_, b_) : min(a_, b_); L[l_] = desc_ ? min(a_, b_) : max(a_, b_); \
        } } } } }
#define MERGE16(A, B) { \
  _Pragma("unroll") for (int j_ = 0; j_ < 16; j_++) A[j_] = max(A[j_], B[15 - j_]); \
  _Pragma("unroll") for (int j_ = 0; j_ < 8; j_++) CEX(A, j_, j_ + 8); \
  _Pragma("unroll") for (int j_ = 0; j_ < 16; j_++) if ((j_ & 4) == 0) CEX(A, j_, j_ + 4); \
  _Pragma("unroll") for (int j_ = 0; j_ < 16; j_++) if ((j_ & 2) == 0) CEX(A, j_, j_ + 2); \
  _Pragma("unroll") for (int j_ = 0; j_ < 16; j_ += 2) CEX(A, j_, j_ + 1); }

constexpr int RT_LROW = 36;

DEV void p3_route(const Params& p, int m0, char* smem) {
  const int tid = opaque_tid(), lane = tid & 63, w = __builtin_amdgcn_readfirstlane(tid >> 6), r = lane & 31, hh = lane >> 5;
  const u16* qp = (const u16*)(p.ws + OFF_QP);
  const u16* sk = (const u16*)(p.ws + OFF_SK);
  unsigned* lists = (unsigned*)smem;
  int* eidx = (int*)(p.ws + OFF_EIDX);
  float* gate = (float*)(p.ws + OFF_GATE);
  __syncthreads();
  {
    const int h = w;
#pragma unroll 1
    for (int i = 0; i < 2; i++) {
      bf16x8 af[4][4];
#pragma unroll
      for (int kt4 = 0; kt4 < 4; kt4++)
#pragma unroll
        for (int ks = 0; ks < 4; ks++) af[kt4][ks] = *(const bf16x8*)(sk + ((size_t)(h * 2 + i) * 128 + kt4 * 32 + r) * 64 + ks * 16 + hh * 8);
#pragma unroll 1
      for (int tt = 0; tt < 4; tt++) {
        bf16x8 bq[4];
#pragma unroll
        for (int ks = 0; ks < 4; ks++) bq[ks] = *(const bf16x8*)(qp + (size_t)(m0 + tt * 32 + r) * 1024 + h * 128 + i * 64 + ks * 16 + hh * 8);
        unsigned L0[16], L1[16], L2[16], L3[16];
#define RT_TILE(LL, kt4) { f32x16 acc = zero16(); \
          _Pragma("unroll") for (int ks = 0; ks < 4; ks++) acc = mfma32(af[kt4][ks], bq[ks], acc); \
          const unsigned kb = (unsigned)(127 - (kt4) * 32 - 4 * hh); \
          _Pragma("unroll") for (int reg = 0; reg < 16; reg++) LL[reg] = (ordkey(acc[reg]) & 0xFFFFFF80u) | (kb - (unsigned)((reg & 3) + 8 * (reg >> 2))); \
          SORT16(LL); }
        RT_TILE(L0, 0); RT_TILE(L1, 1);
        MERGE16(L0, L1);
        RT_TILE(L2, 2); RT_TILE(L3, 3);
        MERGE16(L2, L3);
        MERGE16(L0, L2);
#undef RT_TILE
        unsigned C[16];
#pragma unroll
        for (int j = 0; j < 16; j++) C[j] = (unsigned)__shfl_xor((int)L0[j], 32);
        MERGE16(L0, C);
#pragma unroll
        for (int j = 0; j < 16; j++) C[j] = L0[j];
        if (hh == 0) {
          uint4* dst = (uint4*)(lists + ((size_t)(h * 128 + tt * 32 + r)) * RT_LROW + i * 16);
          dst[0] = make_uint4(C[0], C[1], C[2], C[3]); dst[1] = make_uint4(C[4], C[5], C[6], C[7]);
          dst[2] = make_uint4(C[8], C[9], C[10], C[11]); dst[3] = make_uint4(C[12], C[13], C[14], C[15]);
        }
      }
    }
  }
  __syncthreads();
#pragma unroll 1
  for (int k = 0; k < 2; k++) {
    const int task = tid + k * 512;
    const int h = task >> 7, t = task & 127;
    const uint4* src = (const uint4*)(lists + (size_t)(h * 128 + t) * RT_LROW);
    unsigned K0[16], K1[16];
#pragma unroll
    for (int q = 0; q < 4; q++) {
      const uint4 a = src[q], bb = src[4 + q];
      K0[4 * q] = a.x; K0[4 * q + 1] = a.y; K0[4 * q + 2] = a.z; K0[4 * q + 3] = a.w;
      K1[4 * q] = bb.x; K1[4 * q + 1] = bb.y; K1[4 * q + 2] = bb.z; K1[4 * q + 3] = bb.w;
    }
    float s0[16], s1[16];
#pragma unroll
    for (int j = 0; j < 16; j++) { s0[j] = unordkey(K0[j] & 0xFFFFFF80u); s1[j] = unordkey(K1[j] & 0xFFFFFF80u); }
    unsigned L[16];
#pragma unroll
    for (int j = 0; j < 16; j++) L[j] = 0u;
#pragma unroll
    for (int a = 0; a < 16; a++) {
#pragma unroll
      for (int bb = 0; bb < 16; bb++) {
        if ((a + 1) * (bb + 1) <= 16) {
          unsigned x = (ordkey(s0[a] + s1[bb]) & 0xFFFFFF00u) | (unsigned)(255 - (a * 16 + bb));
          INS16(L, x);
        }
      }
    }
    float fv[16]; int ei[16]; float mx = NEG_INF;
#pragma unroll
    for (int j = 0; j < 16; j++) {
      const int code = 255 - (int)(L[j] & 255u); const int a = code >> 4, bb = code & 15;
      const unsigned ka = ((const unsigned*)src)[a], kb2 = ((const unsigned*)src)[16 + bb];
      const float va = unordkey(ka & 0xFFFFFF80u), vb = unordkey(kb2 & 0xFFFFFF80u);
      fv[j] = va + vb;
      ei[j] = (127 - (int)(ka & 127u)) * 128 + (127 - (int)(kb2 & 127u));
      mx = fmaxf(mx, fv[j]);
    }
    float sum = 0.f;
#pragma unroll
    for (int j = 0; j < 16; j++) { fv[j] = __expf(fv[j] - mx); sum += fv[j]; }
    const float inv = 1.f / sum;
    int* ep = eidx + (size_t)(m0 + t) * 128 + h * 16;
    float* gp = gate + (size_t)(m0 + t) * 128 + h * 16;
#pragma unroll
    for (int q = 0; q < 4; q++) {
      *(int4*)(ep + 4 * q) = make_int4(ei[4 * q], ei[4 * q + 1], ei[4 * q + 2], ei[4 * q + 3]);
      *(float4*)(gp + 4 * q) = make_float4(fv[4 * q] * inv, fv[4 * q + 1] * inv, fv[4 * q + 2] * inv, fv[4 * q + 3] * inv);
    }
  }
}

typedef __attribute__((ext_vector_type(2))) float f32x2;
DEV void dec16(const uint4& q, float* f) {
  f32x2 t;
  t = __builtin_amdgcn_cvt_pk_f32_fp8((int)q.x, false); f[0] = t[0]; f[1] = t[1];
  t = __builtin_amdgcn_cvt_pk_f32_fp8((int)q.x, true);  f[2] = t[0]; f[3] = t[1];
  t = __builtin_amdgcn_cvt_pk_f32_fp8((int)q.y, false); f[4] = t[0]; f[5] = t[1];
  t = __builtin_amdgcn_cvt_pk_f32_fp8((int)q.y, true);  f[6] = t[0]; f[7] = t[1];
  t = __builtin_amdgcn_cvt_pk_f32_fp8((int)q.z, false); f[8] = t[0]; f[9] = t[1];
  t = __builtin_amdgcn_cvt_pk_f32_fp8((int)q.z, true);  f[10] = t[0]; f[11] = t[1];
  t = __builtin_amdgcn_cvt_pk_f32_fp8((int)q.w, false); f[12] = t[0]; f[13] = t[1];
  t = __builtin_amdgcn_cvt_pk_f32_fp8((int)q.w, true);  f[14] = t[0]; f[15] = t[1];
}

constexpr int PX_ROW = 132;
constexpr int PX_Z = 0;
constexpr int PX_E = 8 * 16 * PX_ROW * 4;
constexpr int PX_SS = 2 * PX_E;
constexpr int PX_CL = PX_SS + 512;
constexpr int PX_HQ = PX_CL + 8 * 144 * 4;

DEV void p3_ustage(const Params& p, int m0, char* smem) {
  const int tid_ = opaque_tid(); const int lane = tid_ & 63, w = __builtin_amdgcn_readfirstlane(tid_ >> 6);
  const int sl = lane >> 3, ch = lane & 7;
  const unsigned char* h2q = p.ws + OFF_H2Q;
  const unsigned char* U = p.ws + OFF_U;
  const int* eidx = (const int*)(p.ws + OFF_EIDX);
  float* zb = (float*)(smem + PX_Z) + w * 16 * PX_ROW;
  int* eb = (int*)(smem + PX_E) + w * 16 * PX_ROW;
  int* cl = (int*)(smem + PX_CL) + w * 144;
  char* hqs = smem + PX_HQ + w * 2048;
  {
    int ev[32];
#pragma unroll
    for (int i = 0; i < 16; i++) { const int t = m0 + w * 16 + i; ev[2 * i] = eidx[(size_t)t * 128 + lane]; ev[2 * i + 1] = eidx[(size_t)t * 128 + 64 + lane]; }
#pragma unroll
    for (int i = 0; i < 16; i++) { eb[i * PX_ROW + lane] = ev[2 * i] << 7; eb[i * PX_ROW + 64 + lane] = ev[2 * i + 1] << 7; }
  }
  if (lane < 16) ((float*)(smem + PX_SS))[w * 16 + lane] = 0.f;
#define U_LOAD8(Q, E) { const unsigned uo_ = (unsigned)(E) * 1024u + (unsigned)ch * 16u; _Pragma("unroll") for (int k_ = 0; k_ < 8; k_++) Q[k_] = *(const uint4*)(U + (uo_ + k_ * 128u)); }
#define U_COMPUTE(Q, CE, NV) { const char* hs_ = hqs + (((CE) >> 21) & 1) * 1024 + ch * 16; \
      int d = 0; \
      _Pragma("unroll") for (int k = 0; k < 8; k++) { \
        const uint4 hk = *(const uint4*)(hs_ + k * 128); \
        d = __builtin_amdgcn_sdot4((int)Q[k].x, (int)hk.x, d, false); \
        d = __builtin_amdgcn_sdot4((int)Q[k].y, (int)hk.y, d, false); \
        d = __builtin_amdgcn_sdot4((int)Q[k].z, (int)hk.z, d, false); \
        d = __builtin_amdgcn_sdot4((int)Q[k].w, (int)hk.w, d, false); \
      } \
      d += __builtin_amdgcn_update_dpp(0, d, 0xB1, 0xF, 0xF, false); \
      d += __builtin_amdgcn_update_dpp(0, d, 0x4E, 0xF, 0xF, false); \
      d += __builtin_amdgcn_update_dpp(0, d, 0x141, 0xF, 0xF, false); \
      if (ch == 0 && sl < (NV)) zb[(((CE) >> 21) & 15) * PX_ROW + (((CE) >> 14) & 127)] = (float)d; }
#pragma unroll 1
  for (int rep = 0; rep < PROBE_U; rep++)
#pragma unroll 1
  for (int x = 0; x < 8; x++) {
    int c = 0;
    bool pend = false;
    uint4 qA[8]; int ceA = 0, nA = 0;
    uint4 hqn = *(const uint4*)(h2q + (size_t)(m0 + w * 16) * 1024 + lane * 16);
#pragma unroll 1
    for (int i = 0; i < 16; i++) {
      const uint4 hrow = hqn;
      hqn = *(const uint4*)(h2q + (size_t)(m0 + w * 16 + ((i < 15) ? i + 1 : i)) * 1024 + lane * 16);
      const int ev0 = eb[i * PX_ROW + lane], ev1 = eb[i * PX_ROW + 64 + lane];
      const bool f0 = (ev0 >> 18) == x, f1 = (ev1 >> 18) == x;
      const unsigned long long mk0 = __ballot(f0), mk1 = __ballot(f1);
      const int n0 = __builtin_popcountll(mk0), n = n0 + __builtin_popcountll(mk1);
      const int r0 = __builtin_amdgcn_mbcnt_hi((unsigned)(mk0 >> 32), __builtin_amdgcn_mbcnt_lo((unsigned)mk0, 0));
      const int r1 = n0 + __builtin_amdgcn_mbcnt_hi((unsigned)(mk1 >> 32), __builtin_amdgcn_mbcnt_lo((unsigned)mk1, 0));
      if (f0) cl[c + r0] = (ev0 >> 7) | (lane << 14) | (i << 21);
      if (f1) cl[c + r1] = (ev1 >> 7) | ((64 + lane) << 14) | (i << 21);
      const int m = c + n, rem = m & 7, nfull = m & ~7;
      const int np = (n < rem || i == 15) ? m : nfull;
      uint4 qB[8]; int ceB = 0;
      if (np > 0) { ceB = cl[(sl < np) ? sl : 0]; U_LOAD8(qB, ceB & 0x3FFF); }
      if (pend) { U_COMPUTE(qA, ceA, nA) }
      *(uint4*)(hqs + (i & 1) * 1024 + lane * 16) = hrow;
      if (np > 0) {
#pragma unroll
        for (int k = 0; k < 8; k++) qA[k] = qB[k];
        ceA = ceB; nA = (np < 8) ? np : 8;
#pragma unroll 1
        for (int bb = 8; bb < np; bb += 8) {
          const int ix = bb + sl; ceB = cl[(ix < np) ? ix : bb]; U_LOAD8(qB, ceB & 0x3FFF);
          U_COMPUTE(qA, ceA, 8)
#pragma unroll
          for (int k = 0; k < 8; k++) qA[k] = qB[k];
          ceA = ceB; nA = (np - bb < 8) ? np - bb : 8;
        }
        pend = true;
      } else pend = false;
      if (np == m) c = 0;
      else {
        if (nfull > 0 && lane < rem) { const int v = cl[nfull + lane]; cl[lane] = v; }
        c = rem;
      }
    }
    if (pend) { U_COMPUTE(qA, ceA, nA) }
  }
#undef U_COMPUTE
#undef U_LOAD8
  {
    const float* su = (const float*)(p.ws + OFF_SU);
    const float* sv = (const float*)(p.ws + OFF_SV);
    const float* shs = (const float*)(p.ws + OFF_SH);
    const float* gate = (const float*)(p.ws + OFF_GATE);
#pragma unroll 4
    for (int i = 0; i < 16; i++) {
      const int t = m0 + w * 16 + i;
      const float st = shs[t];
#pragma unroll
      for (int half = 0; half < 2; half++) {
        const int e = eb[i * PX_ROW + half * 64 + lane] >> 7;
        const float z = zb[i * PX_ROW + half * 64 + lane] * (su[e] * st);
        zb[i * PX_ROW + half * 64 + lane] = 0.5f * z * (1.f + erff(z * 0.70710678118654752f)) * gate[(size_t)t * 128 + half * 64 + lane] * sv[e];
      }
    }
  }
}

DEV void p3_vstage(const Params& p, int m0, char* smem) {
  const int tid_ = opaque_tid(); const int lane = tid_ & 63, w = __builtin_amdgcn_readfirstlane(tid_ >> 6);
  const unsigned char* V = p.ws + OFF_V;
  const float* ab = (const float*)(smem + PX_Z) + w * 16 * PX_ROW;
  const int* eb = (const int*)(smem + PX_E) + w * 16 * PX_ROW;
  float* ssq = (float*)(smem + PX_SS) + w * 16;
  u16* F = (u16*)(p.ws + OFF_MIX);
  const int ts = lane >> 3, ch = lane & 7;
  const unsigned cho = (unsigned)ch * 16u;
#define V_LOAD4(Q, E4) { Q[0] = *(const uint4*)(vb + ((unsigned)(E4).x | cho)); Q[1] = *(const uint4*)(vb + ((unsigned)(E4).y | cho)); \
    Q[2] = *(const uint4*)(vb + ((unsigned)(E4).z | cho)); Q[3] = *(const uint4*)(vb + ((unsigned)(E4).w | cho)); }
#pragma unroll 1
  for (int rep = 0; rep < PROBE_V; rep++)
#pragma unroll 1
  for (int x = 0; x < 8; x++) {
    const unsigned char* vb = V + (size_t)x * (16384 * 128);
#pragma unroll 1
    for (int grp = 0; grp < 2; grp++) {
      const int i = grp * 8 + ts;
      const int t = m0 + w * 16 + i;
      const int4* ep = (const int4*)(eb + i * PX_ROW);
      const float4* ap = (const float4*)(ab + i * PX_ROW);
      f32x2 acc[8];
#pragma unroll
      for (int k = 0; k < 8; k++) acc[k] = (f32x2){0.f, 0.f};
      uint4 qA[4], qB[4];
      int4 e4 = ep[0];
      V_LOAD4(qA, e4);
      e4 = ep[1];
      V_LOAD4(qB, e4);
#pragma unroll 1
      for (int pb = 0; pb < 32; pb += 2) {
#pragma unroll
        for (int half = 0; half < 2; half++) {
          const float4 a4 = ap[pb + half];
          const f32x2 a01 = {a4.x, a4.y}, a23 = {a4.z, a4.w};
#define V_PKFMA(ACC, AP, W2, SEL) asm("v_pk_fma_f32 %0, %1, %2, %0 op_sel:[" SEL ",0,0] op_sel_hi:[" SEL ",1,1]" : "+v"(ACC) : "v"(AP), "v"(W2))
#define V_ROW(QQ, AP, SEL) { const unsigned wds[4] = {QQ.x, QQ.y, QQ.z, QQ.w}; \
            _Pragma("unroll") for (int k2 = 0; k2 < 4; k2++) { \
              const f32x2 w0_ = __builtin_amdgcn_cvt_pk_f32_fp8((int)wds[k2], false), w1_ = __builtin_amdgcn_cvt_pk_f32_fp8((int)wds[k2], true); \
              V_PKFMA(acc[2 * k2], AP, w0_, SEL); V_PKFMA(acc[2 * k2 + 1], AP, w1_, SEL); } }
          if (half) { V_ROW(qB[0], a01, "0") V_ROW(qB[1], a01, "1") V_ROW(qB[2], a23, "0") V_ROW(qB[3], a23, "1") }
          else { V_ROW(qA[0], a01, "0") V_ROW(qA[1], a01, "1") V_ROW(qA[2], a23, "0") V_ROW(qA[3], a23, "1") }
#undef V_ROW
#undef V_PKFMA
          const int nx = pb + 2 + half;
          if (nx < 32) { const int4 en = ep[nx]; if (half) { V_LOAD4(qB, en); } else { V_LOAD4(qA, en); } }
        }
      }
      float ss = 0.f;
#pragma unroll
      for (int k = 0; k < 8; k++) ss = fmaf(acc[k][0], acc[k][0], fmaf(acc[k][1], acc[k][1], ss));
      ss += __int_as_float(__builtin_amdgcn_update_dpp(0, __float_as_int(ss), 0xB1, 0xF, 0xF, false));
      ss += __int_as_float(__builtin_amdgcn_update_dpp(0, __float_as_int(ss), 0x4E, 0xF, 0xF, false));
      ss += __int_as_float(__builtin_amdgcn_update_dpp(0, __float_as_int(ss), 0x141, 0xF, 0xF, false));
      if (rep < PROBE_V) {
        u16* fp = F + (size_t)t * 1024 + x * 128 + ch * 16;
        *(uint4*)(fp) = make_uint4(pack2(acc[0][0], acc[0][1]), pack2(acc[1][0], acc[1][1]), pack2(acc[2][0], acc[2][1]), pack2(acc[3][0], acc[3][1]));
        *(uint4*)(fp + 8) = make_uint4(pack2(acc[4][0], acc[4][1]), pack2(acc[5][0], acc[5][1]), pack2(acc[6][0], acc[6][1]), pack2(acc[7][0], acc[7][1]));
        if (ch == 0 && rep == 0) ssq[i] += ss;
      }
    }
  }
#undef V_LOAD4
  {
    const float* mod = (const float*)(p.ws + OFF_MOD);
    const int b = m0 >> 11;
    float4 fg2[4];
#pragma unroll
    for (int j = 0; j < 4; j++) {
      const int col = j * 256 + lane * 4;
      const float4 fg = *(const float4*)(p.post_ffn_g + col);
      const float4 g2 = ldmod(mod, b * 6144 + 5120 + col);
      fg2[j] = make_float4(fg.x * g2.x, fg.y * g2.y, fg.z * g2.z, fg.w * g2.w);
    }
#pragma unroll 2
    for (int i = 0; i < 16; i++) {
      const int t = m0 + w * 16 + i;
      const float rstd = rsqrtf(ssq[i] * (1.f / 1024.f) + 1e-6f);
      const uint4 fA = *(const uint4*)(F + (size_t)t * 1024 + lane * 16), fB = *(const uint4*)(F + (size_t)t * 1024 + lane * 16 + 8);
      const uint4 xA = *(const uint4*)((const u16*)(p.ws + OFF_X1) + (size_t)t * 1024 + lane * 16), xB = *(const uint4*)((const u16*)(p.ws + OFF_X1) + (size_t)t * 1024 + lane * 16 + 8);
      const unsigned fw[8] = {fA.x, fA.y, fA.z, fA.w, fB.x, fB.y, fB.z, fB.w}, xw[8] = {xA.x, xA.y, xA.z, xA.w, xB.x, xB.y, xB.z, xB.w};
#pragma unroll
      for (int j = 0; j < 4; j++) {
        const float4 f = make_float4(bflo(fw[2 * j]), bfhi(fw[2 * j]), bflo(fw[2 * j + 1]), bfhi(fw[2 * j + 1]));
        const int col = j * 256 + lane * 4;
        const float4 x1 = make_float4(bflo(xw[2 * j]), bfhi(xw[2 * j]), bflo(xw[2 * j + 1]), bfhi(xw[2 * j + 1]));
        float4 o;
        o.x = x1.x + (f.x * rstd) * fg2[j].x; o.y = x1.y + (f.y * rstd) * fg2[j].y;
        o.z = x1.z + (f.z * rstd) * fg2[j].z; o.w = x1.w + (f.w * rstd) * fg2[j].w;
        *(float4*)(p.out + (size_t)t * 1024 + col) = o;
      }
    }
  }
}

DEV void phase3_tile(const Params& p, int mt, char* smem) {
  const int m0 = mt * 128;
  const u16* cat = (const u16*)(p.ws + OFF_HBUF) + (size_t)m0 * 1024;
  {
    const u16* wt = (const u16*)(p.ws + OFF_WTOUT);
    for (int rep = 0; rep < PROBE_G3; rep++)
    for (int nc = 0; nc < 4; nc++) {
      EpiStoreBf16 epi{(u16*)(p.ws + OFF_MIX) + (size_t)m0 * 1024, nc * 256};
      gemm_tile(cat, 1024, wt + (size_t)nc * 256 * 1024, 1024, 1024, smem, epi);
    }
  }
  __syncthreads();
  p3_rows1(p, m0);
#if STAGE >= 6
  __syncthreads();
  {
    const u16* wt = (const u16*)(p.ws + OFF_WTQ);
    for (int rep = 0; rep < PROBE_G3; rep++)
    for (int nc = 0; nc < 4; nc++) {
      EpiStoreBf16 epi{(u16*)(p.ws + OFF_QP) + (size_t)m0 * 1024, nc * 256};
      gemm_tile(cat, 1024, wt + (size_t)nc * 256 * 1024, 1024, 1024, smem, epi);
    }
  }
  __syncthreads();
  for (int rep = 0; rep < PROBE_ROUTE; rep++) p3_route(p, m0, smem);
  __syncthreads();
#endif
}

DEV void grid_barrier(unsigned* counter, unsigned& target) {
  asm volatile("s_waitcnt vmcnt(0)" ::: "memory");
  __syncthreads();
  if (threadIdx.x == 0) {
    __builtin_amdgcn_fence(__ATOMIC_RELEASE, "agent");
    asm volatile("s_waitcnt vmcnt(0)" ::: "memory");
    target += gridDim.x;
    __hip_atomic_fetch_add(counter, 1u, __ATOMIC_RELAXED, __HIP_MEMORY_SCOPE_AGENT);
    while (__hip_atomic_load(counter, __ATOMIC_RELAXED, __HIP_MEMORY_SCOPE_AGENT) < target) __builtin_amdgcn_s_sleep(1);
    __builtin_amdgcn_fence(__ATOMIC_ACQUIRE, "agent");
    asm volatile("s_waitcnt vmcnt(0)" ::: "memory");
  }
  __syncthreads();
}

#define XB_TMO      128
#define XB_XCNT(j)  (256  + 64 * (j))
#define XB_XSUB(j)  (1280 + 64 * (j))
#define XB_XGEN(j)  (2304 + 64 * (j))
#define XB_TOP      3328
#define XB_TOPGEN   3392
#define XB_SPIN_CAP (1u << 22)
DEV unsigned xb_ld(unsigned* p) { return __hip_atomic_load(p, __ATOMIC_RELAXED, __HIP_MEMORY_SCOPE_AGENT); }
DEV unsigned xb_add(unsigned* p, unsigned v) { return __hip_atomic_fetch_add(p, v, __ATOMIC_RELAXED, __HIP_MEMORY_SCOPE_AGENT); }
DEV unsigned xb_xcc_id() { return (unsigned)__builtin_amdgcn_s_getreg((3 << 11) | 20) & 0xFu; }
#define XB_SPIN(cond, bar) do { unsigned _sp = 0; while (cond) { __builtin_amdgcn_s_sleep(1); \
    if ((++_sp & 255u) == 0u) { if (xb_ld(&(bar)[XB_TMO])) break; if (_sp > XB_SPIN_CAP) { atomicAdd(&(bar)[XB_TMO], 1u); break; } } } } while (0)
struct XcdBarrier { unsigned* bar; unsigned x; unsigned* st; };
DEV void xcd_barrier_complete(unsigned* bar, unsigned x, unsigned& nloc, unsigned& nx) {
  const unsigned G = gridDim.x;
  unsigned sum, cnt, mine, sp = 0u;
  for (;;) {
    sum = 0u; cnt = 0u; mine = 0u;
#pragma unroll
    for (unsigned j = 0; j < 16; ++j) { const unsigned c = xb_ld(&bar[XB_XCNT(j)]); sum += c; cnt += (c > 0u) ? 1u : 0u; mine = (j == x) ? c : mine; }
    if (sum == G) break;
    __builtin_amdgcn_s_sleep(1);
    if ((++sp & 255u) == 0u) { if (xb_ld(&bar[XB_TMO])) break; if (sp > XB_SPIN_CAP) { atomicAdd(&bar[XB_TMO], 1u); break; } }
  }
  nloc = mine > 0u ? mine : 1u; nx = cnt > 0u ? cnt : 1u;
}
DEV void xcd_barrier(const XcdBarrier& b) {
  asm volatile("s_waitcnt vmcnt(0)" ::: "memory");
  __syncthreads();
  if (threadIdx.x == 0) {
    unsigned* bar = b.bar;
    __builtin_amdgcn_s_waitcnt(0);
    unsigned nloc = b.st[0], nx = b.st[1];
    if (nloc == 0u) { xcd_barrier_complete(bar, b.x, nloc, nx); b.st[0] = nloc; b.st[1] = nx; }
    const unsigned old = xb_add(&bar[XB_XSUB(b.x)], 1u);
    const unsigned gen = old / nloc;
    if (old + 1u == (gen + 1u) * nloc) {
      __builtin_amdgcn_fence(__ATOMIC_RELEASE, "agent");
      asm volatile("s_waitcnt vmcnt(0)" ::: "memory");
      const unsigned og = xb_add(&bar[XB_TOP], 1u);
      const unsigned tg = og / nx;
      if (og + 1u == (tg + 1u) * nx) xb_add(&bar[XB_TOPGEN], 1u);
      else XB_SPIN(xb_ld(&bar[XB_TOPGEN]) == tg, bar);
      __builtin_amdgcn_fence(__ATOMIC_ACQUIRE, "agent");
      xb_add(&bar[XB_XGEN(b.x)], 1u);
      asm volatile("s_waitcnt vmcnt(0)" ::: "memory");
    } else {
      XB_SPIN(xb_ld(&bar[XB_XGEN(b.x)]) == gen, bar);
      __builtin_amdgcn_fence(__ATOMIC_ACQUIRE, "agent");
      asm volatile("s_waitcnt vmcnt(0)" ::: "memory");
    }
  }
  __syncthreads();
}

__global__ void __launch_bounds__(NT) mega(Params p) {
  __shared__ __attribute__((aligned(16))) char smem[LDS_BYTES + 16];
  cg::grid_group grid = cg::this_grid();
  XcdBarrier xb; xb.bar = (unsigned*)(p.ws + OFF_XB); xb.x = xb_xcc_id(); xb.st = (unsigned*)(smem + LDS_BYTES);
  if (threadIdx.x == 0) { xb.st[0] = 0u; xb.st[1] = 0u; (void)xb_add(&xb.bar[XB_XCNT(xb.x)], 1u); }
  __syncthreads();
#if STAGE == 0
  {
    const size_t n4 = (size_t)T_ * 1024 / 4;
    for (size_t i = (size_t)blockIdx.x * NT + threadIdx.x; i < n4; i += (size_t)gridDim.x * NT) ((float4*)p.out)[i] = ((const float4*)p.x)[i];
  }
#endif
  phase_mod(p, smem);
  if (gridDim.x == 0x7fffffffu) grid.sync();
  xcd_barrier(xb);
#if PH(1)
  for (int rep = 0; rep < PROBE_HN; rep++) phase_hnorm(p);
#endif
#if PH(0)
  for (int rep = 0; rep < PROBE_P0; rep++) phase0(p, smem);
#endif
  xcd_barrier(xb);
#if STAGE >= 1 && PH(2)
  for (int rep = 0; rep < PROBE_P1; rep++) phase1(p, smem);
#endif
  xcd_barrier(xb);
  if (gridDim.x == 256 && (blockIdx.x & 1)) convert_fp8_rows(p.peer_v, p.ws + OFF_V, (float*)(p.ws + OFF_SV));
  if (gridDim.x == 256 && !(blockIdx.x & 1)) convert_i8_rows(p.peer_u, p.ws + OFF_U, (float*)(p.ws + OFF_SU));
#if STAGE >= 2 && PH(3)
  for (int rep = 0; rep < PROBE_SSDA; rep++)
  for (int it = blockIdx.x; it < 512; it += gridDim.x) { ssdA_item(p, it >> 5, (it >> 1) & 15, it & 1, smem); }
#endif
#if STAGE >= 4 && PH(4)
  for (int rep = 0; rep < PROBE_DSA; rep++)
  for (int k = 0; k < 4; k++) {
    const int i = blockIdx.x + k * gridDim.x;
    if (gridDim.x == 256) {
      const int rr = i & 255; const int b = rr & 15, a = rr >> 4;
      const int qt = (k == 0) ? a : (k == 1) ? 31 - a : (k == 2) ? 32 + a : 63 - a;
      dsa_item(p, b, qt, smem);
    }
  }
  if (gridDim.x != 256) { for (int i = blockIdx.x; i < 1024; i += gridDim.x) dsa_item(p, i & 15, 63 - (i >> 4), smem); }
  if (gridDim.x == 256 && !(blockIdx.x & 1)) convert_fp8_rows(p.peer_v, p.ws + OFF_V, (float*)(p.ws + OFF_SV));
  if (gridDim.x == 256 && (blockIdx.x & 1)) convert_i8_rows(p.peer_u, p.ws + OFF_U, (float*)(p.ws + OFF_SU));
#if STAGE >= 2
  xcd_barrier(xb);
#endif
  if (gridDim.x == 256) ssdS_pair16(p, blockIdx.x);
  else for (int it = blockIdx.x; it < 512; it += gridDim.x) ssdS_item(p, it >> 5, (it >> 2) & 7, it & 3);
#elif STAGE >= 2 && STAGE < 4
  {
    u16* cat = (u16*)(p.ws + OFF_HBUF);
    for (size_t i = (size_t)blockIdx.x * NT + threadIdx.x; i < (size_t)T_ * 64; i += (size_t)gridDim.x * NT) {
      const size_t t = i >> 6, cc = i & 63;
      *(uint4*)(cat + t * 1024 + cc * 8) = make_uint4(0, 0, 0, 0);
    }
  }
#endif
  xcd_barrier(xb);
#if STAGE >= 2 && PH(5)
  for (int rep = 0; rep < PROBE_SSDB; rep++)
  for (int it = blockIdx.x; it < 256; it += gridDim.x) ssdB_item(p, it >> 4, it & 15, smem);
#endif
  if (gridDim.x == 256) __syncthreads(); else xcd_barrier(xb);
#if STAGE >= 3 && PH(6)
  if (gridDim.x == 256) {
    phase3_tile(p, blockIdx.x, smem);
    __syncthreads();
    p3_ustage(p, blockIdx.x * 128, smem);
    p3_vstage(p, blockIdx.x * 128, smem);
  } else {
    convert_fp8_rows(p.peer_v, p.ws + OFF_V, (float*)(p.ws + OFF_SV));
    xcd_barrier(xb);
    for (int mt = blockIdx.x; mt < 256; mt += gridDim.x) { phase3_tile(p, mt, smem); p3_ustage(p, mt * 128, smem); p3_vstage(p, mt * 128, smem); __syncthreads(); }
  }
#endif
}

extern "C" void kernel_launch(void* const* d_in, const int* in_sizes, int n_in, void* d_out, int out_size, void* d_ws, size_t ws_size, hipStream_t stream) {
  static int grid_blocks = 0;
  if (!grid_blocks) {
    int dev = 0, cus = 0, per_cu = 0;
    hipGetDevice(&dev);
    hipDeviceGetAttribute(&cus, hipDeviceAttributeMultiprocessorCount, dev);
    hipOccupancyMaxActiveBlocksPerMultiprocessor(&per_cu, mega, NT, 0);
    if (per_cu < 1) { fprintf(stderr, "occupancy query says %d blocks/CU\n", per_cu); per_cu = 1; }
    grid_blocks = cus;
    if (ws_size < WS_END) fprintf(stderr, "workspace too small: %zu < %zu\n", ws_size, (size_t)WS_END);
  }
  Params p{};
  p.x = (const float*)d_in[0]; p.c = (const float*)d_in[1]; p.pos = (const int*)d_in[2]; p.w_ada = (const float*)d_in[3]; p.b_ada = (const float*)d_in[4];
  p.pre_mix_g = (const float*)d_in[5]; p.post_mix_g = (const float*)d_in[6]; p.w_in = (const float*)d_in[7]; p.conv_w = (const float*)d_in[8]; p.conv_b = (const float*)d_in[9];
  p.dt_bias = (const float*)d_in[10]; p.a_log = (const float*)d_in[11]; p.d_skip = (const float*)d_in[12]; p.ssd_norm_g = (const float*)d_in[13]; p.w_out = (const float*)d_in[14];
  p.pre_ffn_g = (const float*)d_in[15]; p.post_ffn_g = (const float*)d_in[16]; p.w_q = (const float*)d_in[17]; p.sub_keys = (const float*)d_in[18]; p.peer_u = (const float*)d_in[19];
  p.peer_v = (const float*)d_in[20]; p.out = (float*)d_out; p.ws = (unsigned char*)d_ws;
  if (hipMemsetAsync((unsigned char*)d_ws + OFF_XB, 0, 16384, stream) != hipSuccess) fprintf(stderr, "memset of the barrier words failed\n");
  void* args[] = {&p};
  hipError_t e = hipLaunchCooperativeKernel((void*)mega, dim3(grid_blocks), dim3(NT), args, 0, stream);
  if (e != hipSuccess) fprintf(stderr, "cooperative launch failed: %s (grid %d)\n", hipGetErrorString(e), grid_blocks);
}
```
